# Optimizing an MI355X kernel written in HIP

```python
import jax, jax.numpy as jnp
from jax import lax
import numpy as np

D_MODEL = 1024
BATCH = 8
SEQ = 2048
DEPTH = 1
DEC_BATCH = 128
DEC_SEQ = 1
PAST_LEN = 8192
PAGE_SIZE = 128

MLA_HEADS = 8
MLA_NOPE = 64
MLA_ROPE = 32
MLA_VDIM = 64
MLA_Q_RANK = 256
MLA_KV_RANK = 128
MLA_SCALE = (MLA_NOPE + MLA_ROPE) ** -0.5
ROPE_THETA = 10000.0
Q_BLOCK = 128
GLA_HEADS = 4
GLA_DK = 64
GLA_DV = 128
GLA_GATE_RANK = 16
GLA_TAU = 16.0
GLA_CHUNK = 64

MLA_WIDTH = MLA_HEADS * MLA_VDIM
GLA_WIDTH = GLA_HEADS * GLA_DV
MIX_WIDTH = MLA_WIDTH + GLA_WIDTH
IN_SPLITS = (MLA_Q_RANK, MLA_KV_RANK, MLA_ROPE, MLA_WIDTH, GLA_HEADS * GLA_DK, GLA_HEADS * GLA_DK, GLA_WIDTH, GLA_GATE_RANK, GLA_WIDTH)
IN_WIDTH = MLA_Q_RANK + MLA_KV_RANK + MLA_ROPE + MLA_WIDTH + 2 * GLA_HEADS * GLA_DK + GLA_WIDTH + GLA_GATE_RANK + GLA_WIDTH
DEEPNORM_ALPHA = (2 * DEPTH) ** 0.25
DEEPNORM_BETA = (8 * DEPTH) ** -0.25
NORM_EPS = 1e-6

kernel_name = "hybrid_mla_gla_deepnorm_adaln_step"

F32 = jnp.float32


def rms_norm(x, g):
    xf = x.astype(F32)
    y = xf * lax.rsqrt(jnp.mean(xf * xf, axis=-1, keepdims=True) + NORM_EPS)
    return (y * g.astype(F32)).astype(x.dtype)


def layer_norm(x, g, b):
    xf = x.astype(F32)
    mu = jnp.mean(xf, axis=-1, keepdims=True)
    var = jnp.mean(jnp.square(xf - mu), axis=-1, keepdims=True)
    y = (xf - mu) * lax.rsqrt(var + NORM_EPS)
    return (y * g.astype(F32) + b.astype(F32)).astype(x.dtype)


def rope_cos_sin(pos):
    inv = ROPE_THETA ** (-jnp.arange(0, MLA_ROPE, 2, dtype=F32) / MLA_ROPE)
    ang = pos.astype(F32)[:, None] * inv[None, :]
    return jnp.cos(ang), jnp.sin(ang)


def apply_rope(x, cos, sin):
    half = MLA_ROPE // 2
    xf = x.astype(F32)
    x1, x2 = xf[..., :half], xf[..., half:]
    return jnp.concatenate([x1 * cos - x2 * sin, x2 * cos + x1 * sin], axis=-1).astype(x.dtype)


def ada_modulation(c, w_ada, b_ada):
    mod = jax.nn.silu(c) @ w_ada + b_ada
    shift, scale, gate = jnp.split(mod, 3, axis=-1)
    return shift, scale, gate


def project(h, cos, sin, w_in, q_norm_g, w_uq, kv_norm_g, w_gate_up, b_gate):
    B, S = h.shape[0], h.shape[1]
    z = h @ w_in
    offs = [int(o) for o in np.cumsum(IN_SPLITS)[:-1]]
    cq, ckv, kr, g_mla, gq, gk, gv, glr, g_gla = jnp.split(z, offs, axis=-1)
    q = (rms_norm(cq, q_norm_g) @ w_uq).reshape(B, S, MLA_HEADS, MLA_NOPE + MLA_ROPE)
    q_nope = q[..., :MLA_NOPE]
    q_rope = apply_rope(q[..., MLA_NOPE:], cos[:, None, :], sin[:, None, :])
    ckv = rms_norm(ckv, kv_norm_g)
    kr = apply_rope(kr, cos, sin)
    gla_q = gq.reshape(B, S, GLA_HEADS, GLA_DK) * (GLA_DK ** -0.5)
    gla_k = gk.reshape(B, S, GLA_HEADS, GLA_DK)
    gla_v = gv.reshape(B, S, GLA_HEADS, GLA_DV)
    log_a = jax.nn.log_sigmoid((glr @ w_gate_up + b_gate).astype(F32)) / GLA_TAU
    log_a = log_a.reshape(B, S, GLA_HEADS, GLA_DK)
    return q_nope, q_rope, ckv, kr, g_mla, gla_q, gla_k, gla_v, log_a, g_gla


def mla_prompt(q_nope, q_rope, ckv, kr, w_uk, w_uv):
    B, S = q_nope.shape[0], q_nope.shape[1]
    k_nope = jnp.einsum('bsr,rhn->bshn', ckv, w_uk)
    v = jnp.einsum('bsr,rhv->bshv', ckv, w_uv)
    nb = S // Q_BLOCK
    qn_b = q_nope.reshape(B, nb, Q_BLOCK, MLA_HEADS, MLA_NOPE).transpose(1, 0, 2, 3, 4)
    qr_b = q_rope.reshape(B, nb, Q_BLOCK, MLA_HEADS, MLA_ROPE).transpose(1, 0, 2, 3, 4)
    key_pos = jnp.arange(S)

    def block(args):
        i, qn, qr = args
        s = jnp.einsum('bqhn,bkhn->bhqk', qn, k_nope) + jnp.einsum('bqhp,bkp->bhqk', qr, kr)
        s = s.astype(F32) * MLA_SCALE
        q_pos = i * Q_BLOCK + jnp.arange(Q_BLOCK)
        s = jnp.where(key_pos[None, :] <= q_pos[:, None], s, -jnp.inf)
        p = jax.nn.softmax(s, axis=-1).astype(v.dtype)
        return jnp.einsum('bhqk,bkhv->bqhv', p, v)

    o = lax.map(block, (jnp.arange(nb), qn_b, qr_b))
    return o.transpose(1, 0, 2, 3, 4).reshape(B, S, MLA_HEADS, MLA_VDIM)


def mla_sample(q_nope, q_rope, ckv_new, kr_new, cache_lat, cache_kr, page_table, w_uk, w_uv):
    Bd, Sd = q_nope.shape[0], q_nope.shape[1]
    lat_past = cache_lat[page_table].reshape(Bd, -1, MLA_KV_RANK)
    kr_past = cache_kr[page_table].reshape(Bd, -1, MLA_ROPE)
    q_lat = jnp.einsum('bshn,rhn->bshr', q_nope, w_uk)
    s_past = jnp.einsum('bshr,btr->bhst', q_lat, lat_past) + jnp.einsum('bshp,btp->bhst', q_rope, kr_past)
    s_new = jnp.einsum('bshr,btr->bhst', q_lat, ckv_new) + jnp.einsum('bshp,btp->bhst', q_rope, kr_new)
    causal = jnp.tril(jnp.ones((Sd, Sd), dtype=bool))
    s_new = jnp.where(causal, s_new.astype(F32), -jnp.inf)
    s = jnp.concatenate([s_past.astype(F32), s_new], axis=-1) * MLA_SCALE
    lat_all = jnp.concatenate([lat_past, ckv_new], axis=1)
    p = jax.nn.softmax(s, axis=-1).astype(lat_all.dtype)
    o_lat = jnp.einsum('bhst,btr->bshr', p, lat_all)
    return jnp.einsum('bshr,rhv->bshv', o_lat, w_uv)


def gla_chunked(q, k, v, log_a):
    B, S = q.shape[0], q.shape[1]
    nc = S // GLA_CHUNK

    def to_chunks(t):
        d = t.shape[-1]
        return t.astype(F32).reshape(B, nc, GLA_CHUNK, GLA_HEADS, d).transpose(1, 0, 3, 2, 4)

    xs = (to_chunks(q), to_chunks(k), to_chunks(v), to_chunks(log_a))
    causal = jnp.tril(jnp.ones((GLA_CHUNK, GLA_CHUNK), dtype=bool))

    def step(state, inp):
        qc, kc, vc, gc = inp
        b = jnp.cumsum(gc, axis=2)
        o_inter = jnp.einsum('bhcd,bhde->bhce', qc * jnp.exp(b), state)
        diff = b[:, :, :, None, :] - b[:, :, None, :, :]
        dec = jnp.exp(jnp.where(causal[None, None, :, :, None], diff, -jnp.inf))
        att = jnp.einsum('bhid,bhjd,bhijd->bhij', qc, kc, dec)
        o_intra = jnp.einsum('bhij,bhje->bhie', att, vc)
        b_last = b[:, :, -1:, :]
        new_state = jnp.exp(b_last[:, :, 0, :])[..., None] * state + jnp.einsum('bhcd,bhce->bhde', kc * jnp.exp(b_last - b), vc)
        return new_state, o_inter + o_intra

    s0 = jnp.zeros((B, GLA_HEADS, GLA_DK, GLA_DV), F32)
    s_fin, o = lax.scan(step, s0, xs)
    o = o.transpose(1, 0, 3, 2, 4).reshape(B, S, GLA_HEADS, GLA_DV)
    return o.astype(v.dtype), s_fin.astype(v.dtype)


def gla_recurrent(q, k, v, log_a, state0):
    xs = tuple(t.astype(F32).transpose(1, 0, 2, 3) for t in (q, k, v, log_a))

    def step(state, inp):
        qt, kt, vt, gt = inp
        state = jnp.exp(gt)[..., None] * state + kt[..., None] * vt[..., None, :]
        return state, jnp.einsum('bhd,bhde->bhe', qt, state)

    s_fin, o = lax.scan(step, state0.astype(F32), xs)
    return o.transpose(1, 0, 2, 3).astype(v.dtype), s_fin.astype(state0.dtype)


def finish(x, mla_o, gla_o, g_mla, g_gla, gla_norm_g, w_out, gate_c, ln_g, ln_b):
    B, S = x.shape[0], x.shape[1]
    mla = mla_o.reshape(B, S, MLA_WIDTH) * jax.nn.silu(g_mla)
    gla = rms_norm(gla_o, gla_norm_g).reshape(B, S, GLA_WIDTH) * jax.nn.silu(g_gla)
    sub = jnp.concatenate([mla, gla], axis=-1) @ w_out
    return layer_norm(DEEPNORM_ALPHA * x + gate_c[:, None, :] * sub, ln_g, ln_b)


def setup_inputs(seed: int = 0) -> dict:
    key = jax.random.key(seed)
    ks = jax.random.split(key, 24)
    n_pages = PAST_LEN // PAGE_SIZE
    n_used = DEC_BATCH * n_pages
    n_phys = n_used + max(1, n_used // 4)
    nrm = jax.random.normal
    page_table = jax.random.permutation(ks[0], n_phys)[:n_used].reshape(DEC_BATCH, n_pages).astype(jnp.int32)
    return {
        "x_prompt": nrm(ks[1], (BATCH, SEQ, D_MODEL), F32),
        "x_sample": nrm(ks[2], (DEC_BATCH, DEC_SEQ, D_MODEL), F32),
        "cache_kv_latent": nrm(ks[3], (DEPTH, n_phys, PAGE_SIZE, MLA_KV_RANK), F32),
        "cache_k_rope": nrm(ks[4], (DEPTH, n_phys, PAGE_SIZE, MLA_ROPE), F32),
        "state_gla": nrm(ks[5], (DEPTH, DEC_BATCH, GLA_HEADS, GLA_DK, GLA_DV), F32),
        "page_table": page_table,
        "c_prompt": nrm(ks[6], (BATCH, D_MODEL), F32),
        "c_sample": nrm(ks[7], (DEC_BATCH, D_MODEL), F32),
        "w_ada": nrm(ks[8], (DEPTH, D_MODEL, 3 * D_MODEL), F32) * (0.5 * D_MODEL ** -0.5),
        "b_ada": nrm(ks[9], (DEPTH, 3 * D_MODEL), F32) * 0.02,
        "w_in": nrm(ks[10], (DEPTH, D_MODEL, IN_WIDTH), F32) * D_MODEL ** -0.5,
        "q_norm_g": 1.0 + 0.01 * nrm(ks[11], (DEPTH, MLA_Q_RANK), F32),
        "w_uq": nrm(ks[12], (DEPTH, MLA_Q_RANK, MLA_HEADS * (MLA_NOPE + MLA_ROPE)), F32) * MLA_Q_RANK ** -0.5,
        "kv_norm_g": 1.0 + 0.01 * nrm(ks[13], (DEPTH, MLA_KV_RANK), F32),
        "w_uk": nrm(ks[14], (DEPTH, MLA_KV_RANK, MLA_HEADS, MLA_NOPE), F32) * MLA_KV_RANK ** -0.5,
        "w_uv": nrm(ks[15], (DEPTH, MLA_KV_RANK, MLA_HEADS, MLA_VDIM), F32) * MLA_KV_RANK ** -0.5,
        "w_gate_up": nrm(ks[16], (DEPTH, GLA_GATE_RANK, GLA_HEADS * GLA_DK), F32) * GLA_GATE_RANK ** -0.5,
        "b_gate": nrm(ks[17], (DEPTH, GLA_HEADS * GLA_DK), F32) * 0.02,
        "gla_norm_g": 1.0 + 0.01 * nrm(ks[18], (DEPTH, GLA_HEADS, GLA_DV), F32),
        "w_out": nrm(ks[19], (DEPTH, MIX_WIDTH, D_MODEL), F32) * (MIX_WIDTH ** -0.5 * DEEPNORM_BETA),
        "ln_g": 1.0 + 0.01 * nrm(ks[20], (DEPTH, D_MODEL), F32),
        "ln_b": 0.01 * nrm(ks[21], (DEPTH, D_MODEL), F32),
    }


def reference(x_prompt, x_sample, cache_kv_latent, cache_k_rope, state_gla, page_table, c_prompt, c_sample,
              w_ada, b_ada, w_in, q_norm_g, w_uq, kv_norm_g, w_uk, w_uv, w_gate_up, b_gate, gla_norm_g,
              w_out, ln_g, ln_b):
    cos_p, sin_p = rope_cos_sin(jnp.arange(x_prompt.shape[1], dtype=jnp.int32))
    past_len = page_table.shape[1] * PAGE_SIZE
    cos_s, sin_s = rope_cos_sin(past_len + jnp.arange(x_sample.shape[1], dtype=jnp.int32))
    xp, xs = x_prompt, x_sample
    lat_p, kr_p, st_p, lat_s, kr_s, st_s = [], [], [], [], [], []
    for l in range(DEPTH):
        shift, scale, gate = ada_modulation(c_prompt, w_ada[l], b_ada[l])
        h = xp * (1.0 + scale[:, None, :]) + shift[:, None, :]
        qn, qr, ckv, kr, g_mla, gq, gk, gv, la, g_gla = project(h, cos_p, sin_p, w_in[l], q_norm_g[l], w_uq[l], kv_norm_g[l], w_gate_up[l], b_gate[l])
        mla_o = mla_prompt(qn, qr, ckv, kr, w_uk[l], w_uv[l])
        gla_o, s_fin = gla_chunked(gq, gk, gv, la)
        xp = finish(xp, mla_o, gla_o, g_mla, g_gla, gla_norm_g[l], w_out[l], gate, ln_g[l], ln_b[l])
        lat_p.append(ckv)
        kr_p.append(kr)
        st_p.append(s_fin)
        shift, scale, gate = ada_modulation(c_sample, w_ada[l], b_ada[l])
        h = xs * (1.0 + scale[:, None, :]) + shift[:, None, :]
        qn, qr, ckv, kr, g_mla, gq, gk, gv, la, g_gla = project(h, cos_s, sin_s, w_in[l], q_norm_g[l], w_uq[l], kv_norm_g[l], w_gate_up[l], b_gate[l])
        mla_o = mla_sample(qn, qr, ckv, kr, cache_kv_latent[l], cache_k_rope[l], page_table, w_uk[l], w_uv[l])
        gla_o, s_fin = gla_recurrent(gq, gk, gv, la, state_gla[l])
        xs = finish(xs, mla_o, gla_o, g_mla, g_gla, gla_norm_g[l], w_out[l], gate, ln_g[l], ln_b[l])
        lat_s.append(ckv)
        kr_s.append(kr)
        st_s.append(s_fin)
    return (xp, xs, jnp.stack(lat_p), jnp.stack(kr_p), jnp.stack(st_p), jnp.stack(lat_s), jnp.stack(kr_s), jnp.stack(st_s))
```

```cpp
#include <hip/hip_runtime.h>
#include <cstdint>
#include <cstdio>

typedef __bf16 bf16x8 __attribute__((ext_vector_type(8)));
typedef __bf16 bf16x4 __attribute__((ext_vector_type(4)));
typedef __bf16 bf16x2 __attribute__((ext_vector_type(2)));
typedef float f32x16 __attribute__((ext_vector_type(16)));
typedef float f32x4 __attribute__((ext_vector_type(4)));
typedef float f32x2 __attribute__((ext_vector_type(2)));
typedef unsigned u32x4 __attribute__((ext_vector_type(4)));
typedef unsigned u32x2 __attribute__((ext_vector_type(2)));

#define NTHR 512
#define N_LAUNCHES 1
#define REP_PH (-1)
#define LDS_BYTES 143360
#define LDS_BASE 256

constexpr int DM = 1024, SEQ = 2048, NB = 8, NTOK = 16384, NDEC = 128, RT = NTOK + NDEC;
constexpr int NPAGES = 64;
constexpr float NORM_EPS = 1e-6f;
constexpr float LOG2E = 1.4426950408889634f;
constexpr float QSCALE = 0.10206207261596577f * 1.4426950408889634f;
constexpr float DN_ALPHA = 1.189207115002721f;

constexpr size_t OUT_YP = 0;
constexpr size_t OUT_YS = OUT_YP + (size_t)NTOK * 1024;
constexpr size_t OUT_LATP = OUT_YS + (size_t)NDEC * 1024;
constexpr size_t OUT_KRP = OUT_LATP + (size_t)NTOK * 128;
constexpr size_t OUT_STP = OUT_KRP + (size_t)NTOK * 32;
constexpr size_t OUT_LATS = OUT_STP + (size_t)NB * 4 * 64 * 128;
constexpr size_t OUT_KRS = OUT_LATS + (size_t)NDEC * 128;
constexpr size_t OUT_STS = OUT_KRS + (size_t)NDEC * 32;
constexpr size_t OUT_END = OUT_STS + (size_t)NDEC * 4 * 64 * 128;

constexpr size_t al256(size_t x) { return (x + 255) & ~(size_t)255; }
constexpr size_t WS_CTL = 0;
constexpr size_t CTL_BYTES = 16384;
constexpr size_t WS_MOD = WS_CTL + CTL_BYTES;
constexpr size_t WS_ROPE = WS_MOD + al256((size_t)136 * 3072 * 4);
constexpr size_t WS_WINF = WS_ROPE + al256((size_t)2049 * 32 * 4);
constexpr size_t WS_WUQF = WS_WINF + (size_t)78 * 64 * 1024;
constexpr size_t WS_WKVF = WS_WUQF + (size_t)24 * 16 * 1024;
constexpr size_t WS_WOUTF = WS_WKVF + (size_t)32 * 8 * 1024;
constexpr size_t WS_WUKB = WS_WOUTF + (size_t)32 * 64 * 1024;
constexpr size_t WS_WUVT = WS_WUKB + (size_t)65536 * 2;
constexpr size_t WS_GM = WS_WUVT + (size_t)65536 * 2;
constexpr size_t WS_GQ = WS_GM + al256((size_t)RT * 512 * 2);
constexpr size_t WS_GK = WS_GQ + al256((size_t)RT * 256 * 2);
constexpr size_t WS_GV = WS_GK + al256((size_t)RT * 256 * 2);
constexpr size_t WS_GG = WS_GV + al256((size_t)RT * 512 * 2);
constexpr size_t WS_LAB = WS_GG + al256((size_t)RT * 512 * 2);
constexpr size_t WS_BT = WS_LAB + al256((size_t)RT * 256 * 4);
constexpr size_t WS_GKT = WS_BT + (size_t)NB * 4 * 64 * 2048 * 4;
constexpr size_t WS_GVT = WS_GKT + (size_t)NB * 4 * 64 * 2048 * 2;
constexpr size_t WS_Q = WS_GVT + (size_t)NB * 4 * 128 * 2048 * 2;
constexpr size_t WS_KN = WS_Q + (size_t)NB * 8 * 2048 * 96 * 2;
constexpr size_t WS_KR = WS_KN + (size_t)NB * 8 * 2048 * 64 * 2;
constexpr size_t WS_VT = WS_KR + (size_t)NB * 2048 * 32 * 2;
constexpr size_t WS_AO = WS_VT + (size_t)NB * 8 * 64 * 2048 * 2;
constexpr size_t WS_ST2 = WS_AO + (size_t)NTOK * 512 * 2;
constexpr size_t WS_BL = WS_ST2 + (size_t)NB * 4 * 32 * 128 * 64 * 2;
constexpr size_t WS_QLR = WS_BL + (size_t)NB * 4 * 32 * 64 * 4;
constexpr size_t WS_DPART = WS_QLR + al256((size_t)NDEC * 8 * 160 * 2);
constexpr size_t WS_GLAOS = WS_DPART + al256((size_t)NDEC * 4 * 8 * 132 * 4);
constexpr size_t WS_OLAT = WS_GLAOS + al256((size_t)NDEC * 4 * 128 * 4);
constexpr size_t WS_AS = WS_OLAT + al256((size_t)NDEC * 8 * 128 * 2);
constexpr size_t WS_STATS = WS_AS + (size_t)NDEC * 1024 * 2;
constexpr size_t WS_END = WS_STATS + (size_t)8 * NDEC * 2 * 4;

struct Params {
    const float* x_prompt; const float* x_sample; const float* cache_lat; const float* cache_kr; const float* state_gla;
    const int* page_table; const float* c_prompt; const float* c_sample;
    const float* w_ada; const float* b_ada; const float* w_in; const float* q_norm_g; const float* w_uq; const float* kv_norm_g;
    const float* w_uk; const float* w_uv; const float* w_gate_up; const float* b_gate; const float* gla_norm_g;
    const float* w_out; const float* ln_g; const float* ln_b;
    float* out; unsigned char* ws;
};

__device__ __forceinline__ f32x16 mfma32(bf16x8 a, bf16x8 b, f32x16 c) { return __builtin_amdgcn_mfma_f32_32x32x16_bf16(a, b, c, 0, 0, 0); }
__device__ __forceinline__ unsigned pk2(float lo, float hi) { bf16x2 v = {(__bf16)lo, (__bf16)hi}; return __builtin_bit_cast(unsigned, v); }
__device__ __forceinline__ u32x2 pk4(float a, float b, float c, float d) { u32x2 r; r.x = pk2(a, b); r.y = pk2(c, d); return r; }
__device__ __forceinline__ float bflo(unsigned u) { return __builtin_bit_cast(float, u << 16); }
__device__ __forceinline__ float bfhi(unsigned u) { return __builtin_bit_cast(float, u & 0xffff0000u); }
__device__ __forceinline__ float siluf(float x) { return x * __builtin_amdgcn_rcpf(1.f + __expf(-x)); }
__device__ __forceinline__ float ex2(float x) { return __builtin_amdgcn_exp2f(x); }
__device__ __forceinline__ float wave_sum(float v) {
#pragma unroll
    for (int o = 1; o < 64; o <<= 1) v += __shfl_xor(v, o);
    return v;
}
__device__ __forceinline__ bf16x8 cvt8(f32x4 a, f32x4 b) {
    bf16x8 r; r[0] = (__bf16)a[0]; r[1] = (__bf16)a[1]; r[2] = (__bf16)a[2]; r[3] = (__bf16)a[3]; r[4] = (__bf16)b[0]; r[5] = (__bf16)b[1]; r[6] = (__bf16)b[2]; r[7] = (__bf16)b[3]; return r;
}
__device__ __forceinline__ void unpack8(u32x4 u, float (&f)[8]) {
    f[0] = bflo(u.x); f[1] = bfhi(u.x); f[2] = bflo(u.y); f[3] = bfhi(u.y); f[4] = bflo(u.z); f[5] = bfhi(u.z); f[6] = bflo(u.w); f[7] = bfhi(u.w);
}
__device__ __forceinline__ int permpos(int s) { return (s & ~12) | ((s & 4) << 1) | ((s & 8) >> 1); }

#define XB_TMO      128
#define XB_XCNT(j)  (256  + 64 * (j))
#define XB_XSUB(j)  (1280 + 64 * (j))
#define XB_XGEN(j)  (2304 + 64 * (j))
#define XB_TOP      3328
#define XB_TOPGEN   3392
#define XCD_BAR_WORDS 3456
#define CW_Q2 3520
#define CW_Q3 3584
#define CW_SAMPLE 3648
#define CW_AS 3712
#define CW_COL 3776
#define XB_SPIN_CAP (1u << 22)
#define LAS __attribute__((address_space(3)))
__device__ __forceinline__ unsigned xb_ld(unsigned* p)              { return __hip_atomic_load(p, __ATOMIC_RELAXED, __HIP_MEMORY_SCOPE_AGENT); }
__device__ __forceinline__ unsigned xb_add(unsigned* p, unsigned v) { return __hip_atomic_fetch_add(p, v, __ATOMIC_RELAXED, __HIP_MEMORY_SCOPE_AGENT); }
__device__ __forceinline__ unsigned xb_xcc_id() { return (unsigned)__builtin_amdgcn_s_getreg((3 << 11) | 20) & 0xFu; }
#define XB_SPIN(cond, bar) do { unsigned _sp = 0; while (cond) { __builtin_amdgcn_s_sleep(1); \
    if ((++_sp & 255u) == 0u) { if (xb_ld(&(bar)[XB_TMO])) break; if (_sp > XB_SPIN_CAP) { atomicAdd(&(bar)[XB_TMO], 1u); break; } } } } while (0)
struct XcdBarrier { unsigned* bar; unsigned x; volatile LAS unsigned* st; };
__device__ __forceinline__ XcdBarrier xcd_barrier_post(unsigned* bar, volatile LAS unsigned* st) {
    XcdBarrier b; b.bar = bar; b.x = xb_xcc_id(); b.st = st;
    if (threadIdx.x == 0) (void)xb_add(&bar[XB_XCNT(b.x)], 1u);
    return b;
}
__device__ __forceinline__ void xcd_barrier_complete(unsigned* bar, unsigned x, unsigned& nloc, unsigned& nx) {
    const unsigned G = gridDim.x * gridDim.y * gridDim.z;
    unsigned sum, cnt, mine, sp = 0u;
    for (;;) {
        sum = 0u; cnt = 0u; mine = 0u;
#pragma unroll
        for (unsigned j = 0; j < 16; ++j) { const unsigned c = xb_ld(&bar[XB_XCNT(j)]); sum += c; cnt += (c > 0u) ? 1u : 0u; mine = (j == x) ? c : mine; }
        if (sum == G) break;
        __builtin_amdgcn_s_sleep(1);
        if ((++sp & 255u) == 0u) { if (xb_ld(&bar[XB_TMO])) break; if (sp > XB_SPIN_CAP) { atomicAdd(&bar[XB_TMO], 1u); break; } }
    }
    nloc = mine > 0u ? mine : 1u; nx = cnt > 0u ? cnt : 1u;
}
__device__ __forceinline__ void xcd_barrier(const XcdBarrier& b) {
    asm volatile("s_waitcnt vmcnt(0)" ::: "memory");
    __syncthreads();
    if (threadIdx.x == 0) {
        unsigned* bar = b.bar;
        __builtin_amdgcn_s_waitcnt(0);
        unsigned nloc = b.st[0], nx = b.st[1];
        if (nloc == 0u) { xcd_barrier_complete(bar, b.x, nloc, nx); b.st[0] = nloc; b.st[1] = nx; }
        const unsigned old = xb_add(&bar[XB_XSUB(b.x)], 1u);
        const unsigned gen = old / nloc;
        if (old + 1u == (gen + 1u) * nloc) {
            __builtin_amdgcn_fence(__ATOMIC_RELEASE, "agent");
            asm volatile("s_waitcnt vmcnt(0)" ::: "memory");
            const unsigned og = xb_add(&bar[XB_TOP], 1u);
            const unsigned tg = og / nx;
            if (og + 1u == (tg + 1u) * nx) xb_add(&bar[XB_TOPGEN], 1u);
            else XB_SPIN(xb_ld(&bar[XB_TOPGEN]) == tg, bar);
            __builtin_amdgcn_fence(__ATOMIC_ACQUIRE, "agent");
            xb_add(&bar[XB_XGEN(b.x)], 1u);
            asm volatile("s_waitcnt vmcnt(0)" ::: "memory");
        } else {
            XB_SPIN(xb_ld(&bar[XB_XGEN(b.x)]) == gen, bar);
            __builtin_amdgcn_fence(__ATOMIC_ACQUIRE, "agent");
            asm volatile("s_waitcnt vmcnt(0)" ::: "memory");
        }
    }
    __syncthreads();
}

template <int KS, bool SW>
__device__ __forceinline__ void gemm_2x2(const u32x4* __restrict__ wf, const unsigned char* xl, int xstride, int lane, f32x16 (&acc)[2][2]) {
    constexpr int PF = 8;
    static_assert(KS % PF == 0, "KS must be a multiple of the prefetch depth");
    const int l31 = lane & 31, hh = lane >> 5;
    const unsigned char* x0 = xl + l31 * xstride + hh * 16;
    const unsigned char* x1 = x0 + 32 * xstride;
    const u32x4* w0 = wf + lane;
    const u32x4* w1 = wf + KS * 64 + lane;
    u32x4 ra[PF], rb[PF];
#pragma unroll
    for (int u = 0; u < PF; ++u) { ra[u] = w0[u * 64]; rb[u] = w1[u * 64]; }
#pragma unroll 1
    for (int k0 = 0; k0 < KS; k0 += PF) {
#pragma unroll
        for (int u = 0; u < PF; ++u) {
            const int ks = k0 + u;
            const bf16x8 b0 = *(const bf16x8*)(x0 + ks * 32);
            const bf16x8 b1 = *(const bf16x8*)(x1 + ks * 32);
            const bf16x8 a0 = __builtin_bit_cast(bf16x8, ra[u]);
            const bf16x8 a1 = __builtin_bit_cast(bf16x8, rb[u]);
            if (KS > PF) { ra[u] = w0[(ks + PF) * 64]; rb[u] = w1[(ks + PF) * 64]; }
            __builtin_amdgcn_sched_barrier(0);
            if (SW) {
                acc[0][0] = mfma32(a0, b0, acc[0][0]); acc[0][1] = mfma32(a0, b1, acc[0][1]);
                acc[1][0] = mfma32(a1, b0, acc[1][0]); acc[1][1] = mfma32(a1, b1, acc[1][1]);
            } else {
                acc[0][0] = mfma32(b0, a0, acc[0][0]); acc[0][1] = mfma32(b1, a0, acc[0][1]);
                acc[1][0] = mfma32(b0, a1, acc[1][0]); acc[1][1] = mfma32(b1, a1, acc[1][1]);
            }
            __builtin_amdgcn_sched_barrier(0);
        }
    }
}
constexpr int GPF = 8;
template <int KS, bool SW>
__device__ __forceinline__ void gemm_2x2_stream(const u32x4* __restrict__ wf, const u32x4* __restrict__ wfn, bool fill, const unsigned char* xl, int xstride, int lane,
                                                f32x16 (&acc)[2][2], u32x4 (&ra)[GPF], u32x4 (&rb)[GPF]) {
    static_assert(KS % GPF == 0 && KS >= 2 * GPF, "KS must be a multiple of (and larger than) the prefetch depth");
    const int l31 = lane & 31, hh = lane >> 5;
    const unsigned char* x0 = xl + l31 * xstride + hh * 16;
    const unsigned char* x1 = x0 + 32 * xstride;
    const u32x4* w0 = wf + lane;
    const u32x4* w1 = wf + KS * 64 + lane;
    if (fill) {
#pragma unroll
        for (int u = 0; u < GPF; ++u) { ra[u] = w0[u * 64]; rb[u] = w1[u * 64]; }
    }
    bf16x8 b0 = *(const bf16x8*)(x0), b1 = *(const bf16x8*)(x1);
#pragma unroll 1
    for (int k0 = 0; k0 < KS; k0 += GPF) {
        const bool last = (k0 + GPF >= KS);
        const u32x4* n0 = last ? (wfn + lane) : (w0 + (k0 + GPF) * 64);
        const u32x4* n1 = last ? (wfn + KS * 64 + lane) : (w1 + (k0 + GPF) * 64);
#pragma unroll
        for (int u = 0; u < GPF; ++u) {
            const int ks = k0 + u;
            const bf16x8 nb0 = *(const bf16x8*)(x0 + (ks + 1) * 32);
            const bf16x8 nb1 = *(const bf16x8*)(x1 + (ks + 1) * 32);
            const bf16x8 a0 = __builtin_bit_cast(bf16x8, ra[u]);
            const bf16x8 a1 = __builtin_bit_cast(bf16x8, rb[u]);
            ra[u] = n0[u * 64]; rb[u] = n1[u * 64];
            __builtin_amdgcn_sched_barrier(0);
            if (SW) {
                acc[0][0] = mfma32(a0, b0, acc[0][0]); acc[0][1] = mfma32(a0, b1, acc[0][1]);
                acc[1][0] = mfma32(a1, b0, acc[1][0]); acc[1][1] = mfma32(a1, b1, acc[1][1]);
            } else {
                acc[0][0] = mfma32(b0, a0, acc[0][0]); acc[0][1] = mfma32(b1, a0, acc[0][1]);
                acc[1][0] = mfma32(b0, a1, acc[1][0]); acc[1][1] = mfma32(b1, a1, acc[1][1]);
            }
            __builtin_amdgcn_sched_barrier(0);
            b0 = nb0; b1 = nb1;
        }
    }
}
__device__ __forceinline__ void zero_acc(f32x16 (&acc)[2][2]) {
#pragma unroll
    for (int a = 0; a < 2; ++a)
#pragma unroll
        for (int b = 0; b < 2; ++b)
#pragma unroll
            for (int r = 0; r < 16; ++r) acc[a][b][r] = 0.f;
}
template <int MODE>
__device__ __forceinline__ void store_nat(const f32x16 (&acc)[2][2], __bf16* dst, int ld, int col0, int lane) {
    const int l31 = lane & 31, hh = lane >> 5;
#pragma unroll
    for (int nt = 0; nt < 2; ++nt)
#pragma unroll
        for (int mt = 0; mt < 2; ++mt)
#pragma unroll
            for (int g = 0; g < 4; ++g) {
                float v[4];
#pragma unroll
                for (int i = 0; i < 4; ++i) {
                    float t = acc[nt][mt][4 * g + i];
                    if (MODE == 1) t = siluf(t);
                    if (MODE == 2) t *= 0.125f;
                    if (MODE == 3) t *= QSCALE;
                    v[i] = t;
                }
                *(u32x2*)(dst + (size_t)(32 * mt + l31) * ld + col0 + 32 * nt + 8 * g + 4 * hh) = pk4(v[0], v[1], v[2], v[3]);
            }
}
__device__ __forceinline__ void store_tr(const f32x16 (&acc)[2][2], __bf16* dst, int group, int NT, int rowtile0, int s0, int lane) {
#pragma unroll
    for (int nt = 0; nt < 2; ++nt)
#pragma unroll
        for (int mt = 0; mt < 2; ++mt)
#pragma unroll
            for (int g = 0; g < 4; ++g) {
                const int k16 = (s0 >> 4) + 2 * mt + (g >> 1);
                *(u32x2*)(dst + ((((size_t)group * 128 + k16) * NT + rowtile0 + nt) * 64 + lane) * 8 + 4 * (g & 1)) =
                    pk4(acc[nt][mt][4 * g], acc[nt][mt][4 * g + 1], acc[nt][mt][4 * g + 2], acc[nt][mt][4 * g + 3]);
            }
}

__device__ __forceinline__ int win_col(int np) {
    if (np < 384) return np;
    if (np < 896) return 416 + (np - 384);
    if (np < 1152) return 928 + (np - 896);
    if (np < 1408) return 1184 + (np - 1152);
    if (np < 1920) return 1440 + (np - 1408);
    if (np < 2432) return 1968 + (np - 1920);
    if (np < 2464) return 384 + (np - 2432);
    if (np < 2480) return 1952 + (np - 2464);
    return -1;
}
__device__ void p0_mod_item(const Params& p, int item, unsigned char* lds) {
    int tid = threadIdx.x; asm volatile("" : "+v"(tid));
    const int lane = tid & 63, w = tid >> 6, l31 = lane & 31, hh = lane >> 5;
    const int n0 = item * 32;
    float* mod = (float*)(p.ws + WS_MOD);
    f32x16 acc[5];
#pragma unroll
    for (int m = 0; m < 5; ++m)
#pragma unroll
        for (int r = 0; r < 16; ++r) acc[m][r] = 0.f;
    float aN[8]; f32x4 c0N[5], c1N[5];
    const float* cp[5];
#pragma unroll
    for (int m = 0; m < 5; ++m) { const int row = min(32 * m + l31, 135); cp[m] = (row < 8) ? (p.c_prompt + (size_t)row * 1024) : (p.c_sample + (size_t)(row - 8) * 1024); }
#define MOD_LOAD(k8_) do { const int k0_ = 16 * (8 * w + (k8_)) + 8 * hh; \
        _Pragma("unroll") for (int j = 0; j < 8; ++j) aN[j] = p.w_ada[(size_t)(k0_ + j) * 3072 + n0 + l31]; \
        _Pragma("unroll") for (int m = 0; m < 5; ++m) { c0N[m] = *(const f32x4*)(cp[m] + k0_); c1N[m] = *(const f32x4*)(cp[m] + k0_ + 4); } } while (0)
    MOD_LOAD(0);
#pragma unroll 1
    for (int k8 = 0; k8 < 8; ++k8) {
        float aC[8]; f32x4 c0C[5], c1C[5];
#pragma unroll
        for (int j = 0; j < 8; ++j) aC[j] = aN[j];
#pragma unroll
        for (int m = 0; m < 5; ++m) { c0C[m] = c0N[m]; c1C[m] = c1N[m]; }
        MOD_LOAD(k8 < 7 ? k8 + 1 : 7);
        __builtin_amdgcn_sched_barrier(0);
        bf16x8 a;
#pragma unroll
        for (int j = 0; j < 8; ++j) a[j] = (__bf16)aC[j];
#pragma unroll
        for (int m = 0; m < 5; ++m) {
            bf16x8 bq;
            const bool live = (32 * m + l31) < 136;
#pragma unroll
            for (int j = 0; j < 4; ++j) { bq[j] = (__bf16)(live ? siluf(c0C[m][j]) : 0.f); bq[4 + j] = (__bf16)(live ? siluf(c1C[m][j]) : 0.f); }
            acc[m] = mfma32(a, bq, acc[m]);
        }
        __builtin_amdgcn_sched_barrier(0);
    }
#undef MOD_LOAD
    float* red = (float*)(lds + LDS_BASE);
#pragma unroll
    for (int m = 0; m < 5; ++m) {
#pragma unroll
        for (int r = 0; r < 16; ++r) red[(w * 16 + r) * 64 + lane] = acc[m][r];
        __syncthreads();
#pragma unroll
        for (int q = 0; q < 2; ++q) {
            const int o = tid + 512 * q, r = o >> 6, ln = o & 63;
            float s = 0.f;
#pragma unroll
            for (int ww = 0; ww < 8; ++ww) s += red[(ww * 16 + r) * 64 + ln];
            const int n = n0 + (r & 3) + 8 * (r >> 2) + 4 * (ln >> 5), row = 32 * m + (ln & 31);
            if (row < 136) mod[(size_t)row * 3072 + n] = s + p.b_ada[n];
        }
        __syncthreads();
    }
}
__device__ void p0_convert(const Params& p) {
    int tid0 = threadIdx.x; asm volatile("" : "+v"(tid0));
    const int nmod = (gridDim.x > 128) ? 96 : 0;
    if ((int)blockIdx.x < nmod) return;
    const int gt = ((int)blockIdx.x - nmod) * NTHR + tid0, GT = ((int)gridDim.x - nmod) * NTHR;
    u32x4* winf = (u32x4*)(p.ws + WS_WINF);
    for (int idx = gt; idx < 78 * 64 * 64; idx += GT) {
        const int lane = idx & 63, fk = idx >> 6, ks = fk & 63, nt = fk >> 6;
        const int col = win_col(nt * 32 + (lane & 31)), k0 = ks * 16 + 8 * (lane >> 5);
        float v[8];
#pragma unroll
        for (int j = 0; j < 8; ++j) v[j] = (col >= 0) ? p.w_in[(size_t)(k0 + j) * 2480 + col] : 0.f;
        u32x4 o; o.x = pk2(v[0], v[1]); o.y = pk2(v[2], v[3]); o.z = pk2(v[4], v[5]); o.w = pk2(v[6], v[7]);
        winf[idx] = o;
    }
    u32x4* wuqf = (u32x4*)(p.ws + WS_WUQF);
    for (int idx = gt; idx < 24 * 16 * 64; idx += GT) {
        const int lane = idx & 63, fk = idx >> 6, ks = fk & 15, nt = fk >> 4;
        const int n = nt * 32 + (lane & 31), k0 = ks * 16 + 8 * (lane >> 5);
        float v[8];
#pragma unroll
        for (int j = 0; j < 8; ++j) v[j] = p.w_uq[(size_t)(k0 + j) * 768 + n];
        u32x4 o; o.x = pk2(v[0], v[1]); o.y = pk2(v[2], v[3]); o.z = pk2(v[4], v[5]); o.w = pk2(v[6], v[7]);
        wuqf[idx] = o;
    }
    u32x4* wkvf = (u32x4*)(p.ws + WS_WKVF);
    for (int idx = gt; idx < 32 * 8 * 64; idx += GT) {
        const int lane = idx & 63, fk = idx >> 6, ks = fk & 7, nt = fk >> 3;
        const int n = nt * 32 + (lane & 31), k0 = ks * 16 + 8 * (lane >> 5);
        float v[8];
#pragma unroll
        for (int j = 0; j < 8; ++j) v[j] = (n < 512) ? p.w_uk[(size_t)(k0 + j) * 512 + n] : p.w_uv[(size_t)(k0 + j) * 512 + (n - 512)];
        u32x4 o; o.x = pk2(v[0], v[1]); o.y = pk2(v[2], v[3]); o.z = pk2(v[4], v[5]); o.w = pk2(v[6], v[7]);
        wkvf[idx] = o;
    }
    u32x4* woutf = (u32x4*)(p.ws + WS_WOUTF);
    for (int idx = gt; idx < 32 * 64 * 64; idx += GT) {
        const int lane = idx & 63, fk = idx >> 6, ks = fk & 63, nt = fk >> 6;
        const int n = nt * 32 + (lane & 31), k0 = ks * 16 + 8 * (lane >> 5);
        float v[8];
#pragma unroll
        for (int j = 0; j < 8; ++j) v[j] = p.w_out[(size_t)(k0 + j) * 1024 + n];
        u32x4 o; o.x = pk2(v[0], v[1]); o.y = pk2(v[2], v[3]); o.z = pk2(v[4], v[5]); o.w = pk2(v[6], v[7]);
        woutf[idx] = o;
    }
    __bf16* wukb = (__bf16*)(p.ws + WS_WUKB);
    __bf16* wuvt = (__bf16*)(p.ws + WS_WUVT);
    for (int idx = gt; idx < 65536; idx += GT) {
        wukb[idx] = (__bf16)p.w_uk[idx];
        const int r = idx & 127, v = (idx >> 7) & 63, h = idx >> 13;
        wuvt[idx] = (__bf16)p.w_uv[(size_t)r * 512 + h * 64 + v];
    }
    float* rope = (float*)(p.ws + WS_ROPE);
    for (int idx = gt; idx < 2049 * 16; idx += GT) {
        const int pi = idx >> 4, i = idx & 15;
        const float pos = (pi == 2048) ? 8192.f : (float)pi;
        const float inv = __builtin_amdgcn_exp2f(-(float)(2 * i) * (13.287712379549449f / 32.f));
        const double rev = (double)(pos * inv) * 0.15915494309189535;
        const float fr = (float)(rev - floor(rev));
        const float s = __builtin_amdgcn_sinf(fr), c = __builtin_amdgcn_cosf(fr);
        rope[pi * 32 + i] = c; rope[pi * 32 + 16 + i] = s;
    }
}

constexpr int XS = 2064;
constexpr int ZS = 1808;

__device__ __forceinline__ void p1_post(const Params& p, int it, unsigned char* lds);
__device__ void p1_stripe(const Params& p, int it, int mode, unsigned char* lds) {
    int tid = threadIdx.x; asm volatile("" : "+v"(tid));
    const int lane = tid & 63, w = tid >> 6, l31 = lane & 31, hh = lane >> 5;
    const bool is_s = it >= 256;
    const int srow0 = is_s ? (it - 256) * 64 : 0;
    const int tok0 = is_s ? NTOK + srow0 : it * 64;
    const int b = it >> 5, s0 = (it & 31) * 64;
    unsigned char* A = lds + LDS_BASE;
    const float* mod = (const float*)(p.ws + WS_MOD);
    const float* rope = (const float*)(p.ws + WS_ROPE);
    {
        const int c4 = tid & 255, rb = tid >> 8;
        if (!is_s) {
            const f32x4 sh = *(const f32x4*)(mod + (size_t)b * 3072 + 4 * c4);
            const f32x4 sc = *(const f32x4*)(mod + (size_t)b * 3072 + 1024 + 4 * c4);
            const float* xr = p.x_prompt + (size_t)(it * 64 + rb) * 1024 + 4 * c4;
            {
                f32x4 x[32];
#pragma unroll
                for (int u = 0; u < 32; ++u) x[u] = *(const f32x4*)(xr + (size_t)u * 2048);
                __builtin_amdgcn_sched_barrier(0);
#pragma unroll
                for (int u = 0; u < 32; ++u)
                    *(u32x2*)(A + (2 * u + rb) * XS + c4 * 8) = pk4(x[u][0] * (1.f + sc[0]) + sh[0], x[u][1] * (1.f + sc[1]) + sh[1], x[u][2] * (1.f + sc[2]) + sh[2], x[u][3] * (1.f + sc[3]) + sh[3]);
            }
        } else {
#pragma unroll 1
            for (int i0 = 0; i0 < 32; i0 += 4) {
                f32x4 x[4], sh[4], sc[4];
#pragma unroll
                for (int u = 0; u < 4; ++u) {
                    const int row = 2 * (i0 + u) + rb;
                    x[u] = *(const f32x4*)(p.x_sample + (size_t)(srow0 + row) * 1024 + 4 * c4);
                    sh[u] = *(const f32x4*)(mod + (size_t)(8 + srow0 + row) * 3072 + 4 * c4);
                    sc[u] = *(const f32x4*)(mod + (size_t)(8 + srow0 + row) * 3072 + 1024 + 4 * c4);
                }
                __builtin_amdgcn_sched_barrier(0);
#pragma unroll
                for (int u = 0; u < 4; ++u)
                    *(u32x2*)(A + (2 * (i0 + u) + rb) * XS + c4 * 8) = pk4(x[u][0] * (1.f + sc[u][0]) + sh[u][0], x[u][1] * (1.f + sc[u][1]) + sh[u][1], x[u][2] * (1.f + sc[u][2]) + sh[u][2], x[u][3] * (1.f + sc[u][3]) + sh[u][3]);
            }
        }
    }
    __syncthreads();
    const u32x4* winf = (const u32x4*)(p.ws + WS_WINF);
    __bf16* GM = (__bf16*)(p.ws + WS_GM); __bf16* GQ = (__bf16*)(p.ws + WS_GQ); __bf16* GK = (__bf16*)(p.ws + WS_GK);
    __bf16* GV = (__bf16*)(p.ws + WS_GV); __bf16* GG = (__bf16*)(p.ws + WS_GG);
    __bf16* GKT = (__bf16*)(p.ws + WS_GKT); __bf16* GVT = (__bf16*)(p.ws + WS_GVT);
    f32x16 acc[2][2];
    u32x4 ringa[GPF], ringb[GPF];
    const int sst = (w < 6) ? w : 38;
    bool fill = true;
#pragma unroll 1
    for (int i = 0; i < 4; ++i) {
        if (mode == 1 || (mode >= 2 && i != mode - 2)) continue;
        const int st = 6 + w + 8 * i;
        const int stn = (mode == 0) ? ((i < 3) ? st + 8 : ((w < 7) ? sst : st)) : st;
        zero_acc(acc);
        const bool tr = (!is_s) && (st >= 22 && st < 30);
        if (tr) gemm_2x2_stream<64, false>(winf + (size_t)st * 2 * 64 * 64, winf + (size_t)stn * 2 * 64 * 64, fill, A, XS, lane, acc, ringa, ringb);
        else    gemm_2x2_stream<64, true >(winf + (size_t)st * 2 * 64 * 64, winf + (size_t)stn * 2 * 64 * 64, fill, A, XS, lane, acc, ringa, ringb);
        fill = (mode != 0);
        int lane2 = lane; asm volatile("" : "+v"(lane2));
        if (st < 14) store_nat<1>(acc, GM + (size_t)tok0 * 512, 512, (st - 6) * 64, lane2);
        else if (st < 18) store_nat<2>(acc, GQ + (size_t)tok0 * 256, 256, (st - 14) * 64, lane2);
        else if (st < 22) {
            store_nat<0>(acc, GK + (size_t)tok0 * 256, 256, (st - 18) * 64, lane2);
            if (!is_s) {
                const int l31b = lane2 & 31, hhb = lane2 >> 5;
                __bf16* gb = GKT + ((((size_t)(b * 4 + (st - 18)) * 128 + (s0 >> 4) + (l31b >> 4)) * 2) * 64 + 32 * ((l31b >> 2) & 1) + 4 * hhb) * 8 + 4 * ((l31b >> 3) & 1) + (l31b & 3);
#pragma unroll
                for (int mt = 0; mt < 2; ++mt)
#pragma unroll
                    for (int nt = 0; nt < 2; ++nt)
#pragma unroll
                        for (int r = 0; r < 16; ++r)
                            gb[(size_t)mt * 2 * 2 * 512 + nt * 512 + ((r & 3) + 8 * (r >> 2)) * 8] = (__bf16)acc[nt][mt][r];
            }
        } else if (st < 30) {
            if (tr) store_tr(acc, GVT, b * 4 + ((st - 22) >> 1), 4, ((st - 22) & 1) * 2, s0, lane2);
            else store_nat<0>(acc, GV + (size_t)tok0 * 512, 512, (st - 22) * 64, lane2);
        } else store_nat<1>(acc, GG + (size_t)tok0 * 512, 512, (st - 30) * 64, lane2);
    }
    if (mode >= 2) { __syncthreads(); return; }
    if (w < 7) { zero_acc(acc); gemm_2x2_stream<64, true>(winf + (size_t)sst * 2 * 64 * 64, winf + (size_t)sst * 2 * 64 * 64, fill, A, XS, lane, acc, ringa, ringb); }
    __syncthreads();
    unsigned char* Z = A;
    if (w < 7) {
        const int cb = (w < 4) ? 64 * w : (w < 6 ? 256 + 64 * (w - 4) : 384);
#pragma unroll
        for (int nt = 0; nt < 2; ++nt)
#pragma unroll
            for (int mt = 0; mt < 2; ++mt)
#pragma unroll
                for (int g = 0; g < 4; ++g) {
                    f32x4 v = {acc[nt][mt][4 * g], acc[nt][mt][4 * g + 1], acc[nt][mt][4 * g + 2], acc[nt][mt][4 * g + 3]};
                    *(f32x4*)(Z + (32 * mt + l31) * ZS + (cb + 32 * nt + 8 * g + 4 * hh) * 4) = v;
                }
    }
    __syncthreads();
    p1_post(p, it, lds);
}

__device__ __forceinline__ void p1_post(const Params& p, int it, unsigned char* lds) {
    int tid = threadIdx.x; asm volatile("" : "+v"(tid));
    const int lane = tid & 63, w = tid >> 6, l31 = lane & 31, hh = lane >> 5;
    const bool is_s = it >= 256;
    const int srow0 = is_s ? (it - 256) * 64 : 0;
    const int tok0 = is_s ? NTOK + srow0 : it * 64;
    const int b = it >> 5, s0 = (it & 31) * 64;
    unsigned char* Z = lds + LDS_BASE;
    const float* rope = (const float*)(p.ws + WS_ROPE);
    f32x16 acc[2][2];
    float* latout = p.out + (is_s ? OUT_LATS + (size_t)srow0 * 128 : OUT_LATP + (size_t)it * 64 * 128);
    for (int rr = 0; rr < 8; ++rr) {
        const int row = 8 * w + rr;
        unsigned char* zr = Z + row * ZS;
        const f32x4 v = *(const f32x4*)(zr + 16 * lane);
        const float ss = wave_sum(v[0] * v[0] + v[1] * v[1] + v[2] * v[2] + v[3] * v[3]);
        const float inv = rsqrtf(ss * (1.f / 256.f) + NORM_EPS);
        const f32x4 g = *(const f32x4*)(p.q_norm_g + 4 * lane);
        const f32x2 c = *(const f32x2*)(zr + 1024 + 8 * lane);
        const float ss2 = wave_sum(c[0] * c[0] + c[1] * c[1]);
        const float inv2 = rsqrtf(ss2 * (1.f / 128.f) + NORM_EPS);
        const f32x2 g2 = *(const f32x2*)(p.kv_norm_g + 2 * lane);
        const float y0 = c[0] * inv2 * g2[0], y1 = c[1] * inv2 * g2[1];
        *(u32x2*)(zr + 8 * lane) = pk4(v[0] * inv * g[0], v[1] * inv * g[1], v[2] * inv * g[2], v[3] * inv * g[3]);
        *(unsigned*)(zr + 1024 + 4 * lane) = pk2(y0, y1);
        f32x2 yo = {y0, y1};
        *(f32x2*)(latout + (size_t)row * 128 + 2 * lane) = yo;
    }
    {
        float* krout = p.out + (is_s ? OUT_KRS + (size_t)srow0 * 32 : OUT_KRP + (size_t)it * 64 * 32);
        __bf16* KR = (__bf16*)(p.ws + WS_KR);
#pragma unroll
        for (int q = 0; q < 2; ++q) {
            const int idx = tid + NTHR * q, row = idx >> 4, i = idx & 15;
            const float* zr = (const float*)(Z + row * ZS);
            const float x1 = zr[384 + i], x2 = zr[400 + i];
            const int pi = is_s ? 2048 : s0 + row;
            const float cs = rope[pi * 32 + i], sn = rope[pi * 32 + 16 + i];
            const float o1 = x1 * cs - x2 * sn, o2 = x2 * cs + x1 * sn;
            krout[row * 32 + i] = o1; krout[row * 32 + 16 + i] = o2;
            if (!is_s) { KR[((size_t)b * 2048 + s0 + row) * 32 + i] = (__bf16)o1; KR[((size_t)b * 2048 + s0 + row) * 32 + 16 + i] = (__bf16)o2; }
        }
    }
    {
        const int n = 32 * w + l31, h = w >> 1, dk = 32 * (w & 1) + l31;
        bf16x8 wb;
#pragma unroll
        for (int e = 0; e < 8; ++e) wb[e] = (__bf16)p.w_gate_up[(8 * hh + e) * 256 + n];
        const float bg = p.b_gate[n];
        f32x16 la[2];
#pragma unroll
        for (int mt = 0; mt < 2; ++mt) {
            const float* zr = (const float*)(Z + (32 * mt + l31) * ZS);
            const bf16x8 ga = cvt8(*(const f32x4*)(zr + 416 + 8 * hh), *(const f32x4*)(zr + 420 + 8 * hh));
#pragma unroll
            for (int r = 0; r < 16; ++r) la[mt][r] = 0.f;
            la[mt] = mfma32(ga, wb, la[mt]);
#pragma unroll
            for (int r = 0; r < 16; ++r) { const float a = la[mt][r] + bg; la[mt][r] = (fminf(a, 0.f) - __logf(1.f + __expf(-fabsf(a)))) * (1.f / 16.f); }
        }
        if (!is_s) {
            float carry = 0.f;
#pragma unroll
            for (int mt = 0; mt < 2; ++mt) {
                float bs[4], ps[4];
#pragma unroll
                for (int g = 0; g < 4; ++g) { bs[g] = (la[mt][4 * g] + la[mt][4 * g + 1]) + (la[mt][4 * g + 2] + la[mt][4 * g + 3]); ps[g] = __shfl_xor(bs[g], 32); }
#pragma unroll
                for (int g = 0; g < 4; ++g) {
                    const float b0s = hh ? ps[g] : bs[g], b1s = hh ? bs[g] : ps[g];
                    float run = carry + (hh ? b0s : 0.f);
#pragma unroll
                    for (int i = 0; i < 4; ++i) { run += la[mt][4 * g + i]; la[mt][4 * g + i] = run; }
                    carry += b0s + b1s;
                }
            }
        }
        float* LAB = (float*)(p.ws + WS_LAB) + (size_t)tok0 * 256 + n;
#pragma unroll
        for (int mt = 0; mt < 2; ++mt)
#pragma unroll
            for (int r = 0; r < 16; ++r) LAB[(size_t)(32 * mt + (r & 3) + 8 * (r >> 2) + 4 * hh) * 256] = la[mt][r];
        if (!is_s) {
            float* BT = (float*)(p.ws + WS_BT);
#pragma unroll
            for (int mt = 0; mt < 2; ++mt)
#pragma unroll
                for (int g = 0; g < 4; ++g) {
                    const int k16 = (s0 >> 4) + 2 * mt + (g >> 1);
                    f32x4 v = {la[mt][4 * g], la[mt][4 * g + 1], la[mt][4 * g + 2], la[mt][4 * g + 3]};
                    *(f32x4*)(BT + ((((size_t)(b * 4 + h) * 128 + k16) * 2 + (w & 1)) * 64 + lane) * 8 + 4 * (g & 1)) = v;
                }
            if (hh) ((float*)(p.ws + WS_BL))[((size_t)(b * 4 + h) * 32 + (s0 >> 6)) * 64 + dk] = la[1][15];
        }
    }
    __syncthreads();
    {
        const u32x4* wuqf = (const u32x4*)(p.ws + WS_WUQF);
        const int h = w;
        const unsigned char* x0 = Z + l31 * ZS + hh * 16;
        const unsigned char* x1 = x0 + 32 * ZS;
        const int qoff = (h < 4) ? 512 + 128 * h : 1280 + 128 * (h - 4);
        __bf16* QLR = (__bf16*)(p.ws + WS_QLR);
        __bf16* Q = (__bf16*)(p.ws + WS_Q) + ((size_t)(b * 8 + h) * 2048 + s0) * 96;
#pragma unroll 1
        for (int j = 0; j < 3; ++j) {
            f32x16 q[2];
#pragma unroll
            for (int m = 0; m < 2; ++m)
#pragma unroll
                for (int r = 0; r < 16; ++r) q[m][r] = 0.f;
            const u32x4* wq = wuqf + (size_t)(3 * h + j) * 16 * 64 + lane;
            u32x4 rq[16];
#pragma unroll
            for (int ks = 0; ks < 16; ++ks) rq[ks] = wq[ks * 64];
            __builtin_amdgcn_sched_barrier(0);
#pragma unroll
            for (int ks = 0; ks < 16; ++ks) {
                const bf16x8 a = __builtin_bit_cast(bf16x8, rq[ks]);
                const bf16x8 b0 = *(const bf16x8*)(x0 + ks * 32), b1 = *(const bf16x8*)(x1 + ks * 32);
                q[0] = mfma32(a, b0, q[0]); q[1] = mfma32(a, b1, q[1]);
            }
            if (j == 2) {
#pragma unroll
                for (int m = 0; m < 2; ++m) {
                    const int pi = is_s ? 2048 : s0 + 32 * m + l31;
#pragma unroll
                    for (int g = 0; g < 2; ++g) {
                        const f32x4 cs = *(const f32x4*)(rope + pi * 32 + 8 * g + 4 * hh);
                        const f32x4 sn = *(const f32x4*)(rope + pi * 32 + 16 + 8 * g + 4 * hh);
#pragma unroll
                        for (int i = 0; i < 4; ++i) {
                            const float x1v = q[m][4 * g + i], x2v = q[m][4 * g + 8 + i];
                            q[m][4 * g + i] = x1v * cs[i] - x2v * sn[i];
                            q[m][4 * g + 8 + i] = x2v * cs[i] + x1v * sn[i];
                        }
                    }
                }
            }
#pragma unroll
            for (int m = 0; m < 2; ++m)
#pragma unroll
                for (int g = 0; g < 4; ++g) {
                    const int tok = 32 * m + l31;
                    if (!is_s) {
                        *(u32x2*)(Q + (size_t)tok * 96 + 32 * j + 8 * g + 4 * hh) = pk4(q[m][4 * g] * QSCALE, q[m][4 * g + 1] * QSCALE, q[m][4 * g + 2] * QSCALE, q[m][4 * g + 3] * QSCALE);
                    } else if (j == 2) {
                        *(u32x2*)(QLR + ((size_t)(srow0 + tok) * 8 + h) * 160 + 128 + 8 * g + 4 * hh) = pk4(q[m][4 * g] * QSCALE, q[m][4 * g + 1] * QSCALE, q[m][4 * g + 2] * QSCALE, q[m][4 * g + 3] * QSCALE);
                    } else {
                        *(u32x2*)(Z + tok * ZS + qoff + (32 * j + 8 * g + 4 * hh) * 2) = pk4(q[m][4 * g], q[m][4 * g + 1], q[m][4 * g + 2], q[m][4 * g + 3]);
                    }
                }
        }
        if (is_s) {
            asm volatile("s_waitcnt lgkmcnt(0)" ::: "memory");
            const __bf16* wukb = (const __bf16*)(p.ws + WS_WUKB);
#pragma unroll 1
            for (int rt = 0; rt < 4; ++rt) {
                f32x16 ql[2];
#pragma unroll
                for (int m = 0; m < 2; ++m)
#pragma unroll
                    for (int r = 0; r < 16; ++r) ql[m][r] = 0.f;
#pragma unroll
                for (int ks = 0; ks < 4; ++ks) {
                    const bf16x8 b0 = *(const bf16x8*)(Z + l31 * ZS + qoff + (16 * ks + 8 * hh) * 2);
                    const bf16x8 b1 = *(const bf16x8*)(Z + (32 + l31) * ZS + qoff + (16 * ks + 8 * hh) * 2);
                    const bf16x8 a = *(const bf16x8*)(wukb + ((size_t)(32 * rt + l31) * 8 + h) * 64 + 16 * ks + 8 * hh);
                    ql[0] = mfma32(a, b0, ql[0]); ql[1] = mfma32(a, b1, ql[1]);
                }
#pragma unroll
                for (int m = 0; m < 2; ++m)
#pragma unroll
                    for (int g = 0; g < 4; ++g)
                        *(u32x2*)(QLR + ((size_t)(srow0 + 32 * m + l31) * 8 + h) * 160 + 32 * rt + 8 * g + 4 * hh) =
                            pk4(ql[m][4 * g] * QSCALE, ql[m][4 * g + 1] * QSCALE, ql[m][4 * g + 2] * QSCALE, ql[m][4 * g + 3] * QSCALE);
            }
        }
    }
    if (!is_s) {
        const u32x4* wkvf = (const u32x4*)(p.ws + WS_WKVF);
        __bf16* KN = (__bf16*)(p.ws + WS_KN);
        __bf16* VT = (__bf16*)(p.ws + WS_VT);
#pragma unroll 1
        for (int pp = 0; pp < 2; ++pp) {
            const int nt0 = 4 * w + 2 * pp;
            zero_acc(acc);
            if (w < 4) {
                gemm_2x2<8, true>(wkvf + (size_t)nt0 * 8 * 64, Z + 1024, ZS, lane, acc);
                const int hd = nt0 >> 1;
                store_nat<0>(acc, KN + ((size_t)(b * 8 + hd) * 2048 + s0) * 64, 64, 0, lane);
            } else {
                gemm_2x2<8, false>(wkvf + (size_t)nt0 * 8 * 64, Z + 1024, ZS, lane, acc);
                const int hd = (nt0 - 16) >> 1;
                store_tr(acc, VT, b * 8 + hd, 2, 0, s0, lane);
            }
        }
    }
    __syncthreads();
}

constexpr int KST = 208, VST = 144;
constexpr int KBUF = 64 * KST, VBUF = 8192;

__device__ void p2_attn(const Params& p, int bh, int qb, unsigned char* lds) {
    int tid = threadIdx.x; asm volatile("" : "+v"(tid));
    const int lane = tid & 63, w = tid >> 6, l31 = lane & 31, hh = lane >> 5;
    const int b = bh >> 3, h = bh & 7;
    const __bf16* Q = (const __bf16*)(p.ws + WS_Q) + (size_t)bh * 2048 * 96;
    const __bf16* KN = (const __bf16*)(p.ws + WS_KN) + (size_t)bh * 2048 * 64;
    const __bf16* KR = (const __bf16*)(p.ws + WS_KR) + (size_t)b * 2048 * 32;
    const __bf16* VT = (const __bf16*)(p.ws + WS_VT) + (size_t)bh * 64 * 2048;
    unsigned char* Kb = lds + LDS_BASE;
    unsigned char* Vb = Kb + 2 * KBUF;
    const int qrow0 = qb * 256 + 32 * w, qi = qrow0 + l31;
    bf16x8 qf[6];
#pragma unroll
    for (int ks = 0; ks < 6; ++ks) qf[ks] = *(const bf16x8*)(Q + (size_t)qi * 96 + 16 * ks + 8 * hh);
    f32x16 o[2];
#pragma unroll
    for (int d = 0; d < 2; ++d)
#pragma unroll
        for (int r = 0; r < 16; ++r) o[d][r] = 0.f;
    float m = -1e30f, l = 0.f;
    const int nkt = (qb + 1) * 4;
    const int key_k = tid >> 3, ch_k = tid & 7, key_r = tid >> 2, ch_r = tid & 3;
    u32x4 kA, rA = {0u, 0u, 0u, 0u}, vA, kB, rB = {0u, 0u, 0u, 0u}, vB;
#define ATT_LOAD(kx, rx, vx, jt_) do { const int jc_ = ((jt_) < nkt) ? (jt_) : (nkt - 1); const int k0_ = 64 * jc_; \
        kx = *(const u32x4*)(KN + (size_t)(k0_ + key_k) * 64 + 8 * ch_k); \
        if (tid < 256) rx = *(const u32x4*)(KR + (size_t)(k0_ + key_r) * 32 + 8 * ch_r); \
        vx = *(const u32x4*)(VT + (size_t)jc_ * 4096 + (size_t)tid * 8); } while (0)
#define ATT_STORE(kx, rx, vx, buf_) do { unsigned char* kn_ = Kb + (buf_) * KBUF; unsigned char* vn_ = Vb + (buf_) * VBUF; \
        *(u32x4*)(kn_ + key_k * KST + ch_k * 16) = kx; \
        if (tid < 256) *(u32x4*)(kn_ + key_r * KST + 128 + ch_r * 16) = rx; \
        *(u32x4*)(vn_ + tid * 16) = vx; } while (0)
#define ATT_COMPUTE(j_, cur_) do { \
        const unsigned char* kb = Kb + (cur_) * KBUF; \
        const unsigned char* vb = Vb + (cur_) * VBUF; \
        _Pragma("unroll") for (int sub = 0; sub < 2; ++sub) { \
            const int key_lo = 64 * (j_) + 32 * sub; \
            if (key_lo <= qrow0 + 31) { \
                f32x16 s; \
                _Pragma("unroll") for (int r = 0; r < 16; ++r) s[r] = 0.f; \
                _Pragma("unroll") for (int ks = 0; ks < 6; ++ks) { \
                    const bf16x8 kf = *(const bf16x8*)(kb + (32 * sub + l31) * KST + (16 * ks + 8 * hh) * 2); \
                    s = mfma32(kf, qf[ks], s); } \
                if (key_lo + 31 > qrow0) { \
                    _Pragma("unroll") for (int r = 0; r < 16; ++r) { const int key = key_lo + (r & 3) + 8 * (r >> 2) + 4 * hh; if (key > qi) s[r] = -1e30f; } } \
                float mx = s[0]; \
                _Pragma("unroll") for (int r = 1; r < 16; ++r) mx = fmaxf(mx, s[r]); \
                mx = fmaxf(mx, __shfl_xor(mx, 32)); \
                const float mn = fmaxf(m, mx), alpha = ex2(m - mn); \
                m = mn; \
                float ps = 0.f; \
                _Pragma("unroll") for (int r = 0; r < 16; ++r) { s[r] = ex2(s[r] - mn); ps += s[r]; } \
                l = l * alpha + ps; \
                _Pragma("unroll") for (int d = 0; d < 2; ++d) _Pragma("unroll") for (int r = 0; r < 16; ++r) o[d][r] *= alpha; \
                _Pragma("unroll") for (int sk = 0; sk < 2; ++sk) { \
                    bf16x8 pf; \
                    _Pragma("unroll") for (int e = 0; e < 8; ++e) pf[e] = (__bf16)s[8 * sk + e]; \
                    _Pragma("unroll") for (int d = 0; d < 2; ++d) { \
                        const bf16x8 vf = *(const bf16x8*)(vb + ((2 * sub + sk) * 2 + d) * 1024 + lane * 16); \
                        o[d] = mfma32(vf, pf, o[d]); } } } } } while (0)
    ATT_LOAD(kA, rA, vA, 0);
    ATT_LOAD(kB, rB, vB, 1);
    ATT_STORE(kA, rA, vA, 0);
    ATT_LOAD(kA, rA, vA, 2);
    __syncthreads();
    for (int j = 0; j < nkt; j += 2) {
        ATT_COMPUTE(j, 0);
        ATT_STORE(kB, rB, vB, 1);
        ATT_LOAD(kB, rB, vB, j + 3);
        __syncthreads();
        ATT_COMPUTE(j + 1, 1);
        ATT_STORE(kA, rA, vA, 0);
        ATT_LOAD(kA, rA, vA, j + 4);
        __syncthreads();
    }
#undef ATT_LOAD
#undef ATT_STORE
#undef ATT_COMPUTE
    const float lt = l + __shfl_xor(l, 32);
    const float inv = 1.f / lt;
    __bf16* AO = (__bf16*)(p.ws + WS_AO) + ((size_t)b * 2048 + qi) * 512 + h * 64;
#pragma unroll
    for (int d = 0; d < 2; ++d)
#pragma unroll
        for (int g = 0; g < 4; ++g)
            *(u32x2*)(AO + 32 * d + 8 * g + 4 * hh) = pk4(o[d][4 * g] * inv, o[d][4 * g + 1] * inv, o[d][4 * g + 2] * inv, o[d][4 * g + 3] * inv);
}

constexpr int DVS = 80;
constexpr int DW_BYTES = 128 * DVS + 16 * DVS;
__device__ __forceinline__ f32x4 mfma16(bf16x8 a, bf16x8 b, f32x4 c) { return __builtin_amdgcn_mfma_f32_16x16x32_bf16(a, b, c, 0, 0, 0); }
__device__ void p2_decode(const Params& p, int bs, int split, unsigned char* lds) {
    int tid = threadIdx.x; asm volatile("" : "+v"(tid));
    const int lane = tid & 63, w = tid >> 6, l15 = lane & 15, q4 = lane >> 4;
    unsigned char* QF = lds + LDS_BASE;
    unsigned char* WV = QF + 5120 + w * DW_BYTES;
    unsigned char* WP = WV + 128 * DVS;
    const __bf16* QLR = (const __bf16*)(p.ws + WS_QLR);
    const int pg0 = split * 16 + 2 * w;
    const int phys0 = p.page_table[bs * NPAGES + pg0], phys1 = p.page_table[bs * NPAGES + pg0 + 1];
    u32x2 qlo = {0u, 0u}, qhi = {0u, 0u};
    if (tid < 320) {
        const int ks = tid >> 6, ln = tid & 63, hd = ln & 15, qq = ln >> 4;
        if (hd < 8) {
            qlo = *(const u32x2*)(QLR + ((size_t)bs * 8 + hd) * 160 + 32 * ks + 4 * qq);
            qhi = *(const u32x2*)(QLR + ((size_t)bs * 8 + hd) * 160 + 32 * ks + 16 + 4 * qq);
        }
    }
    f32x4 o[8];
#pragma unroll
    for (int t = 0; t < 8; ++t) o[t] = (f32x4){0.f, 0.f, 0.f, 0.f};
    float m = -1e30f, l = 0.f;
    f32x4 raw[2][10];
#define DEC_ISSUE(tt_) do { const int phys_ = ((tt_) >> 2) ? phys1 : phys0; \
        _Pragma("unroll") for (int j = 0; j < 2; ++j) { const int pos_ = ((tt_) & 3) * 32 + 16 * j + l15; \
            const float* lp_ = p.cache_lat + ((size_t)phys_ * 128 + pos_) * 128 + 4 * q4; \
            const float* kp_ = p.cache_kr + ((size_t)phys_ * 128 + pos_) * 32 + 4 * q4; \
            _Pragma("unroll") for (int ks = 0; ks < 4; ++ks) { raw[j][2 * ks] = *(const f32x4*)(lp_ + 32 * ks); raw[j][2 * ks + 1] = *(const f32x4*)(lp_ + 32 * ks + 16); } \
            raw[j][8] = *(const f32x4*)(kp_); raw[j][9] = *(const f32x4*)(kp_ + 16); } } while (0)
    DEC_ISSUE(0);
    if (tid < 320) { u32x4 v; v.x = qlo.x; v.y = qlo.y; v.z = qhi.x; v.w = qhi.y; *(u32x4*)(QF + tid * 16) = v; }
    __syncthreads();
#pragma unroll 1
    for (int tt = 0; tt < 8; ++tt) {
        f32x4 s[2];
#pragma unroll
        for (int j = 0; j < 2; ++j) {
            s[j] = (f32x4){0.f, 0.f, 0.f, 0.f};
#pragma unroll
            for (int ks = 0; ks < 5; ++ks) {
                const bf16x8 kf = cvt8(raw[j][2 * ks], raw[j][2 * ks + 1]);
                const bf16x8 qf = *(const bf16x8*)(QF + (ks * 64 + lane) * 16);
                s[j] = mfma16(kf, qf, s[j]);
                if (ks < 4) {
#pragma unroll
                    for (int e = 0; e < 8; ++e) {
                        const int d = 32 * ks + 16 * (e >> 2) + 4 * q4 + (e & 3);
                        *(__bf16*)(WV + d * DVS + (16 * j + l15) * 2) = kf[e];
                    }
                }
            }
        }
        asm volatile("" ::: "memory");
        DEC_ISSUE(tt < 7 ? tt + 1 : 7);
        float mx = fmaxf(fmaxf(fmaxf(s[0][0], s[0][1]), fmaxf(s[0][2], s[0][3])), fmaxf(fmaxf(s[1][0], s[1][1]), fmaxf(s[1][2], s[1][3])));
        mx = fmaxf(mx, __shfl_xor(mx, 16)); mx = fmaxf(mx, __shfl_xor(mx, 32));
        const float mn = fmaxf(m, mx), alpha = ex2(m - mn);
        m = mn;
        float ps = 0.f;
#pragma unroll
        for (int j = 0; j < 2; ++j)
#pragma unroll
            for (int r = 0; r < 4; ++r) { s[j][r] = ex2(s[j][r] - mn); ps += s[j][r]; }
        l = l * alpha + ps;
#pragma unroll
        for (int t = 0; t < 8; ++t) o[t] *= alpha;
#pragma unroll
        for (int j = 0; j < 2; ++j) *(u32x2*)(WP + l15 * DVS + (16 * j + 4 * q4) * 2) = pk4(s[j][0], s[j][1], s[j][2], s[j][3]);
        asm volatile("s_waitcnt lgkmcnt(0)" ::: "memory");
        {
            const bf16x8 pf = *(const bf16x8*)(WP + l15 * DVS + 8 * q4 * 2);
#pragma unroll
            for (int t = 0; t < 8; ++t) {
                const bf16x8 vf = *(const bf16x8*)(WV + (16 * t + l15) * DVS + 8 * q4 * 2);
                o[t] = mfma16(vf, pf, o[t]);
            }
        }
        asm volatile("s_waitcnt lgkmcnt(0)" ::: "memory");
    }
#undef DEC_ISSUE
    float lt = l + __shfl_xor(l, 16); lt += __shfl_xor(lt, 32);
    __syncthreads();
    float* MG = (float*)(lds + LDS_BASE);
    if (l15 < 8) {
        float* rec = MG + (w * 8 + l15) * 132;
        if (q4 == 0) { rec[0] = m; rec[1] = lt; }
#pragma unroll
        for (int t = 0; t < 8; ++t) *(f32x4*)(rec + 4 + 16 * t + 4 * q4) = o[t];
    }
    __syncthreads();
    {
        const int hd = tid >> 6, r2 = 2 * (tid & 63);
        float M = -1e30f;
#pragma unroll
        for (int ww = 0; ww < 8; ++ww) M = fmaxf(M, MG[(ww * 8 + hd) * 132]);
        float L = 0.f, o0 = 0.f, o1 = 0.f;
#pragma unroll
        for (int ww = 0; ww < 8; ++ww) {
            const float* rec = MG + (ww * 8 + hd) * 132;
            const float wt = ex2(rec[0] - M);
            L = fmaf(wt, rec[1], L); o0 = fmaf(wt, rec[4 + r2], o0); o1 = fmaf(wt, rec[5 + r2], o1);
        }
        float* dp = (float*)(p.ws + WS_DPART) + ((size_t)(bs * 4 + split) * 8 + hd) * 132;
        if ((tid & 63) == 0) { dp[0] = M; dp[1] = L; }
        f32x2 ov = {o0, o1};
        *(f32x2*)(dp + 4 + r2) = ov;
    }
    __syncthreads();
}

__device__ void p2_scan(const Params& p, int bh) {
    int tid = threadIdx.x; asm volatile("" : "+v"(tid));
    const int lane = tid & 63, w = tid >> 6, l31 = lane & 31, hh = lane >> 5;
    const int dkt = w & 1, dvt = w >> 1;
    const float* BT = (const float*)(p.ws + WS_BT) + (size_t)bh * 64 * 2048;
    const __bf16* GKT = (const __bf16*)(p.ws + WS_GKT) + (size_t)bh * 64 * 2048;
    const __bf16* GVT = (const __bf16*)(p.ws + WS_GVT) + (size_t)bh * 128 * 2048;
    const float* BL = (const float*)(p.ws + WS_BL) + (size_t)bh * 32 * 64;
    __bf16* ST2 = (__bf16*)(p.ws + WS_ST2) + (size_t)bh * 32 * 128 * 64;
    const int dkA = 32 * dkt + l31, dvB = 32 * dvt + l31;
    f32x16 S;
#pragma unroll
    for (int r = 0; r < 16; ++r) S[r] = 0.f;
    float decN[16], blN; u32x4 kN[4]; f32x4 b0N[4], b1N[4]; bf16x8 vN[4];
#define SCAN_LOAD(c_) do { \
        _Pragma("unroll") for (int r = 0; r < 16; ++r) decN[r] = BL[(c_) * 64 + 32 * dkt + (r & 3) + 8 * (r >> 2) + 4 * hh]; \
        blN = BL[(c_) * 64 + dkA]; \
        _Pragma("unroll") for (int ks = 0; ks < 4; ++ks) { const size_t k16 = (size_t)(c_) * 4 + ks; \
            kN[ks] = *(const u32x4*)(GKT + ((k16 * 2 + dkt) * 64 + lane) * 8); \
            b0N[ks] = *(const f32x4*)(BT + ((k16 * 2 + dkt) * 64 + lane) * 8); b1N[ks] = *(const f32x4*)(BT + ((k16 * 2 + dkt) * 64 + lane) * 8 + 4); \
            vN[ks] = *(const bf16x8*)(GVT + ((k16 * 4 + dvt) * 64 + lane) * 8); } \
    } while (0)
    SCAN_LOAD(0);
#pragma unroll 1
    for (int c = 0; c < 32; ++c) {
        float dec[16]; u32x4 kC[4]; f32x4 b0C[4], b1C[4]; bf16x8 vC[4];
        const float blast = blN;
#pragma unroll
        for (int r = 0; r < 16; ++r) dec[r] = decN[r];
#pragma unroll
        for (int ks = 0; ks < 4; ++ks) { kC[ks] = kN[ks]; b0C[ks] = b0N[ks]; b1C[ks] = b1N[ks]; vC[ks] = vN[ks]; }
        SCAN_LOAD(c + 1);
        __builtin_amdgcn_sched_barrier(0);
#pragma unroll
        for (int g = 0; g < 4; ++g)
            *(u32x2*)(ST2 + ((size_t)c * 128 + dvB) * 64 + 32 * dkt + 8 * g + 4 * hh) = pk4(S[4 * g], S[4 * g + 1], S[4 * g + 2], S[4 * g + 3]);
#pragma unroll
        for (int r = 0; r < 16; ++r) S[r] *= __expf(dec[r]);
#pragma unroll
        for (int ks = 0; ks < 4; ++ks) {
            float kv[8]; unpack8(kC[ks], kv);
            bf16x8 ka;
#pragma unroll
            for (int e = 0; e < 4; ++e) { ka[e] = (__bf16)(kv[e] * __expf(blast - b0C[ks][e])); ka[4 + e] = (__bf16)(kv[4 + e] * __expf(blast - b1C[ks][e])); }
            S = mfma32(ka, vC[ks], S);
        }
        __builtin_amdgcn_sched_barrier(0);
    }
#undef SCAN_LOAD
    float* stp = p.out + OUT_STP + (size_t)bh * 64 * 128;
#pragma unroll
    for (int r = 0; r < 16; ++r) {
        const int dkr = 32 * dkt + (r & 3) + 8 * (r >> 2) + 4 * hh;
        stp[(size_t)dkr * 128 + dvB] = S[r];
    }
}

__device__ void p2_glarec(const Params& p, int bs, unsigned char* lds) {
    int tid = threadIdx.x; asm volatile("" : "+v"(tid));
    float* sq = (float*)(lds + LDS_BASE); float* sk = sq + 256; float* se = sk + 256;
    const __bf16* GQ = (const __bf16*)(p.ws + WS_GQ) + (size_t)(NTOK + bs) * 256;
    const __bf16* GK = (const __bf16*)(p.ws + WS_GK) + (size_t)(NTOK + bs) * 256;
    const float* LAB = (const float*)(p.ws + WS_LAB) + (size_t)(NTOK + bs) * 256;
    if (tid < 256) { sq[tid] = (float)GQ[tid]; sk[tid] = (float)GK[tid]; se[tid] = __expf(LAB[tid]); }
    __syncthreads();
    const int h = tid >> 7, dv = tid & 127;
    const float v = (float)((const __bf16*)(p.ws + WS_GV))[(size_t)(NTOK + bs) * 512 + h * 128 + dv];
    const float* s0 = p.state_gla + ((size_t)(bs * 4 + h) * 64) * 128 + dv;
    float* s1 = p.out + OUT_STS + ((size_t)(bs * 4 + h) * 64) * 128 + dv;
    float o = 0.f;
#pragma unroll 8
    for (int dk = 0; dk < 64; ++dk) {
        const float ns = se[h * 64 + dk] * s0[(size_t)dk * 128] + sk[h * 64 + dk] * v;
        s1[(size_t)dk * 128] = ns;
        o = fmaf(sq[h * 64 + dk], ns, o);
    }
    ((float*)(p.ws + WS_GLAOS))[(size_t)(bs * 4 + h) * 128 + dv] = o;
    __syncthreads();
}

__device__ __forceinline__ void p3_outproj(const Params& p, int it, unsigned char* lds);
__device__ void p3_stripe(const Params& p, int it, unsigned char* lds) {
    int tid = threadIdx.x; asm volatile("" : "+v"(tid));
    const int lane = tid & 63, w = tid >> 6, l31 = lane & 31, hh = lane >> 5;
    const bool is_s = it >= 512;
    const int srow0 = is_s ? (it - 512) * 32 : 0;
    const int st = it >> 1, half = it & 1;
    const int tok0 = is_s ? NTOK + srow0 : st * 64 + 32 * half;
    const int b = st >> 5, c = st & 31, s0 = c * 64;
    unsigned char* A = lds + LDS_BASE;
    const __bf16* GM = (const __bf16*)(p.ws + WS_GM);
    const __bf16* GG = (const __bf16*)(p.ws + WS_GG);
    if (!is_s) {
        const __bf16* AO = (const __bf16*)(p.ws + WS_AO);
        const int h = w >> 1, dvh = w & 1, bh = b * 4 + h;
        const int ti = 32 * half + l31;
        const size_t trow = (size_t)(st * 64 + ti);
        const __bf16* GQ = (const __bf16*)(p.ws + WS_GQ);
        const __bf16* GK = (const __bf16*)(p.ws + WS_GK);
        const float* LAB = (const float*)(p.ws + WS_LAB);
        const __bf16* GVT = (const __bf16*)(p.ws + WS_GVT) + (size_t)bh * 128 * 2048;
        const __bf16* ST2 = (const __bf16*)(p.ws + WS_ST2) + ((size_t)bh * 32 + c) * 128 * 64;
        bf16x8 qf[4], kf0[4], vf0[2][2];
        {
            u32x4 av[4], gv[4];
            u32x4 qr[4], kr[4]; f32x4 qb0[4], qb1[4], kb0[4], kb1[4];
            const size_t jrow = (size_t)(st * 64 + l31);
#pragma unroll
            for (int i = 0; i < 4; ++i) {
                const int idx = i * NTHR + tid, row = idx >> 6, ch = idx & 63;
                av[i] = *(const u32x4*)(AO + (size_t)(tok0 + row) * 512 + 8 * ch);
                gv[i] = *(const u32x4*)(GM + (size_t)(tok0 + row) * 512 + 8 * ch);
            }
#pragma unroll
            for (int ks = 0; ks < 4; ++ks) {
                const int dk0 = h * 64 + 16 * ks + 8 * hh;
                qr[ks] = *(const u32x4*)(GQ + trow * 256 + dk0);
                qb0[ks] = *(const f32x4*)(LAB + trow * 256 + dk0); qb1[ks] = *(const f32x4*)(LAB + trow * 256 + dk0 + 4);
                kr[ks] = *(const u32x4*)(GK + jrow * 256 + dk0);
                kb0[ks] = *(const f32x4*)(LAB + jrow * 256 + dk0); kb1[ks] = *(const f32x4*)(LAB + jrow * 256 + dk0 + 4);
            }
#pragma unroll
            for (int sk = 0; sk < 2; ++sk)
#pragma unroll
                for (int t = 0; t < 2; ++t) vf0[sk][t] = *(const bf16x8*)(GVT + ((((size_t)(s0 >> 4) + sk) * 4 + 2 * dvh + t) * 64 + lane) * 8);
            __builtin_amdgcn_sched_barrier(0);
#pragma unroll
            for (int i = 0; i < 4; ++i) {
                const int idx = i * NTHR + tid, row = idx >> 6, ch = idx & 63;
                float af[8], gf[8]; unpack8(av[i], af); unpack8(gv[i], gf);
                u32x4 o; o.x = pk2(af[0] * gf[0], af[1] * gf[1]); o.y = pk2(af[2] * gf[2], af[3] * gf[3]); o.z = pk2(af[4] * gf[4], af[5] * gf[5]); o.w = pk2(af[6] * gf[6], af[7] * gf[7]);
                *(u32x4*)(A + row * XS + ch * 16) = o;
            }
#pragma unroll
            for (int ks = 0; ks < 4; ++ks) {
                float qv[8], kv[8]; unpack8(qr[ks], qv); unpack8(kr[ks], kv);
#pragma unroll
                for (int e = 0; e < 4; ++e) {
                    qf[ks][e] = (__bf16)(qv[e] * __expf(qb0[ks][e])); qf[ks][4 + e] = (__bf16)(qv[4 + e] * __expf(qb1[ks][e]));
                    kf0[ks][e] = (__bf16)(kv[e] * __expf(-kb0[ks][e])); kf0[ks][4 + e] = (__bf16)(kv[4 + e] * __expf(-kb1[ks][e]));
                }
            }
        }
        bf16x8 sf[4][2], vf1[2][2]; u32x4 kr1[4]; f32x4 kb10[4], kb11[4], gn[2][4]; u32x2 gg[2][4];
        {
            const size_t jrow1 = (size_t)(st * 64 + 32 + l31);
#pragma unroll
            for (int ks = 0; ks < 4; ++ks) {
                const int dk0 = h * 64 + 16 * ks + 8 * hh;
#pragma unroll
                for (int t = 0; t < 2; ++t) sf[ks][t] = *(const bf16x8*)(ST2 + (size_t)(32 * (2 * dvh + t) + l31) * 64 + 16 * ks + 8 * hh);
                kr1[ks] = *(const u32x4*)(GK + jrow1 * 256 + dk0);
                kb10[ks] = *(const f32x4*)(LAB + jrow1 * 256 + dk0); kb11[ks] = *(const f32x4*)(LAB + jrow1 * 256 + dk0 + 4);
            }
#pragma unroll
            for (int sk = 0; sk < 2; ++sk)
#pragma unroll
                for (int t = 0; t < 2; ++t) vf1[sk][t] = *(const bf16x8*)(GVT + ((((size_t)(s0 >> 4) + 2 + sk) * 4 + 2 * dvh + t) * 64 + lane) * 8);
#pragma unroll
            for (int t = 0; t < 2; ++t)
#pragma unroll
                for (int g = 0; g < 4; ++g) {
                    const int dv = 32 * (2 * dvh + t) + 8 * g + 4 * hh;
                    gn[t][g] = *(const f32x4*)(p.gla_norm_g + h * 128 + dv);
                    gg[t][g] = *(const u32x2*)(GG + trow * 512 + h * 128 + dv);
                }
        }
        __builtin_amdgcn_sched_barrier(0);
        f32x16 o[2];
#pragma unroll
        for (int t = 0; t < 2; ++t)
#pragma unroll
            for (int r = 0; r < 16; ++r) o[t][r] = 0.f;
        {
            f32x16 att;
#pragma unroll
            for (int r = 0; r < 16; ++r) att[r] = 0.f;
#pragma unroll
            for (int ks = 0; ks < 4; ++ks) att = mfma32(kf0[ks], qf[ks], att);
            if (half == 0) {
#pragma unroll
                for (int r = 0; r < 16; ++r) { const int j = (r & 3) + 8 * (r >> 2) + 4 * hh; if (j > l31) att[r] = 0.f; }
            }
#pragma unroll
            for (int sk = 0; sk < 2; ++sk) {
                bf16x8 pf;
#pragma unroll
                for (int e = 0; e < 8; ++e) pf[e] = (__bf16)att[8 * sk + e];
#pragma unroll
                for (int t = 0; t < 2; ++t) o[t] = mfma32(vf0[sk][t], pf, o[t]);
            }
        }
        __builtin_amdgcn_sched_barrier(0);
        if (half == 1) {
            f32x16 att;
#pragma unroll
            for (int r = 0; r < 16; ++r) att[r] = 0.f;
#pragma unroll
            for (int ks = 0; ks < 4; ++ks) {
                float kv[8]; unpack8(kr1[ks], kv);
                bf16x8 kf;
#pragma unroll
                for (int e = 0; e < 4; ++e) { kf[e] = (__bf16)(kv[e] * __expf(-kb10[ks][e])); kf[4 + e] = (__bf16)(kv[4 + e] * __expf(-kb11[ks][e])); }
                att = mfma32(kf, qf[ks], att);
            }
#pragma unroll
            for (int r = 0; r < 16; ++r) { const int j = (r & 3) + 8 * (r >> 2) + 4 * hh; if (j > l31) att[r] = 0.f; }
#pragma unroll
            for (int sk = 0; sk < 2; ++sk) {
                bf16x8 pf;
#pragma unroll
                for (int e = 0; e < 8; ++e) pf[e] = (__bf16)att[8 * sk + e];
#pragma unroll
                for (int t = 0; t < 2; ++t) o[t] = mfma32(vf1[sk][t], pf, o[t]);
            }
        }
#pragma unroll
        for (int ks = 0; ks < 4; ++ks)
#pragma unroll
            for (int t = 0; t < 2; ++t) o[t] = mfma32(sf[ks][t], qf[ks], o[t]);
        float ss = 0.f;
#pragma unroll
        for (int t = 0; t < 2; ++t)
#pragma unroll
            for (int r = 0; r < 16; ++r) ss = fmaf(o[t][r], o[t][r], ss);
        ss += __shfl_xor(ss, 32);
        float* SSX = (float*)(lds + LDS_BASE + 64 * XS);
        if (hh == 0) SSX[w * 32 + l31] = ss;
        __syncthreads();
        ss += SSX[(w ^ 1) * 32 + l31];
        const float inv = rsqrtf(ss * (1.f / 128.f) + NORM_EPS);
#pragma unroll
        for (int t = 0; t < 2; ++t)
#pragma unroll
            for (int g = 0; g < 4; ++g) {
                const int dv = 32 * (2 * dvh + t) + 8 * g + 4 * hh;
                *(u32x2*)(A + l31 * XS + (512 + h * 128 + dv) * 2) =
                    pk4(o[t][4 * g] * inv * gn[t][g][0] * bflo(gg[t][g].x), o[t][4 * g + 1] * inv * gn[t][g][1] * bfhi(gg[t][g].x),
                        o[t][4 * g + 2] * inv * gn[t][g][2] * bflo(gg[t][g].y), o[t][4 * g + 3] * inv * gn[t][g][3] * bfhi(gg[t][g].y));
            }
    }
    __syncthreads();
    p3_outproj(p, it, lds);
}

__device__ __forceinline__ void p3_outproj(const Params& p, int it, unsigned char* lds) {
    int tid = threadIdx.x; asm volatile("" : "+v"(tid));
    const int lane = tid & 63, w = tid >> 6, l31 = lane & 31, hh = lane >> 5;
    const bool is_s = it >= 512;
    const int srow0 = is_s ? (it - 512) * 32 : 0;
    const int st = it >> 1, half = it & 1, b = st >> 5;
    unsigned char* A = lds + LDS_BASE;
    const u32x4* woutf = (const u32x4*)(p.ws + WS_WOUTF);
    const float* mod = (const float*)(p.ws + WS_MOD);
    float s1 = 0.f, s2 = 0.f;
    const size_t row0 = is_s ? (size_t)srow0 : (size_t)st * 64 + 32 * half;
    const float* xb0 = (is_s ? p.x_sample : p.x_prompt) + (row0 + l31) * 1024 + 64 * w + 4 * hh;
    const float* gb0 = mod + (size_t)(is_s ? (8 + srow0 + l31) : b) * 3072 + 2048 + 64 * w + 4 * hh;
    float* yb0 = p.out + (is_s ? OUT_YS : OUT_YP) + (row0 + l31) * 1024 + 64 * w + 4 * hh;
    f32x16 vacc[2][2];
#pragma unroll
    for (int q = 0; q < 2; ++q) {
        f32x16 acc[2];
#pragma unroll
        for (int nt = 0; nt < 2; ++nt)
#pragma unroll
            for (int r = 0; r < 16; ++r) acc[nt][r] = 0.f;
        {
            const unsigned char* x0 = A + l31 * XS + hh * 16;
            const u32x4* w0 = woutf + (size_t)(w + 8 * q) * 2 * 64 * 64 + lane;
            const u32x4* w1 = w0 + 64 * 64;
            u32x4 ra[8], rb[8];
#pragma unroll
            for (int u = 0; u < 8; ++u) { ra[u] = w0[u * 64]; rb[u] = w1[u * 64]; }
            bf16x8 b0 = *(const bf16x8*)(x0);
#pragma unroll 1
            for (int k0 = 0; k0 < 64; k0 += 8) {
#pragma unroll
                for (int u = 0; u < 8; ++u) {
                    const int ks = k0 + u;
                    const bf16x8 nb0 = *(const bf16x8*)(x0 + (ks + 1) * 32);
                    const bf16x8 a0 = __builtin_bit_cast(bf16x8, ra[u]), a1 = __builtin_bit_cast(bf16x8, rb[u]);
                    ra[u] = w0[(ks + 8) * 64]; rb[u] = w1[(ks + 8) * 64];
                    __builtin_amdgcn_sched_barrier(0);
                    acc[0] = mfma32(a0, b0, acc[0]); acc[1] = mfma32(a1, b0, acc[1]);
                    __builtin_amdgcn_sched_barrier(0);
                    b0 = nb0;
                }
            }
        }
        f32x4 xv[2][4], gt[2][4];
#pragma unroll
        for (int nt = 0; nt < 2; ++nt)
#pragma unroll
            for (int g = 0; g < 4; ++g) {
                const int off = 512 * q + 32 * nt + 8 * g;
                xv[nt][g] = *(const f32x4*)(xb0 + off);
                gt[nt][g] = *(const f32x4*)(gb0 + off);
            }
        __builtin_amdgcn_sched_barrier(0);
#pragma unroll
        for (int nt = 0; nt < 2; ++nt)
#pragma unroll
            for (int g = 0; g < 4; ++g)
#pragma unroll
                for (int i = 0; i < 4; ++i) {
                    const float v = DN_ALPHA * xv[nt][g][i] + gt[nt][g][i] * acc[nt][4 * g + i];
                    vacc[q][nt][4 * g + i] = v;
                    s1 += v; s2 = fmaf(v, v, s2);
                }
        __builtin_amdgcn_sched_barrier(0);
    }
    float* LNP = (float*)(lds + LDS_BASE + 64 * XS);
    s1 += __shfl_xor(s1, 32); s2 += __shfl_xor(s2, 32);
    __syncthreads();
    if (hh == 0) { LNP[(w * 32 + l31) * 2] = s1; LNP[(w * 32 + l31) * 2 + 1] = s2; }
    __syncthreads();
    float mean, rstd;
    {
        float a = 0.f, bq = 0.f;
#pragma unroll
        for (int ww = 0; ww < 8; ++ww) { a += LNP[(ww * 32 + l31) * 2]; bq += LNP[(ww * 32 + l31) * 2 + 1]; }
        mean = a * (1.f / 1024.f);
        const float var = fmaxf(bq * (1.f / 1024.f) - mean * mean, 0.f);
        rstd = rsqrtf(var + NORM_EPS);
    }
    const float* lgb = p.ln_g + 64 * w + 4 * hh;
    const float* lbb = p.ln_b + 64 * w + 4 * hh;
#pragma unroll
    for (int q = 0; q < 2; ++q) {
        f32x4 lg[2][4], lb[2][4];
#pragma unroll
        for (int nt = 0; nt < 2; ++nt)
#pragma unroll
            for (int g = 0; g < 4; ++g) {
                const int off = 512 * q + 32 * nt + 8 * g;
                lg[nt][g] = *(const f32x4*)(lgb + off); lb[nt][g] = *(const f32x4*)(lbb + off);
            }
        __builtin_amdgcn_sched_barrier(0);
#pragma unroll
        for (int nt = 0; nt < 2; ++nt)
#pragma unroll
            for (int g = 0; g < 4; ++g) {
                const int off = 512 * q + 32 * nt + 8 * g;
                f32x4 y;
#pragma unroll
                for (int i = 0; i < 4; ++i) y[i] = (vacc[q][nt][4 * g + i] - mean) * rstd * lg[nt][g][i] + lb[nt][g][i];
                *(f32x4*)(yb0 + off) = y;
            }
        __builtin_amdgcn_sched_barrier(0);
    }
    __syncthreads();
}


__device__ void p3s_arows(const Params& p, int k, unsigned char* lds) {
    int tid = threadIdx.x; asm volatile("" : "+v"(tid));
    const int lane = tid & 63, w = tid >> 6, l31 = lane & 31, hh = lane >> 5;
    const int r0 = 8 * k, h = w;
    const __bf16* QLR = (const __bf16*)(p.ws + WS_QLR);
    const float* DP = (const float*)(p.ws + WS_DPART);
    const float* lat_s = p.out + OUT_LATS;
    const float* kr_s = p.out + OUT_KRS;
    const __bf16* GM = (const __bf16*)(p.ws + WS_GM);
    const __bf16* GG = (const __bf16*)(p.ws + WS_GG);
    __bf16* AS = (__bf16*)(p.ws + WS_AS);
    unsigned char* OL = lds + LDS_BASE + w * 2304;
#pragma unroll 1
    for (int q0 = 0; q0 < 8; q0 += 4) {
        float qa[4], qb[4], qc[4], la[4], lb2[4], kc[4], mi[4][4], li[4][4];
        f32x2 ln[4], ov[4][4];
#pragma unroll
        for (int u = 0; u < 4; ++u) {
            const int bs = r0 + q0 + u;
            const __bf16* ql = QLR + ((size_t)bs * 8 + h) * 160;
            qa[u] = (float)ql[lane]; qb[u] = (float)ql[64 + lane]; qc[u] = (float)ql[128 + (lane & 31)];
            la[u] = lat_s[(size_t)bs * 128 + lane]; lb2[u] = lat_s[(size_t)bs * 128 + 64 + lane]; kc[u] = kr_s[(size_t)bs * 32 + (lane & 31)];
            ln[u] = *(const f32x2*)(lat_s + (size_t)bs * 128 + 2 * lane);
#pragma unroll
            for (int sp = 0; sp < 4; ++sp) {
                const float* d = DP + ((size_t)(bs * 4 + sp) * 8 + h) * 132;
                mi[u][sp] = d[0]; li[u][sp] = d[1]; ov[u][sp] = *(const f32x2*)(d + 4 + 2 * lane);
            }
        }
        __builtin_amdgcn_sched_barrier(0);
#pragma unroll
        for (int u = 0; u < 4; ++u) {
            float part = qa[u] * la[u] + qb[u] * lb2[u];
            if (lane < 32) part += qc[u] * kc[u];
            const float sn = wave_sum(part);
            float M = sn;
#pragma unroll
            for (int sp = 0; sp < 4; ++sp) M = fmaxf(M, mi[u][sp]);
            const float wn = ex2(sn - M);
            float L = wn, o0 = wn * ln[u][0], o1 = wn * ln[u][1];
#pragma unroll
            for (int sp = 0; sp < 4; ++sp) {
                const float wt = ex2(mi[u][sp] - M);
                L = fmaf(wt, li[u][sp], L); o0 = fmaf(wt, ov[u][sp][0], o0); o1 = fmaf(wt, ov[u][sp][1], o1);
            }
            const float inv = __builtin_amdgcn_rcpf(L);
            *(unsigned*)(OL + (q0 + u) * 288 + 4 * lane) = pk2(o0 * inv, o1 * inv);
        }
    }
    asm volatile("s_waitcnt lgkmcnt(0)" ::: "memory");
    {
        const __bf16* wuvt = (const __bf16*)(p.ws + WS_WUVT);
        f32x16 mo[2];
#pragma unroll
        for (int vt = 0; vt < 2; ++vt)
#pragma unroll
            for (int r = 0; r < 16; ++r) mo[vt][r] = 0.f;
        bf16x8 ob[8], wa[2][8];
        const int tk = (l31 < 8) ? l31 : 7;
#pragma unroll
        for (int ks = 0; ks < 8; ++ks) {
            ob[ks] = *(const bf16x8*)(OL + tk * 288 + (16 * ks + 8 * hh) * 2);
            wa[0][ks] = *(const bf16x8*)(wuvt + ((size_t)h * 64 + l31) * 128 + 16 * ks + 8 * hh);
            wa[1][ks] = *(const bf16x8*)(wuvt + ((size_t)h * 64 + 32 + l31) * 128 + 16 * ks + 8 * hh);
        }
        __builtin_amdgcn_sched_barrier(0);
#pragma unroll
        for (int ks = 0; ks < 8; ++ks)
#pragma unroll
            for (int vt = 0; vt < 2; ++vt) mo[vt] = mfma32(wa[vt][ks], ob[ks], mo[vt]);
        if (l31 < 8) {
#pragma unroll
            for (int vt = 0; vt < 2; ++vt)
#pragma unroll
                for (int g = 0; g < 4; ++g) {
                    const int v = 32 * vt + 8 * g + 4 * hh;
                    const u32x2 gm = *(const u32x2*)(GM + (size_t)(NTOK + r0 + l31) * 512 + h * 64 + v);
                    *(u32x2*)(AS + (size_t)(r0 + l31) * 1024 + h * 64 + v) =
                        pk4(mo[vt][4 * g] * bflo(gm.x), mo[vt][4 * g + 1] * bfhi(gm.x), mo[vt][4 * g + 2] * bflo(gm.y), mo[vt][4 * g + 3] * bfhi(gm.y));
                }
        }
    }
    {
        const float* GLAOS = (const float*)(p.ws + WS_GLAOS);
        f32x2 ov[4], gn[4]; unsigned gg[4];
#pragma unroll
        for (int u = 0; u < 4; ++u) {
            const int pr = w * 4 + u, t = pr >> 2, hg = pr & 3, bs = r0 + t;
            ov[u] = *(const f32x2*)(GLAOS + ((size_t)bs * 4 + hg) * 128 + 2 * lane);
            gn[u] = *(const f32x2*)(p.gla_norm_g + hg * 128 + 2 * lane);
            gg[u] = *(const unsigned*)(GG + (size_t)(NTOK + bs) * 512 + hg * 128 + 2 * lane);
        }
        __builtin_amdgcn_sched_barrier(0);
#pragma unroll
        for (int u = 0; u < 4; ++u) {
            const int pr = w * 4 + u, t = pr >> 2, hg = pr & 3, bs = r0 + t;
            const float ss = wave_sum(ov[u][0] * ov[u][0] + ov[u][1] * ov[u][1]);
            const float inv = rsqrtf(ss * (1.f / 128.f) + NORM_EPS);
            *(unsigned*)(AS + (size_t)bs * 1024 + 512 + hg * 128 + 2 * lane) = pk2(ov[u][0] * inv * gn[u][0] * bflo(gg[u]), ov[u][1] * inv * gn[u][1] * bfhi(gg[u]));
        }
    }
    __syncthreads();
}
__device__ void p3s_cols(const Params& p, int k, unsigned char* lds) {
    int tid = threadIdx.x; asm volatile("" : "+v"(tid));
    const int lane = tid & 63, w = tid >> 6, l31 = lane & 31, hh = lane >> 5;
    const int nt = w >> 1, mt = w & 1;
    unsigned char* A = lds + LDS_BASE;
    const __bf16* AS = (const __bf16*)(p.ws + WS_AS);
    const u32x4* woutf = (const u32x4*)(p.ws + WS_WOUTF);
    const float* mod = (const float*)(p.ws + WS_MOD);
    float* ST = (float*)(lds + LDS_BASE + 64 * XS);
    float* STATS = (float*)(p.ws + WS_STATS);
#pragma unroll 1
    for (int pass = 0; pass < 2; ++pass) {
        {
            u32x4 t[16];
#pragma unroll
            for (int i = 0; i < 16; ++i) { const int idx = i * NTHR + tid, row = idx >> 7, ch = idx & 127; t[i] = *(const u32x4*)(AS + (size_t)(64 * pass + row) * 1024 + 8 * ch); }
            __builtin_amdgcn_sched_barrier(0);
#pragma unroll
            for (int i = 0; i < 16; ++i) { const int idx = i * NTHR + tid, row = idx >> 7, ch = idx & 127; *(u32x4*)(A + row * XS + ch * 16) = t[i]; }
        }
        __syncthreads();
        f32x16 acc;
#pragma unroll
        for (int r = 0; r < 16; ++r) acc[r] = 0.f;
        const int row = 64 * pass + 32 * mt + l31;
        const int ncol = 128 * k + 32 * nt + 4 * hh;
        f32x4 xv[4], gt[4];
#pragma unroll
        for (int g = 0; g < 4; ++g) { xv[g] = *(const f32x4*)(p.x_sample + (size_t)row * 1024 + ncol + 8 * g); gt[g] = *(const f32x4*)(mod + (size_t)(8 + row) * 3072 + 2048 + ncol + 8 * g); }
        {
            const unsigned char* x0 = A + (32 * mt + l31) * XS + hh * 16;
            const u32x4* w0 = woutf + (size_t)(4 * k + nt) * 64 * 64 + lane;
            u32x4 ra[8];
#pragma unroll
            for (int u = 0; u < 8; ++u) ra[u] = w0[u * 64];
#pragma unroll 1
            for (int k0 = 0; k0 < 64; k0 += 8) {
#pragma unroll
                for (int u = 0; u < 8; ++u) {
                    const int ks = k0 + u;
                    const bf16x8 b0 = *(const bf16x8*)(x0 + ks * 32);
                    const bf16x8 a0 = __builtin_bit_cast(bf16x8, ra[u]);
                    ra[u] = w0[(ks + 8) * 64];
                    __builtin_amdgcn_sched_barrier(0);
                    acc = mfma32(a0, b0, acc);
                    __builtin_amdgcn_sched_barrier(0);
                }
            }
        }
        float s1 = 0.f, s2 = 0.f;
        float* yb = p.out + OUT_YS + (size_t)row * 1024 + ncol;
#pragma unroll
        for (int g = 0; g < 4; ++g) {
            f32x4 v;
#pragma unroll
            for (int i = 0; i < 4; ++i) { v[i] = DN_ALPHA * xv[g][i] + gt[g][i] * acc[4 * g + i]; s1 += v[i]; s2 = fmaf(v[i], v[i], s2); }
            *(f32x4*)(yb + 8 * g) = v;
        }
        s1 += __shfl_xor(s1, 32); s2 += __shfl_xor(s2, 32);
        if (hh == 0) { ST[(w * 32 + l31) * 2] = s1; ST[(w * 32 + l31) * 2 + 1] = s2; }
        __syncthreads();
        if (tid < 64) {
            const int m2 = tid >> 5, tk = tid & 31;
            float a = 0.f, bq = 0.f;
#pragma unroll
            for (int n2 = 0; n2 < 4; ++n2) { a += ST[((2 * n2 + m2) * 32 + tk) * 2]; bq += ST[((2 * n2 + m2) * 32 + tk) * 2 + 1]; }
            STATS[((size_t)k * NDEC + 64 * pass + tid) * 2] = a; STATS[((size_t)k * NDEC + 64 * pass + tid) * 2 + 1] = bq;
        }
        __syncthreads();
    }
}
__device__ void p3s_ln(const Params& p, int k, unsigned char* lds) {
    int tid = threadIdx.x; asm volatile("" : "+v"(tid));
    const int row = 32 * k + (tid >> 4), c0 = (tid & 15) * 64;
    const float* STATS = (const float*)(p.ws + WS_STATS);
    float a = 0.f, bq = 0.f;
#pragma unroll
    for (int j = 0; j < 8; ++j) { a += STATS[((size_t)j * NDEC + row) * 2]; bq += STATS[((size_t)j * NDEC + row) * 2 + 1]; }
    const float mean = a * (1.f / 1024.f);
    const float rstd = rsqrtf(fmaxf(bq * (1.f / 1024.f) - mean * mean, 0.f) + NORM_EPS);
    float* y = p.out + OUT_YS + (size_t)row * 1024 + c0;
    f32x4 v[16];
#pragma unroll
    for (int i = 0; i < 16; ++i) v[i] = *(const f32x4*)(y + 4 * i);
    __builtin_amdgcn_sched_barrier(0);
#pragma unroll
    for (int i = 0; i < 16; ++i) {
        const f32x4 lg = *(const f32x4*)(p.ln_g + c0 + 4 * i), lb = *(const f32x4*)(p.ln_b + c0 + 4 * i);
        f32x4 o;
#pragma unroll
        for (int e = 0; e < 4; ++e) o[e] = (v[i][e] - mean) * rstd * lg[e] + lb[e];
        *(f32x4*)(y + 4 * i) = o;
    }
}

__device__ __forceinline__ int q_next(unsigned* cnt, unsigned char* lds) {
    volatile LAS unsigned* slot = (volatile LAS unsigned*)(lds + 16);
    __syncthreads();
    if (threadIdx.x == 0) *slot = __hip_atomic_fetch_add(cnt, 1u, __ATOMIC_RELAXED, __HIP_MEMORY_SCOPE_AGENT);
    __syncthreads();
    return (int)*slot;
}
__device__ __forceinline__ void signal_done(unsigned* cnt) {
    asm volatile("s_waitcnt vmcnt(0)" ::: "memory");
    __syncthreads();
    if (threadIdx.x == 0) {
        __builtin_amdgcn_fence(__ATOMIC_RELEASE, "agent");
        asm volatile("s_waitcnt vmcnt(0)" ::: "memory");
        (void)__hip_atomic_fetch_add(cnt, 1u, __ATOMIC_RELAXED, __HIP_MEMORY_SCOPE_AGENT);
    }
}
__device__ __forceinline__ void wait_count(unsigned* bar, unsigned* cnt, unsigned want) {
    if (threadIdx.x == 0) {
        XB_SPIN(xb_ld(cnt) < want, bar);
        __builtin_amdgcn_fence(__ATOMIC_ACQUIRE, "agent");
        asm volatile("s_waitcnt vmcnt(0)" ::: "memory");
    }
    __syncthreads();
}

__global__ void __launch_bounds__(NTHR) fwd_mega(Params p, int ph_lo, int ph_hi, int use_bar) {
    extern __shared__ __attribute__((aligned(16))) unsigned char lds[];
    const int tid = threadIdx.x;
    if (use_bar) {
        if (tid == 0) { *(u32x4*)lds = (u32x4){0u, 0u, 0u, 0u}; }
        __syncthreads();
        (void)xcd_barrier_post((unsigned*)(p.ws + WS_CTL), (volatile LAS unsigned*)lds);
    }
    const int G = gridDim.x, bid = blockIdx.x;
    unsigned* ctl = (unsigned*)(p.ws + WS_CTL);
    for (int ph = ph_lo; ph < ph_hi; ++ph) {
        for (int rep = 0; rep < ((ph == REP_PH) ? 2 : 1); ++rep) {
        if (ph == 0) {
            for (int item = bid; item < 96; item += G) p0_mod_item(p, item, lds);
            p0_convert(p);
        } else if (ph == 1 || ph == 2) {
            bool sample_ok = false;
            int local = 0;
            for (;;) {
                int kind, a0, a1;
                if (ph == 1) { a0 = bid + local * G; ++local; if (a0 >= 256) break; kind = 0; a1 = 0; }
                else {
                    const int i = q_next(ctl + CW_Q2 + 16 * rep, lds);
                    if (i >= 1194) break;
                    if (i < 2) { kind = 0; a0 = 256 + i; a1 = 1; }
                    else if (i < 10) { kind = 0; a0 = 256 + ((i - 2) >> 2); a1 = 2 + ((i - 2) & 3); }
                    else if (i < 42) { kind = 1; a0 = i - 10; a1 = 0; }
                    else if (i < 298) { kind = 2; a0 = (i - 42) & 63; a1 = 7 - ((i - 42) >> 6); }
                    else if (i < 426) { kind = 3; a0 = i - 298; a1 = 0; }
                    else if (i < 938) { kind = 4; a0 = (i - 426) >> 2; a1 = (i - 426) & 3; }
                    else { kind = 2; a0 = (i - 938) & 63; a1 = 3 - ((i - 938) >> 6); }
                }
                if (kind >= 3 && !sample_ok) { wait_count(ctl, ctl + CW_SAMPLE, 10u * (rep + 1)); sample_ok = true; }
                if (kind == 0) { p1_stripe(p, a0, a1, lds); if (ph == 2) signal_done(ctl + CW_SAMPLE); }
                else if (kind == 1) p2_scan(p, a0);
                else if (kind == 2) p2_attn(p, a0, a1, lds);
                else if (kind == 3) p2_glarec(p, a0, lds);
                else p2_decode(p, a0, a1, lds);
            }
        } else {
            for (;;) {
                const int qi = q_next(ctl + CW_Q3 + 16 * rep, lds);
                if (qi >= 540) break;
                if (qi < 16) { p3s_arows(p, qi, lds); signal_done(ctl + CW_AS); }
                else if (qi < 272) p3_stripe(p, qi - 16, lds);
                else if (qi < 280) { wait_count(ctl, ctl + CW_AS, 16u * (rep + 1)); p3s_cols(p, qi - 272, lds); signal_done(ctl + CW_COL); }
                else if (qi < 536) p3_stripe(p, qi - 280 + 256, lds);
                else { wait_count(ctl, ctl + CW_COL, 8u * (rep + 1)); p3s_ln(p, qi - 536, lds); }
            }
        }
        }
        if (use_bar && ph + 1 < ph_hi) {
            XcdBarrier xb; xb.bar = (unsigned*)(p.ws + WS_CTL); xb.x = xb_xcc_id(); xb.st = (volatile LAS unsigned*)lds;
            xcd_barrier(xb);
        }
    }
}


extern "C" void kernel_launch(void* const* d_in, const int* in_sizes, int n_in, void* d_out, int out_size, void* d_ws, size_t ws_size, hipStream_t stream) {
    static int grid = 0;
    if (grid == 0) {
        if (n_in != 22 || (size_t)out_size != OUT_END || ws_size < WS_END) { fprintf(stderr, "kernel_launch: unexpected shapes (n_in %d out %d ws %zu)\n", n_in, out_size, ws_size); grid = -1; return; }
        int dev = 0, cus = 0, per_cu = 0;
        if (hipGetDevice(&dev) != hipSuccess || hipDeviceGetAttribute(&cus, hipDeviceAttributeMultiprocessorCount, dev) != hipSuccess) { grid = -1; return; }
        if (hipFuncSetAttribute((const void*)fwd_mega, hipFuncAttributeMaxDynamicSharedMemorySize, LDS_BYTES) != hipSuccess) { fprintf(stderr, "kernel_launch: hipFuncSetAttribute failed\n"); grid = -1; return; }
        if (hipOccupancyMaxActiveBlocksPerMultiprocessor(&per_cu, (const void*)fwd_mega, NTHR, LDS_BYTES) != hipSuccess || per_cu < 1) { fprintf(stderr, "kernel_launch: occupancy query says %d\n", per_cu); grid = -1; return; }
        (void)hipGetLastError();
        grid = cus;
    }
    if (grid < 0) return;
    Params p{};
    p.x_prompt = (const float*)d_in[0]; p.x_sample = (const float*)d_in[1]; p.cache_lat = (const float*)d_in[2]; p.cache_kr = (const float*)d_in[3];
    p.state_gla = (const float*)d_in[4]; p.page_table = (const int*)d_in[5]; p.c_prompt = (const float*)d_in[6]; p.c_sample = (const float*)d_in[7];
    p.w_ada = (const float*)d_in[8]; p.b_ada = (const float*)d_in[9]; p.w_in = (const float*)d_in[10]; p.q_norm_g = (const float*)d_in[11];
    p.w_uq = (const float*)d_in[12]; p.kv_norm_g = (const float*)d_in[13]; p.w_uk = (const float*)d_in[14]; p.w_uv = (const float*)d_in[15];
    p.w_gate_up = (const float*)d_in[16]; p.b_gate = (const float*)d_in[17]; p.gla_norm_g = (const float*)d_in[18]; p.w_out = (const float*)d_in[19];
    p.ln_g = (const float*)d_in[20]; p.ln_b = (const float*)d_in[21];
    p.out = (float*)d_out; p.ws = (unsigned char*)d_ws;
    if (hipMemsetAsync((char*)d_ws + WS_CTL, 0, CTL_BYTES, stream) != hipSuccess) { fprintf(stderr, "kernel_launch: memset failed\n"); return; }
#if N_LAUNCHES == 1
    hipLaunchKernelGGL(fwd_mega, dim3(grid), dim3(NTHR), LDS_BYTES, stream, p, 0, 4, 1);
#else
    for (int ph = 0; ph < 4; ++ph) hipLaunchKernelGGL(fwd_mega, dim3(grid), dim3(NTHR), LDS_BYTES, stream, p, ph, ph + 1, 0);
#endif
    const hipError_t le = hipPeekAtLastError();
    if (le != hipSuccess) fprintf(stderr, "kernel_launch: launch failed: %s\n", hipGetErrorName(le));
}
```

```cpp
#include <hip/hip_runtime.h>
#include <cstdint>
#include <cstdio>

typedef __bf16 bf16x8 __attribute__((ext_vector_type(8)));
typedef __bf16 bf16x4 __attribute__((ext_vector_type(4)));
typedef __bf16 bf16x2 __attribute__((ext_vector_type(2)));
typedef float f32x16 __attribute__((ext_vector_type(16)));
typedef float f32x4 __attribute__((ext_vector_type(4)));
typedef float f32x2 __attribute__((ext_vector_type(2)));
typedef unsigned u32x4 __attribute__((ext_vector_type(4)));
typedef unsigned u32x2 __attribute__((ext_vector_type(2)));

#define NTHR 512
#define N_LAUNCHES 1
#define REP_PH (-1)
#define LDS_BYTES 143360
#define LDS_BASE 256

constexpr int DM = 1024, SEQ = 2048, NB = 8, NTOK = 16384, NDEC = 128, RT = NTOK + NDEC;
constexpr int NPAGES = 64;
constexpr float NORM_EPS = 1e-6f;
constexpr float LOG2E = 1.4426950408889634f;
constexpr float QSCALE = 0.10206207261596577f * 1.4426950408889634f;
constexpr float DN_ALPHA = 1.189207115002721f;

constexpr size_t OUT_YP = 0;
constexpr size_t OUT_YS = OUT_YP + (size_t)NTOK * 1024;
constexpr size_t OUT_LATP = OUT_YS + (size_t)NDEC * 1024;
constexpr size_t OUT_KRP = OUT_LATP + (size_t)NTOK * 128;
constexpr size_t OUT_STP = OUT_KRP + (size_t)NTOK * 32;
constexpr size_t OUT_LATS = OUT_STP + (size_t)NB * 4 * 64 * 128;
constexpr size_t OUT_KRS = OUT_LATS + (size_t)NDEC * 128;
constexpr size_t OUT_STS = OUT_KRS + (size_t)NDEC * 32;
constexpr size_t OUT_END = OUT_STS + (size_t)NDEC * 4 * 64 * 128;

constexpr size_t al256(size_t x) { return (x + 255) & ~(size_t)255; }
constexpr size_t WS_CTL = 0;
constexpr size_t CTL_BYTES = 16384;
constexpr size_t WS_MOD = WS_CTL + CTL_BYTES;
constexpr size_t WS_ROPE = WS_MOD + al256((size_t)136 * 3072 * 4);
constexpr size_t WS_WINF = WS_ROPE + al256((size_t)2049 * 32 * 4);
constexpr size_t WS_WUQF = WS_WINF + (size_t)78 * 64 * 1024;
constexpr size_t WS_WKVF = WS_WUQF + (size_t)24 * 16 * 1024;
constexpr size_t WS_WOUTF = WS_WKVF + (size_t)32 * 8 * 1024;
constexpr size_t WS_WUKB = WS_WOUTF + (size_t)32 * 64 * 1024;
constexpr size_t WS_WUVT = WS_WUKB + (size_t)65536 * 2;
constexpr size_t WS_GM = WS_WUVT + (size_t)65536 * 2;
constexpr size_t WS_GQ = WS_GM + al256((size_t)RT * 512 * 2);
constexpr size_t WS_GK = WS_GQ + al256((size_t)RT * 256 * 2);
constexpr size_t WS_GV = WS_GK + al256((size_t)RT * 256 * 2);
constexpr size_t WS_GG = WS_GV + al256((size_t)RT * 512 * 2);
constexpr size_t WS_LAB = WS_GG + al256((size_t)RT * 512 * 2);
constexpr size_t WS_BT = WS_LAB + al256((size_t)RT * 256 * 4);
constexpr size_t WS_GKT = WS_BT + (size_t)NB * 4 * 64 * 2048 * 4;
constexpr size_t WS_GVT = WS_GKT + (size_t)NB * 4 * 64 * 2048 * 2;
constexpr size_t WS_Q = WS_GVT + (size_t)NB * 4 * 128 * 2048 * 2;
constexpr size_t WS_KN = WS_Q + (size_t)NB * 8 * 2048 * 96 * 2;
constexpr size_t WS_KR = WS_KN + (size_t)NB * 8 * 2048 * 64 * 2;
constexpr size_t WS_VT = WS_KR + (size_t)NB * 2048 * 32 * 2;
constexpr size_t WS_AO = WS_VT + (size_t)NB * 8 * 64 * 2048 * 2;
constexpr size_t WS_ST2 = WS_AO + (size_t)NTOK * 512 * 2;
constexpr size_t WS_BL = WS_ST2 + (size_t)NB * 4 * 32 * 128 * 64 * 2;
constexpr size_t WS_QLR = WS_BL + (size_t)NB * 4 * 32 * 64 * 4;
constexpr size_t WS_DPART = WS_QLR + al256((size_t)NDEC * 8 * 160 * 2);
constexpr size_t WS_GLAOS = WS_DPART + al256((size_t)NDEC * 4 * 8 * 132 * 4);
constexpr size_t WS_OLAT = WS_GLAOS + al256((size_t)NDEC * 4 * 128 * 4);
constexpr size_t WS_AS = WS_OLAT + al256((size_t)NDEC * 8 * 128 * 2);
constexpr size_t WS_STATS = WS_AS + (size_t)NDEC * 1024 * 2;
constexpr size_t WS_END = WS_STATS + (size_t)8 * NDEC * 2 * 4;

struct Params {
    const float* x_prompt; const float* x_sample; const float* cache_lat; const float* cache_kr; const float* state_gla;
    const int* page_table; const float* c_prompt; const float* c_sample;
    const float* w_ada; const float* b_ada; const float* w_in; const float* q_norm_g; const float* w_uq; const float* kv_norm_g;
    const float* w_uk; const float* w_uv; const float* w_gate_up; const float* b_gate; const float* gla_norm_g;
    const float* w_out; const float* ln_g; const float* ln_b;
    float* out; unsigned char* ws;
};

__device__ __forceinline__ f32x16 mfma32(bf16x8 a, bf16x8 b, f32x16 c) { return __builtin_amdgcn_mfma_f32_32x32x16_bf16(a, b, c, 0, 0, 0); }
__device__ __forceinline__ unsigned pk2(float lo, float hi) { bf16x2 v = {(__bf16)lo, (__bf16)hi}; return __builtin_bit_cast(unsigned, v); }
__device__ __forceinline__ u32x2 pk4(float a, float b, float c, float d) { u32x2 r; r.x = pk2(a, b); r.y = pk2(c, d); return r; }
__device__ __forceinline__ float bflo(unsigned u) { return __builtin_bit_cast(float, u << 16); }
__device__ __forceinline__ float bfhi(unsigned u) { return __builtin_bit_cast(float, u & 0xffff0000u); }
__device__ __forceinline__ float siluf(float x) { return x * __builtin_amdgcn_rcpf(1.f + __expf(-x)); }
__device__ __forceinline__ float ex2(float x) { return __builtin_amdgcn_exp2f(x); }
__device__ __forceinline__ float wave_sum(float v) {
#pragma unroll
    for (int o = 1; o < 64; o <<= 1) v += __shfl_xor(v, o);
    return v;
}
__device__ __forceinline__ bf16x8 cvt8(f32x4 a, f32x4 b) {
    bf16x8 r; r[0] = (__bf16)a[0]; r[1] = (__bf16)a[1]; r[2] = (__bf16)a[2]; r[3] = (__bf16)a[3]; r[4] = (__bf16)b[0]; r[5] = (__bf16)b[1]; r[6] = (__bf16)b[2]; r[7] = (__bf16)b[3]; return r;
}
__device__ __forceinline__ void unpack8(u32x4 u, float (&f)[8]) {
    f[0] = bflo(u.x); f[1] = bfhi(u.x); f[2] = bflo(u.y); f[3] = bfhi(u.y); f[4] = bflo(u.z); f[5] = bfhi(u.z); f[6] = bflo(u.w); f[7] = bfhi(u.w);
}
__device__ __forceinline__ int permpos(int s) { return (s & ~12) | ((s & 4) << 1) | ((s & 8) >> 1); }

#define XB_TMO      128
#define XB_XCNT(j)  (256  + 64 * (j))
#define XB_XSUB(j)  (1280 + 64 * (j))
#define XB_XGEN(j)  (2304 + 64 * (j))
#define XB_TOP      3328
#define XB_TOPGEN   3392
#define XCD_BAR_WORDS 3456
#define CW_Q2 3520
#define CW_Q3 3584
#define CW_SAMPLE 3648
#define CW_AS 3712
#define CW_COL 3776
#define XB_SPIN_CAP (1u << 22)
#define LAS __attribute__((address_space(3)))
__device__ __forceinline__ unsigned xb_ld(unsigned* p)              { return __hip_atomic_load(p, __ATOMIC_RELAXED, __HIP_MEMORY_SCOPE_AGENT); }
__device__ __forceinline__ unsigned xb_add(unsigned* p, unsigned v) { return __hip_atomic_fetch_add(p, v, __ATOMIC_RELAXED, __HIP_MEMORY_SCOPE_AGENT); }
__device__ __forceinline__ unsigned xb_xcc_id() { return (unsigned)__builtin_amdgcn_s_getreg((3 << 11) | 20) & 0xFu; }
#define XB_SPIN(cond, bar) do { unsigned _sp = 0; while (cond) { __builtin_amdgcn_s_sleep(1); \
    if ((++_sp & 255u) == 0u) { if (xb_ld(&(bar)[XB_TMO])) break; if (_sp > XB_SPIN_CAP) { atomicAdd(&(bar)[XB_TMO], 1u); break; } } } } while (0)
struct XcdBarrier { unsigned* bar; unsigned x; volatile LAS unsigned* st; };
__device__ __forceinline__ XcdBarrier xcd_barrier_post(unsigned* bar, volatile LAS unsigned* st) {
    XcdBarrier b; b.bar = bar; b.x = xb_xcc_id(); b.st = st;
    if (threadIdx.x == 0) (void)xb_add(&bar[XB_XCNT(b.x)], 1u);
    return b;
}
__device__ __forceinline__ void xcd_barrier_complete(unsigned* bar, unsigned x, unsigned& nloc, unsigned& nx) {
    const unsigned G = gridDim.x * gridDim.y * gridDim.z;
    unsigned sum, cnt, mine, sp = 0u;
    for (;;) {
        sum = 0u; cnt = 0u; mine = 0u;
#pragma unroll
        for (unsigned j = 0; j < 16; ++j) { const unsigned c = xb_ld(&bar[XB_XCNT(j)]); sum += c; cnt += (c > 0u) ? 1u : 0u; mine = (j == x) ? c : mine; }
        if (sum == G) break;
        __builtin_amdgcn_s_sleep(1);
        if ((++sp & 255u) == 0u) { if (xb_ld(&bar[XB_TMO])) break; if (sp > XB_SPIN_CAP) { atomicAdd(&bar[XB_TMO], 1u); break; } }
    }
    nloc = mine > 0u ? mine : 1u; nx = cnt > 0u ? cnt : 1u;
}
__device__ __forceinline__ void xcd_barrier(const XcdBarrier& b) {
    asm volatile("s_waitcnt vmcnt(0)" ::: "memory");
    __syncthreads();
    if (threadIdx.x == 0) {
        unsigned* bar = b.bar;
        __builtin_amdgcn_s_waitcnt(0);
        unsigned nloc = b.st[0], nx = b.st[1];
        if (nloc == 0u) { xcd_barrier_complete(bar, b.x, nloc, nx); b.st[0] = nloc; b.st[1] = nx; }
        const unsigned old = xb_add(&bar[XB_XSUB(b.x)], 1u);
        const unsigned gen = old / nloc;
        if (old + 1u == (gen + 1u) * nloc) {
            __builtin_amdgcn_fence(__ATOMIC_RELEASE, "agent");
            asm volatile("s_waitcnt vmcnt(0)" ::: "memory");
            const unsigned og = xb_add(&bar[XB_TOP], 1u);
            const unsigned tg = og / nx;
            if (og + 1u == (tg + 1u) * nx) xb_add(&bar[XB_TOPGEN], 1u);
            else XB_SPIN(xb_ld(&bar[XB_TOPGEN]) == tg, bar);
            __builtin_amdgcn_fence(__ATOMIC_ACQUIRE, "agent");
            xb_add(&bar[XB_XGEN(b.x)], 1u);
            asm volatile("s_waitcnt vmcnt(0)" ::: "memory");
        } else {
            XB_SPIN(xb_ld(&bar[XB_XGEN(b.x)]) == gen, bar);
            __builtin_amdgcn_fence(__ATOMIC_ACQUIRE, "agent");
            asm volatile("s_waitcnt vmcnt(0)" ::: "memory");
        }
    }
    __syncthreads();
}

template <int KS, bool SW>
__device__ __forceinline__ void gemm_2x2(const u32x4* __restrict__ wf, const unsigned char* xl, int xstride, int lane, f32x16 (&acc)[2][2]) {
    constexpr int PF = 8;
    static_assert(KS % PF == 0, "KS must be a multiple of the prefetch depth");
    const int l31 = lane & 31, hh = lane >> 5;
    const unsigned char* x0 = xl + l31 * xstride + hh * 16;
    const unsigned char* x1 = x0 + 32 * xstride;
    const u32x4* w0 = wf + lane;
    const u32x4* w1 = wf + KS * 64 + lane;
    u32x4 ra[PF], rb[PF];
#pragma unroll
    for (int u = 0; u < PF; ++u) { ra[u] = w0[u * 64]; rb[u] = w1[u * 64]; }
#pragma unroll 1
    for (int k0 = 0; k0 < KS; k0 += PF) {
#pragma unroll
        for (int u = 0; u < PF; ++u) {
            const int ks = k0 + u;
            const bf16x8 b0 = *(const bf16x8*)(x0 + ks * 32);
            const bf16x8 b1 = *(const bf16x8*)(x1 + ks * 32);
            const bf16x8 a0 = __builtin_bit_cast(bf16x8, ra[u]);
            const bf16x8 a1 = __builtin_bit_cast(bf16x8, rb[u]);
            if (KS > PF) { ra[u] = w0[(ks + PF) * 64]; rb[u] = w1[(ks + PF) * 64]; }
            __builtin_amdgcn_sched_barrier(0);
            if (SW) {
                acc[0][0] = mfma32(a0, b0, acc[0][0]); acc[0][1] = mfma32(a0, b1, acc[0][1]);
                acc[1][0] = mfma32(a1, b0, acc[1][0]); acc[1][1] = mfma32(a1, b1, acc[1][1]);
            } else {
                acc[0][0] = mfma32(b0, a0, acc[0][0]); acc[0][1] = mfma32(b1, a0, acc[0][1]);
                acc[1][0] = mfma32(b0, a1, acc[1][0]); acc[1][1] = mfma32(b1, a1, acc[1][1]);
            }
            __builtin_amdgcn_sched_barrier(0);
        }
    }
}
constexpr int GPF = 8;
template <int KS, bool SW>
__device__ __forceinline__ void gemm_2x2_stream(const u32x4* __restrict__ wf, const u32x4* __restrict__ wfn, bool fill, const unsigned char* xl, int xstride, int lane,
                                                f32x16 (&acc)[2][2], u32x4 (&ra)[GPF], u32x4 (&rb)[GPF]) {
    static_assert(KS % GPF == 0 && KS >= 2 * GPF, "KS must be a multiple of (and larger than) the prefetch depth");
    const int l31 = lane & 31, hh = lane >> 5;
    const unsigned char* x0 = xl + l31 * xstride + hh * 16;
    const unsigned char* x1 = x0 + 32 * xstride;
    const u32x4* w0 = wf + lane;
    const u32x4* w1 = wf + KS * 64 + lane;
    if (fill) {
#pragma unroll
        for (int u = 0; u < GPF; ++u) { ra[u] = w0[u * 64]; rb[u] = w1[u * 64]; }
    }
    bf16x8 b0 = *(const bf16x8*)(x0), b1 = *(const bf16x8*)(x1);
#pragma unroll 1
    for (int k0 = 0; k0 < KS; k0 += GPF) {
        const bool last = (k0 + GPF >= KS);
        const u32x4* n0 = last ? (wfn + lane) : (w0 + (k0 + GPF) * 64);
        const u32x4* n1 = last ? (wfn + KS * 64 + lane) : (w1 + (k0 + GPF) * 64);
#pragma unroll
        for (int u = 0; u < GPF; ++u) {
            const int ks = k0 + u;
            const bf16x8 nb0 = *(const bf16x8*)(x0 + (ks + 1) * 32);
            const bf16x8 nb1 = *(const bf16x8*)(x1 + (ks + 1) * 32);
            const bf16x8 a0 = __builtin_bit_cast(bf16x8, ra[u]);
            const bf16x8 a1 = __builtin_bit_cast(bf16x8, rb[u]);
            ra[u] = n0[u * 64]; rb[u] = n1[u * 64];
            __builtin_amdgcn_sched_barrier(0);
            if (SW) {
                acc[0][0] = mfma32(a0, b0, acc[0][0]); acc[0][1] = mfma32(a0, b1, acc[0][1]);
                acc[1][0] = mfma32(a1, b0, acc[1][0]); acc[1][1] = mfma32(a1, b1, acc[1][1]);
            } else {
                acc[0][0] = mfma32(b0, a0, acc[0][0]); acc[0][1] = mfma32(b1, a0, acc[0][1]);
                acc[1][0] = mfma32(b0, a1, acc[1][0]); acc[1][1] = mfma32(b1, a1, acc[1][1]);
            }
            __builtin_amdgcn_sched_barrier(0);
            b0 = nb0; b1 = nb1;
        }
    }
}
__device__ __forceinline__ void zero_acc(f32x16 (&acc)[2][2]) {
#pragma unroll
    for (int a = 0; a < 2; ++a)
#pragma unroll
        for (int b = 0; b < 2; ++b)
#pragma unroll
            for (int r = 0; r < 16; ++r) acc[a][b][r] = 0.f;
}
template <int MODE>
__device__ __forceinline__ void store_nat(const f32x16 (&acc)[2][2], __bf16* dst, int ld, int col0, int lane) {
    const int l31 = lane & 31, hh = lane >> 5;
#pragma unroll
    for (int nt = 0; nt < 2; ++nt)
#pragma unroll
        for (int mt = 0; mt < 2; ++mt)
#pragma unroll
            for (int g = 0; g < 4; ++g) {
                float v[4];
#pragma unroll
                for (int i = 0; i < 4; ++i) {
                    float t = acc[nt][mt][4 * g + i];
                    if (MODE == 1) t = siluf(t);
                    if (MODE == 2) t *= 0.125f;
                    if (MODE == 3) t *= QSCALE;
                    v[i] = t;
                }
                *(u32x2*)(dst + (size_t)(32 * mt + l31) * ld + col0 + 32 * nt + 8 * g + 4 * hh) = pk4(v[0], v[1], v[2], v[3]);
            }
}
__device__ __forceinline__ void store_tr(const f32x16 (&acc)[2][2], __bf16* dst, int group, int NT, int rowtile0, int s0, int lane) {
#pragma unroll
    for (int nt = 0; nt < 2; ++nt)
#pragma unroll
        for (int mt = 0; mt < 2; ++mt)
#pragma unroll
            for (int g = 0; g < 4; ++g) {
                const int k16 = (s0 >> 4) + 2 * mt + (g >> 1);
                *(u32x2*)(dst + ((((size_t)group * 128 + k16) * NT + rowtile0 + nt) * 64 + lane) * 8 + 4 * (g & 1)) =
                    pk4(acc[nt][mt][4 * g], acc[nt][mt][4 * g + 1], acc[nt][mt][4 * g + 2], acc[nt][mt][4 * g + 3]);
            }
}

__device__ __forceinline__ int win_col(int np) {
    if (np < 384) return np;
    if (np < 896) return 416 + (np - 384);
    if (np < 1152) return 928 + (np - 896);
    if (np < 1408) return 1184 + (np - 1152);
    if (np < 1920) return 1440 + (np - 1408);
    if (np < 2432) return 1968 + (np - 1920);
    if (np < 2464) return 384 + (np - 2432);
    if (np < 2480) return 1952 + (np - 2464);
    return -1;
}
__device__ void p0_mod_item(const Params& p, int item, unsigned char* lds) {
    int tid = threadIdx.x; asm volatile("" : "+v"(tid));
    const int lane = tid & 63, w = tid >> 6, l31 = lane & 31, hh = lane >> 5;
    const int n0 = item * 32;
    float* mod = (float*)(p.ws + WS_MOD);
    f32x16 acc[5];
#pragma unroll
    for (int m = 0; m < 5; ++m)
#pragma unroll
        for (int r = 0; r < 16; ++r) acc[m][r] = 0.f;
    float aN[8]; f32x4 c0N[5], c1N[5];
    const float* cp[5];
#pragma unroll
    for (int m = 0; m < 5; ++m) { const int row = min(32 * m + l31, 135); cp[m] = (row < 8) ? (p.c_prompt + (size_t)row * 1024) : (p.c_sample + (size_t)(row - 8) * 1024); }
#define MOD_LOAD(k8_) do { const int k0_ = 16 * (8 * w + (k8_)) + 8 * hh; \
        _Pragma("unroll") for (int j = 0; j < 8; ++j) aN[j] = p.w_ada[(size_t)(k0_ + j) * 3072 + n0 + l31]; \
        _Pragma("unroll") for (int m = 0; m < 5; ++m) { c0N[m] = *(const f32x4*)(cp[m] + k0_); c1N[m] = *(const f32x4*)(cp[m] + k0_ + 4); } } while (0)
    MOD_LOAD(0);
#pragma unroll 1
    for (int k8 = 0; k8 < 8; ++k8) {
        float aC[8]; f32x4 c0C[5], c1C[5];
#pragma unroll
        for (int j = 0; j < 8; ++j) aC[j] = aN[j];
#pragma unroll
        for (int m = 0; m < 5; ++m) { c0C[m] = c0N[m]; c1C[m] = c1N[m]; }
        MOD_LOAD(k8 < 7 ? k8 + 1 : 7);
        __builtin_amdgcn_sched_barrier(0);
        bf16x8 a;
#pragma unroll
        for (int j = 0; j < 8; ++j) a[j] = (__bf16)aC[j];
#pragma unroll
        for (int m = 0; m < 5; ++m) {
            bf16x8 bq;
            const bool live = (32 * m + l31) < 136;
#pragma unroll
            for (int j = 0; j < 4; ++j) { bq[j] = (__bf16)(live ? siluf(c0C[m][j]) : 0.f); bq[4 + j] = (__bf16)(live ? siluf(c1C[m][j]) : 0.f); }
            acc[m] = mfma32(a, bq, acc[m]);
        }
        __builtin_amdgcn_sched_barrier(0);
    }
#undef MOD_LOAD
    float* red = (float*)(lds + LDS_BASE);
#pragma unroll
    for (int m = 0; m < 5; ++m) {
#pragma unroll
        for (int r = 0; r < 16; ++r) red[(w * 16 + r) * 64 + lane] = acc[m][r];
        __syncthreads();
#pragma unroll
        for (int q = 0; q < 2; ++q) {
            const int o = tid + 512 * q, r = o >> 6, ln = o & 63;
            float s = 0.f;
#pragma unroll
            for (int ww = 0; ww < 8; ++ww) s += red[(ww * 16 + r) * 64 + ln];
            const int n = n0 + (r & 3) + 8 * (r >> 2) + 4 * (ln >> 5), row = 32 * m + (ln & 31);
            if (row < 136) mod[(size_t)row * 3072 + n] = s + p.b_ada[n];
        }
        __syncthreads();
    }
}
__device__ void p0_convert(const Params& p) {
    int tid0 = threadIdx.x; asm volatile("" : "+v"(tid0));
    const int nmod = (gridDim.x > 128) ? 96 : 0;
    if ((int)blockIdx.x < nmod) return;
    const int gt = ((int)blockIdx.x - nmod) * NTHR + tid0, GT = ((int)gridDim.x - nmod) * NTHR;
    u32x4* winf = (u32x4*)(p.ws + WS_WINF);
    for (int idx = gt; idx < 78 * 64 * 64; idx += GT) {
        const int lane = idx & 63, fk = idx >> 6, ks = fk & 63, nt = fk >> 6;
        const int col = win_col(nt * 32 + (lane & 31)), k0 = ks * 16 + 8 * (lane >> 5);
        float v[8];
#pragma unroll
        for (int j = 0; j < 8; ++j) v[j] = (col >= 0) ? p.w_in[(size_t)(k0 + j) * 2480 + col] : 0.f;
        u32x4 o; o.x = pk2(v[0], v[1]); o.y = pk2(v[2], v[3]); o.z = pk2(v[4], v[5]); o.w = pk2(v[6], v[7]);
        winf[idx] = o;
    }
    u32x4* wuqf = (u32x4*)(p.ws + WS_WUQF);
    for (int idx = gt; idx < 24 * 16 * 64; idx += GT) {
        const int lane = idx & 63, fk = idx >> 6, ks = fk & 15, nt = fk >> 4;
        const int n = nt * 32 + (lane & 31), k0 = ks * 16 + 8 * (lane >> 5);
        float v[8];
#pragma unroll
        for (int j = 0; j < 8; ++j) v[j] = p.w_uq[(size_t)(k0 + j) * 768 + n];
        u32x4 o; o.x = pk2(v[0], v[1]); o.y = pk2(v[2], v[3]); o.z = pk2(v[4], v[5]); o.w = pk2(v[6], v[7]);
        wuqf[idx] = o;
    }
    u32x4* wkvf = (u32x4*)(p.ws + WS_WKVF);
    for (int idx = gt; idx < 32 * 8 * 64; idx += GT) {
        const int lane = idx & 63, fk = idx >> 6, ks = fk & 7, nt = fk >> 3;
        const int n = nt * 32 + (lane & 31), k0 = ks * 16 + 8 * (lane >> 5);
        float v[8];
#pragma unroll
        for (int j = 0; j < 8; ++j) v[j] = (n < 512) ? p.w_uk[(size_t)(k0 + j) * 512 + n] : p.w_uv[(size_t)(k0 + j) * 512 + (n - 512)];
        u32x4 o; o.x = pk2(v[0], v[1]); o.y = pk2(v[2], v[3]); o.z = pk2(v[4], v[5]); o.w = pk2(v[6], v[7]);
        wkvf[idx] = o;
    }
    u32x4* woutf = (u32x4*)(p.ws + WS_WOUTF);
    for (int idx = gt; idx < 32 * 64 * 64; idx += GT) {
        const int lane = idx & 63, fk = idx >> 6, ks = fk & 63, nt = fk >> 6;
        const int n = nt * 32 + (lane & 31), k0 = ks * 16 + 8 * (lane >> 5);
        float v[8];
#pragma unroll
        for (int j = 0; j < 8; ++j) v[j] = p.w_out[(size_t)(k0 + j) * 1024 + n];
        u32x4 o; o.x = pk2(v[0], v[1]); o.y = pk2(v[2], v[3]); o.z = pk2(v[4], v[5]); o.w = pk2(v[6], v[7]);
        woutf[idx] = o;
    }
    __bf16* wukb = (__bf16*)(p.ws + WS_WUKB);
    __bf16* wuvt = (__bf16*)(p.ws + WS_WUVT);
    for (int idx = gt; idx < 65536; idx += GT) {
        wukb[idx] = (__bf16)p.w_uk[idx];
        const int r = idx & 127, v = (idx >> 7) & 63, h = idx >> 13;
        wuvt[idx] = (__bf16)p.w_uv[(size_t)r * 512 + h * 64 + v];
    }
    float* rope = (float*)(p.ws + WS_ROPE);
    for (int idx = gt; idx < 2049 * 16; idx += GT) {
        const int pi = idx >> 4, i = idx & 15;
        const float pos = (pi == 2048) ? 8192.f : (float)pi;
        const float inv = __builtin_amdgcn_exp2f(-(float)(2 * i) * (13.287712379549449f / 32.f));
        const double rev = (double)(pos * inv) * 0.15915494309189535;
        const float fr = (float)(rev - floor(rev));
        const float s = __builtin_amdgcn_sinf(fr), c = __builtin_amdgcn_cosf(fr);
        rope[pi * 32 + i] = c; rope[pi * 32 + 16 + i] = s;
    }
}

constexpr int XS = 2064;
constexpr int ZS = 1808;

__device__ __forceinline__ void p1_post(const Params& p, int it, unsigned char* lds);
__device__ void p1_stripe(const Params& p, int it, int mode, unsigned char* lds) {
    int tid = threadIdx.x; asm volatile("" : "+v"(tid));
    const int lane = tid & 63, w = tid >> 6, l31 = lane & 31, hh = lane >> 5;
    const bool is_s = it >= 256;
    const int srow0 = is_s ? (it - 256) * 64 : 0;
    const int tok0 = is_s ? NTOK + srow0 : it * 64;
    const int b = it >> 5, s0 = (it & 31) * 64;
    unsigned char* A = lds + LDS_BASE;
    const float* mod = (const float*)(p.ws + WS_MOD);
    const float* rope = (const float*)(p.ws + WS_ROPE);
    {
        const int c4 = tid & 255, rb = tid >> 8;
        if (!is_s) {
            const f32x4 sh = *(const f32x4*)(mod + (size_t)b * 3072 + 4 * c4);
            const f32x4 sc = *(const f32x4*)(mod + (size_t)b * 3072 + 1024 + 4 * c4);
            const float* xr = p.x_prompt + (size_t)(it * 64 + rb) * 1024 + 4 * c4;
            {
                f32x4 x[32];
#pragma unroll
                for (int u = 0; u < 32; ++u) x[u] = *(const f32x4*)(xr + (size_t)u * 2048);
                __builtin_amdgcn_sched_barrier(0);
#pragma unroll
                for (int u = 0; u < 32; ++u)
                    *(u32x2*)(A + (2 * u + rb) * XS + c4 * 8) = pk4(x[u][0] * (1.f + sc[0]) + sh[0], x[u][1] * (1.f + sc[1]) + sh[1], x[u][2] * (1.f + sc[2]) + sh[2], x[u][3] * (1.f + sc[3]) + sh[3]);
            }
        } else {
#pragma unroll 1
            for (int i0 = 0; i0 < 32; i0 += 4) {
                f32x4 x[4], sh[4], sc[4];
#pragma unroll
                for (int u = 0; u < 4; ++u) {
                    const int row = 2 * (i0 + u) + rb;
                    x[u] = *(const f32x4*)(p.x_sample + (size_t)(srow0 + row) * 1024 + 4 * c4);
                    sh[u] = *(const f32x4*)(mod + (size_t)(8 + srow0 + row) * 3072 + 4 * c4);
                    sc[u] = *(const f32x4*)(mod + (size_t)(8 + srow0 + row) * 3072 + 1024 + 4 * c4);
                }
                __builtin_amdgcn_sched_barrier(0);
#pragma unroll
                for (int u = 0; u < 4; ++u)
                    *(u32x2*)(A + (2 * (i0 + u) + rb) * XS + c4 * 8) = pk4(x[u][0] * (1.f + sc[u][0]) + sh[u][0], x[u][1] * (1.f + sc[u][1]) + sh[u][1], x[u][2] * (1.f + sc[u][2]) + sh[u][2], x[u][3] * (1.f + sc[u][3]) + sh[u][3]);
            }
        }
    }
    __syncthreads();
    const u32x4* winf = (const u32x4*)(p.ws + WS_WINF);
    __bf16* GM = (__bf16*)(p.ws + WS_GM); __bf16* GQ = (__bf16*)(p.ws + WS_GQ); __bf16* GK = (__bf16*)(p.ws + WS_GK);
    __bf16* GV = (__bf16*)(p.ws + WS_GV); __bf16* GG = (__bf16*)(p.ws + WS_GG);
    __bf16* GKT = (__bf16*)(p.ws + WS_GKT); __bf16* GVT = (__bf16*)(p.ws + WS_GVT);
    f32x16 acc[2][2];
    u32x4 ringa[GPF], ringb[GPF];
    const int sst = (w < 6) ? w : 38;
    bool fill = true;
#pragma unroll 1
    for (int i = 0; i < 4; ++i) {
        if (mode == 1 || (mode >= 2 && i != mode - 2)) continue;
        const int st = 6 + w + 8 * i;
        const int stn = (mode == 0) ? ((i < 3) ? st + 8 : ((w < 7) ? sst : st)) : st;
        zero_acc(acc);
        const bool tr = (!is_s) && (st >= 22 && st < 30);
        if (tr) gemm_2x2_stream<64, false>(winf + (size_t)st * 2 * 64 * 64, winf + (size_t)stn * 2 * 64 * 64, fill, A, XS, lane, acc, ringa, ringb);
        else    gemm_2x2_stream<64, true >(winf + (size_t)st * 2 * 64 * 64, winf + (size_t)stn * 2 * 64 * 64, fill, A, XS, lane, acc, ringa, ringb);
        fill = (mode != 0);
        int lane2 = lane; asm volatile("" : "+v"(lane2));
        if (st < 14) store_nat<1>(acc, GM + (size_t)tok0 * 512, 512, (st - 6) * 64, lane2);
        else if (st < 18) store_nat<2>(acc, GQ + (size_t)tok0 * 256, 256, (st - 14) * 64, lane2);
        else if (st < 22) {
            store_nat<0>(acc, GK + (size_t)tok0 * 256, 256, (st - 18) * 64, lane2);
            if (!is_s) {
                const int l31b = lane2 & 31, hhb = lane2 >> 5;
                __bf16* gb = GKT + ((((size_t)(b * 4 + (st - 18)) * 128 + (s0 >> 4) + (l31b >> 4)) * 2) * 64 + 32 * ((l31b >> 2) & 1) + 4 * hhb) * 8 + 4 * ((l31b >> 3) & 1) + (l31b & 3);
#pragma unroll
                for (int mt = 0; mt < 2; ++mt)
#pragma unroll
                    for (int nt = 0; nt < 2; ++nt)
#pragma unroll
                        for (int r = 0; r < 16; ++r)
                            gb[(size_t)mt * 2 * 2 * 512 + nt * 512 + ((r & 3) + 8 * (r >> 2)) * 8] = (__bf16)acc[nt][mt][r];
            }
        } else if (st < 30) {
            if (tr) store_tr(acc, GVT, b * 4 + ((st - 22) >> 1), 4, ((st - 22) & 1) * 2, s0, lane2);
            else store_nat<0>(acc, GV + (size_t)tok0 * 512, 512, (st - 22) * 64, lane2);
        } else store_nat<1>(acc, GG + (size_t)tok0 * 512, 512, (st - 30) * 64, lane2);
    }
    if (mode >= 2) { __syncthreads(); return; }
    if (w < 7) { zero_acc(acc); gemm_2x2_stream<64, true>(winf + (size_t)sst * 2 * 64 * 64, winf + (size_t)sst * 2 * 64 * 64, fill, A, XS, lane, acc, ringa, ringb); }
    __syncthreads();
    unsigned char* Z = A;
    if (w < 7) {
        const int cb = (w < 4) ? 64 * w : (w < 6 ? 256 + 64 * (w - 4) : 384);
#pragma unroll
        for (int nt = 0; nt < 2; ++nt)
#pragma unroll
            for (int mt = 0; mt < 2; ++mt)
#pragma unroll
                for (int g = 0; g < 4; ++g) {
                    f32x4 v = {acc[nt][mt][4 * g], acc[nt][mt][4 * g + 1], acc[nt][mt][4 * g + 2], acc[nt][mt][4 * g + 3]};
                    *(f32x4*)(Z + (32 * mt + l31) * ZS + (cb + 32 * nt + 8 * g + 4 * hh) * 4) = v;
                }
    }
    __syncthreads();
    p1_post(p, it, lds);
}

__device__ __forceinline__ void p1_post(const Params& p, int it, unsigned char* lds) {
    int tid = threadIdx.x; asm volatile("" : "+v"(tid));
    const int lane = tid & 63, w = tid >> 6, l31 = lane & 31, hh = lane >> 5;
    const bool is_s = it >= 256;
    const int srow0 = is_s ? (it - 256) * 64 : 0;
    const int tok0 = is_s ? NTOK + srow0 : it * 64;
    const int b = it >> 5, s0 = (it & 31) * 64;
    unsigned char* Z = lds + LDS_BASE;
    const float* rope = (const float*)(p.ws + WS_ROPE);
    f32x16 acc[2][2];
    float* latout = p.out + (is_s ? OUT_LATS + (size_t)srow0 * 128 : OUT_LATP + (size_t)it * 64 * 128);
    for (int rr = 0; rr < 8; ++rr) {
        const int row = 8 * w + rr;
        unsigned char* zr = Z + row * ZS;
        const f32x4 v = *(const f32x4*)(zr + 16 * lane);
        const float ss = wave_sum(v[0] * v[0] + v[1] * v[1] + v[2] * v[2] + v[3] * v[3]);
        const float inv = rsqrtf(ss * (1.f / 256.f) + NORM_EPS);
        const f32x4 g = *(const f32x4*)(p.q_norm_g + 4 * lane);
        const f32x2 c = *(const f32x2*)(zr + 1024 + 8 * lane);
        const float ss2 = wave_sum(c[0] * c[0] + c[1] * c[1]);
        const float inv2 = rsqrtf(ss2 * (1.f / 128.f) + NORM_EPS);
        const f32x2 g2 = *(const f32x2*)(p.kv_norm_g + 2 * lane);
        const float y0 = c[0] * inv2 * g2[0], y1 = c[1] * inv2 * g2[1];
        *(u32x2*)(zr + 8 * lane) = pk4(v[0] * inv * g[0], v[1] * inv * g[1], v[2] * inv * g[2], v[3] * inv * g[3]);
        *(unsigned*)(zr + 1024 + 4 * lane) = pk2(y0, y1);
        f32x2 yo = {y0, y1};
        *(f32x2*)(latout + (size_t)row * 128 + 2 * lane) = yo;
    }
    {
        float* krout = p.out + (is_s ? OUT_KRS + (size_t)srow0 * 32 : OUT_KRP + (size_t)it * 64 * 32);
        __bf16* KR = (__bf16*)(p.ws + WS_KR);
#pragma unroll
        for (int q = 0; q < 2; ++q) {
            const int idx = tid + NTHR * q, row = idx >> 4, i = idx & 15;
            const float* zr = (const float*)(Z + row * ZS);
            const float x1 = zr[384 + i], x2 = zr[400 + i];
            const int pi = is_s ? 2048 : s0 + row;
            const float cs = rope[pi * 32 + i], sn = rope[pi * 32 + 16 + i];
            const float o1 = x1 * cs - x2 * sn, o2 = x2 * cs + x1 * sn;
            krout[row * 32 + i] = o1; krout[row * 32 + 16 + i] = o2;
            if (!is_s) { KR[((size_t)b * 2048 + s0 + row) * 32 + i] = (__bf16)o1; KR[((size_t)b * 2048 + s0 + row) * 32 + 16 + i] = (__bf16)o2; }
        }
    }
    {
        const int n = 32 * w + l31, h = w >> 1, dk = 32 * (w & 1) + l31;
        bf16x8 wb;
#pragma unroll
        for (int e = 0; e < 8; ++e) wb[e] = (__bf16)p.w_gate_up[(8 * hh + e) * 256 + n];
        const float bg = p.b_gate[n];
        f32x16 la[2];
#pragma unroll
        for (int mt = 0; mt < 2; ++mt) {
            const float* zr = (const float*)(Z + (32 * mt + l31) * ZS);
            const bf16x8 ga = cvt8(*(const f32x4*)(zr + 416 + 8 * hh), *(const f32x4*)(zr + 420 + 8 * hh));
#pragma unroll
            for (int r = 0; r < 16; ++r) la[mt][r] = 0.f;
            la[mt] = mfma32(ga, wb, la[mt]);
#pragma unroll
            for (int r = 0; r < 16; ++r) { const float a = la[mt][r] + bg; la[mt][r] = (fminf(a, 0.f) - __logf(1.f + __expf(-fabsf(a)))) * (1.f / 16.f); }
        }
        if (!is_s) {
            float carry = 0.f;
#pragma unroll
            for (int mt = 0; mt < 2; ++mt) {
                float bs[4], ps[4];
#pragma unroll
                for (int g = 0; g < 4; ++g) { bs[g] = (la[mt][4 * g] + la[mt][4 * g + 1]) + (la[mt][4 * g + 2] + la[mt][4 * g + 3]); ps[g] = __shfl_xor(bs[g], 32); }
#pragma unroll
                for (int g = 0; g < 4; ++g) {
                    const float b0s = hh ? ps[g] : bs[g], b1s = hh ? bs[g] : ps[g];
                    float run = carry + (hh ? b0s : 0.f);
#pragma unroll
                    for (int i = 0; i < 4; ++i) { run += la[mt][4 * g + i]; la[mt][4 * g + i] = run; }
                    carry += b0s + b1s;
                }
            }
        }
        float* LAB = (float*)(p.ws + WS_LAB) + (size_t)tok0 * 256 + n;
#pragma unroll
        for (int mt = 0; mt < 2; ++mt)
#pragma unroll
            for (int r = 0; r < 16; ++r) LAB[(size_t)(32 * mt + (r & 3) + 8 * (r >> 2) + 4 * hh) * 256] = la[mt][r];
        if (!is_s) {
            float* BT = (float*)(p.ws + WS_BT);
#pragma unroll
            for (int mt = 0; mt < 2; ++mt)
#pragma unroll
                for (int g = 0; g < 4; ++g) {
                    const int k16 = (s0 >> 4) + 2 * mt + (g >> 1);
                    f32x4 v = {la[mt][4 * g], la[mt][4 * g + 1], la[mt][4 * g + 2], la[mt][4 * g + 3]};
                    *(f32x4*)(BT + ((((size_t)(b * 4 + h) * 128 + k16) * 2 + (w & 1)) * 64 + lane) * 8 + 4 * (g & 1)) = v;
                }
            if (hh) ((float*)(p.ws + WS_BL))[((size_t)(b * 4 + h) * 32 + (s0 >> 6)) * 64 + dk] = la[1][15];
        }
    }
    __syncthreads();
    {
        const u32x4* wuqf = (const u32x4*)(p.ws + WS_WUQF);
        const int h = w;
        const unsigned char* x0 = Z + l31 * ZS + hh * 16;
        const unsigned char* x1 = x0 + 32 * ZS;
        const int qoff = (h < 4) ? 512 + 128 * h : 1280 + 128 * (h - 4);
        __bf16* QLR = (__bf16*)(p.ws + WS_QLR);
        __bf16* Q = (__bf16*)(p.ws + WS_Q) + ((size_t)(b * 8 + h) * 2048 + s0) * 96;
#pragma unroll 1
        for (int j = 0; j < 3; ++j) {
            f32x16 q[2];
#pragma unroll
            for (int m = 0; m < 2; ++m)
#pragma unroll
                for (int r = 0; r < 16; ++r) q[m][r] = 0.f;
            const u32x4* wq = wuqf + (size_t)(3 * h + j) * 16 * 64 + lane;
            u32x4 rq[16];
#pragma unroll
            for (int ks = 0; ks < 16; ++ks) rq[ks] = wq[ks * 64];
            __builtin_amdgcn_sched_barrier(0);
#pragma unroll
            for (int ks = 0; ks < 16; ++ks) {
                const bf16x8 a = __builtin_bit_cast(bf16x8, rq[ks]);
                const bf16x8 b0 = *(const bf16x8*)(x0 + ks * 32), b1 = *(const bf16x8*)(x1 + ks * 32);
                q[0] = mfma32(a, b0, q[0]); q[1] = mfma32(a, b1, q[1]);
            }
            if (j == 2) {
#pragma unroll
                for (int m = 0; m < 2; ++m) {
                    const int pi = is_s ? 2048 : s0 + 32 * m + l31;
#pragma unroll
                    for (int g = 0; g < 2; ++g) {
                        const f32x4 cs = *(const f32x4*)(rope + pi * 32 + 8 * g + 4 * hh);
                        const f32x4 sn = *(const f32x4*)(rope + pi * 32 + 16 + 8 * g + 4 * hh);
#pragma unroll
                        for (int i = 0; i < 4; ++i) {
                            const float x1v = q[m][4 * g + i], x2v = q[m][4 * g + 8 + i];
                            q[m][4 * g + i] = x1v * cs[i] - x2v * sn[i];
                            q[m][4 * g + 8 + i] = x2v * cs[i] + x1v * sn[i];
                        }
                    }
                }
            }
#pragma unroll
            for (int m = 0; m < 2; ++m)
#pragma unroll
                for (int g = 0; g < 4; ++g) {
                    const int tok = 32 * m + l31;
                    if (!is_s) {
                        *(u32x2*)(Q + (size_t)tok * 96 + 32 * j + 8 * g + 4 * hh) = pk4(q[m][4 * g] * QSCALE, q[m][4 * g + 1] * QSCALE, q[m][4 * g + 2] * QSCALE, q[m][4 * g + 3] * QSCALE);
                    } else if (j == 2) {
                        *(u32x2*)(QLR + ((size_t)(srow0 + tok) * 8 + h) * 160 + 128 + 8 * g + 4 * hh) = pk4(q[m][4 * g] * QSCALE, q[m][4 * g + 1] * QSCALE, q[m][4 * g + 2] * QSCALE, q[m][4 * g + 3] * QSCALE);
                    } else {
                        *(u32x2*)(Z + tok * ZS + qoff + (32 * j + 8 * g + 4 * hh) * 2) = pk4(q[m][4 * g], q[m][4 * g + 1], q[m][4 * g + 2], q[m][4 * g + 3]);
                    }
                }
        }
        if (is_s) {
            asm volatile("s_waitcnt lgkmcnt(0)" ::: "memory");
            const __bf16* wukb = (const __bf16*)(p.ws + WS_WUKB);
#pragma unroll 1
            for (int rt = 0; rt < 4; ++rt) {
                f32x16 ql[2];
#pragma unroll
                for (int m = 0; m < 2; ++m)
#pragma unroll
                    for (int r = 0; r < 16; ++r) ql[m][r] = 0.f;
#pragma unroll
                for (int ks = 0; ks < 4; ++ks) {
                    const bf16x8 b0 = *(const bf16x8*)(Z + l31 * ZS + qoff + (16 * ks + 8 * hh) * 2);
                    const bf16x8 b1 = *(const bf16x8*)(Z + (32 + l31) * ZS + qoff + (16 * ks + 8 * hh) * 2);
                    const bf16x8 a = *(const bf16x8*)(wukb + ((size_t)(32 * rt + l31) * 8 + h) * 64 + 16 * ks + 8 * hh);
                    ql[0] = mfma32(a, b0, ql[0]); ql[1] = mfma32(a, b1, ql[1]);
                }
#pragma unroll
                for (int m = 0; m < 2; ++m)
#pragma unroll
                    for (int g = 0; g < 4; ++g)
                        *(u32x2*)(QLR + ((size_t)(srow0 + 32 * m + l31) * 8 + h) * 160 + 32 * rt + 8 * g + 4 * hh) =
                            pk4(ql[m][4 * g] * QSCALE, ql[m][4 * g + 1] * QSCALE, ql[m][4 * g + 2] * QSCALE, ql[m][4 * g + 3] * QSCALE);
            }
        }
    }
    if (!is_s) {
        const u32x4* wkvf = (const u32x4*)(p.ws + WS_WKVF);
        __bf16* KN = (__bf16*)(p.ws + WS_KN);
        __bf16* VT = (__bf16*)(p.ws + WS_VT);
#pragma unroll 1
        for (int pp = 0; pp < 2; ++pp) {
            const int nt0 = 4 * w + 2 * pp;
            zero_acc(acc);
            if (w < 4) {
                gemm_2x2<8, true>(wkvf + (size_t)nt0 * 8 * 64, Z + 1024, ZS, lane, acc);
                const int hd = nt0 >> 1;
                store_nat<0>(acc, KN + ((size_t)(b * 8 + hd) * 2048 + s0) * 64, 64, 0, lane);
            } else {
                gemm_2x2<8, false>(wkvf + (size_t)nt0 * 8 * 64, Z + 1024, ZS, lane, acc);
                const int hd = (nt0 - 16) >> 1;
                store_tr(acc, VT, b * 8 + hd, 2, 0, s0, lane);
            }
        }
    }
    __syncthreads();
}

constexpr int KST = 208, VST = 144;
constexpr int KBUF = 64 * KST, VBUF = 8192;

__device__ void p2_attn(const Params& p, int bh, int qb, unsigned char* lds) {
    int tid = threadIdx.x; asm volatile("" : "+v"(tid));
    const int lane = tid & 63, w = tid >> 6, l31 = lane & 31, hh = lane >> 5;
    const int b = bh >> 3, h = bh & 7;
    const __bf16* Q = (const __bf16*)(p.ws + WS_Q) + (size_t)bh * 2048 * 96;
    const __bf16* KN = (const __bf16*)(p.ws + WS_KN) + (size_t)bh * 2048 * 64;
    const __bf16* KR = (const __bf16*)(p.ws + WS_KR) + (size_t)b * 2048 * 32;
    const __bf16* VT = (const __bf16*)(p.ws + WS_VT) + (size_t)bh * 64 * 2048;
    unsigned char* Kb = lds + LDS_BASE;
    unsigned char* Vb = Kb + 2 * KBUF;
    const int qrow0 = qb * 256 + 32 * w, qi = qrow0 + l31;
    bf16x8 qf[6];
#pragma unroll
    for (int ks = 0; ks < 6; ++ks) qf[ks] = *(const bf16x8*)(Q + (size_t)qi * 96 + 16 * ks + 8 * hh);
    f32x16 o[2];
#pragma unroll
    for (int d = 0; d < 2; ++d)
#pragma unroll
        for (int r = 0; r < 16; ++r) o[d][r] = 0.f;
    float m = -1e30f, l = 0.f;
    const int nkt = (qb + 1) * 4;
    const int key_k = tid >> 3, ch_k = tid & 7, key_r = tid >> 2, ch_r = tid & 3;
    u32x4 kA, rA = {0u, 0u, 0u, 0u}, vA, kB, rB = {0u, 0u, 0u, 0u}, vB;
#define ATT_LOAD(kx, rx, vx, jt_) do { const int jc_ = ((jt_) < nkt) ? (jt_) : (nkt - 1); const int k0_ = 64 * jc_; \
        kx = *(const u32x4*)(KN + (size_t)(k0_ + key_k) * 64 + 8 * ch_k); \
        if (tid < 256) rx = *(const u32x4*)(KR + (size_t)(k0_ + key_r) * 32 + 8 * ch_r); \
        vx = *(const u32x4*)(VT + (size_t)jc_ * 4096 + (size_t)tid * 8); } while (0)
#define ATT_STORE(kx, rx, vx, buf_) do { unsigned char* kn_ = Kb + (buf_) * KBUF; unsigned char* vn_ = Vb + (buf_) * VBUF; \
        *(u32x4*)(kn_ + key_k * KST + ch_k * 16) = kx; \
        if (tid < 256) *(u32x4*)(kn_ + key_r * KST + 128 + ch_r * 16) = rx; \
        *(u32x4*)(vn_ + tid * 16) = vx; } while (0)
#define ATT_COMPUTE(j_, cur_) do { \
        const unsigned char* kb = Kb + (cur_) * KBUF; \
        const unsigned char* vb = Vb + (cur_) * VBUF; \
        _Pragma("unroll") for (int sub = 0; sub < 2; ++sub) { \
            const int key_lo = 64 * (j_) + 32 * sub; \
            if (key_lo <= qrow0 + 31) { \
                f32x16 s; \
                _Pragma("unroll") for (int r = 0; r < 16; ++r) s[r] = 0.f; \
                _Pragma("unroll") for (int ks = 0; ks < 6; ++ks) { \
                    const bf16x8 kf = *(const bf16x8*)(kb + (32 * sub + l31) * KST + (16 * ks + 8 * hh) * 2); \
                    s = mfma32(kf, qf[ks], s); } \
                if (key_lo + 31 > qrow0) { \
                    _Pragma("unroll") for (int r = 0; r < 16; ++r) { const int key = key_lo + (r & 3) + 8 * (r >> 2) + 4 * hh; if (key > qi) s[r] = -1e30f; } } \
                float mx = s[0]; \
                _Pragma("unroll") for (int r = 1; r < 16; ++r) mx = fmaxf(mx, s[r]); \
                mx = fmaxf(mx, __shfl_xor(mx, 32)); \
                const float mn = fmaxf(m, mx), alpha = ex2(m - mn); \
                m = mn; \
                float ps = 0.f; \
                _Pragma("unroll") for (int r = 0; r < 16; ++r) { s[r] = ex2(s[r] - mn); ps += s[r]; } \
                l = l * alpha + ps; \
                _Pragma("unroll") for (int d = 0; d < 2; ++d) _Pragma("unroll") for (int r = 0; r < 16; ++r) o[d][r] *= alpha; \
                _Pragma("unroll") for (int sk = 0; sk < 2; ++sk) { \
                    bf16x8 pf; \
                    _Pragma("unroll") for (int e = 0; e < 8; ++e) pf[e] = (__bf16)s[8 * sk + e]; \
                    _Pragma("unroll") for (int d = 0; d < 2; ++d) { \
                        const bf16x8 vf = *(const bf16x8*)(vb + ((2 * sub + sk) * 2 + d) * 1024 + lane * 16); \
                        o[d] = mfma32(vf, pf, o[d]); } } } } } while (0)
    ATT_LOAD(kA, rA, vA, 0);
    ATT_LOAD(kB, rB, vB, 1);
    ATT_STORE(kA, rA, vA, 0);
    ATT_LOAD(kA, rA, vA, 2);
    __syncthreads();
    for (int j = 0; j < nkt; j += 2) {
        ATT_COMPUTE(j, 0);
        ATT_STORE(kB, rB, vB, 1);
        ATT_LOAD(kB, rB, vB, j + 3);
        __syncthreads();
        ATT_COMPUTE(j + 1, 1);
        ATT_STORE(kA, rA, vA, 0);
        ATT_LOAD(kA, rA, vA, j + 4);
        __syncthreads();
    }
#undef ATT_LOAD
#undef ATT_STORE
#undef ATT_COMPUTE
    const float lt = l + __shfl_xor(l, 32);
    const float inv = 1.f / lt;
    __bf16* AO = (__bf16*)(p.ws + WS_AO) + ((size_t)b * 2048 + qi) * 512 + h * 64;
#pragma unroll
    for (int d = 0; d < 2; ++d)
#pragma unroll
        for (int g = 0; g < 4; ++g)
            *(u32x2*)(AO + 32 * d + 8 * g + 4 * hh) = pk4(o[d][4 * g] * inv, o[d][4 * g + 1] * inv, o[d][4 * g + 2] * inv, o[d][4 * g + 3] * inv);
}

constexpr int DVS = 80;
constexpr int DW_BYTES = 8192 + 32 * DVS + 16 * DVS;
typedef short s16x4 __attribute__((ext_vector_type(4)));
__device__ __forceinline__ f32x4 mfma16(bf16x8 a, bf16x8 b, f32x4 c) { return __builtin_amdgcn_mfma_f32_16x16x32_bf16(a, b, c, 0, 0, 0); }
__device__ __forceinline__ s16x4 lds_tr16(const unsigned char* q) { return __builtin_amdgcn_ds_read_tr16_b64_v4i16((LAS s16x4*)q); }
__device__ void p2_decode(const Params& p, int bs, int split, unsigned char* lds) {
    int tid = threadIdx.x; asm volatile("" : "+v"(tid));
    const int lane = tid & 63, w = tid >> 6, l15 = lane & 15, q4 = lane >> 4;
    unsigned char* IMG = lds + LDS_BASE + w * DW_BYTES;
    unsigned char* KRI = IMG + 8192;
    unsigned char* WP = KRI + 32 * DVS;
    const __bf16* QLR = (const __bf16*)(p.ws + WS_QLR);
    const int pg0 = split * 16 + 2 * w;
    const int phys0 = p.page_table[bs * NPAGES + pg0], phys1 = p.page_table[bs * NPAGES + pg0 + 1];
    f32x4 raw[20];
#define DEC_ISSUE(tt_) do { const int phys_ = ((tt_) >> 2) ? phys1 : phys0; \
        const float* lp_ = p.cache_lat + ((size_t)phys_ * 128 + ((tt_) & 3) * 32) * 128 + 4 * lane; \
        const float* kp_ = p.cache_kr + ((size_t)phys_ * 128 + ((tt_) & 3) * 32) * 32 + 4 * lane; \
        _Pragma("unroll") for (int i = 0; i < 16; ++i) raw[i] = *(const f32x4*)(lp_ + 256 * i); \
        _Pragma("unroll") for (int i = 0; i < 4; ++i) raw[16 + i] = *(const f32x4*)(kp_ + 256 * i); } while (0)
    DEC_ISSUE(0);
    bf16x8 qf[5];
#pragma unroll
    for (int ks = 0; ks < 5; ++ks) {
        u32x4 v = *(const u32x4*)(QLR + ((size_t)bs * 8 + (l15 & 7)) * 160 + 32 * ks + 8 * q4);
        if (l15 >= 8) v = (u32x4){0u, 0u, 0u, 0u};
        qf[ks] = __builtin_bit_cast(bf16x8, v);
    }
    const int hi = lane >> 5;
    const int W0 = 256 * hi + 16 * (((lane & 31) >> 1) ^ (hi << 2)) + 8 * (lane & 1);
    const int KW0 = (lane >> 3) * DVS + 8 * (lane & 7);
    const int RB0 = 256 * l15 + 16 * (q4 ^ (l15 >> 2)) + 64 * (l15 & 3);
    const int TQ = l15 >> 2, TP = lane & 3;
    const int T00 = 256 * (8 * q4 + TQ) + 16 * ((TP >> 1) ^ ((TQ << 2) | ((2 * q4) & 3))) + 8 * (TP & 1);
    const int T01 = 256 * (8 * q4 + 4 + TQ) + 16 * ((TP >> 1) ^ ((TQ << 2) | ((2 * q4 + 1) & 3))) + 8 * (TP & 1);
    f32x4 o[8];
#pragma unroll
    for (int t = 0; t < 8; ++t) o[t] = (f32x4){0.f, 0.f, 0.f, 0.f};
    float m = -1e30f, l = 0.f;
#pragma unroll 1
    for (int tt = 0; tt < 8; ++tt) {
#pragma unroll
        for (int i = 0; i < 16; ++i) {
            const int ci = (((2 * i) & 3) << 2) | ((i >> 1) & 3);
            *(u32x2*)(IMG + 512 * i + (W0 ^ (ci << 4))) = pk4(raw[i][0], raw[i][1], raw[i][2], raw[i][3]);
        }
#pragma unroll
        for (int i = 0; i < 4; ++i) *(u32x2*)(KRI + 8 * i * DVS + KW0) = pk4(raw[16 + i][0], raw[16 + i][1], raw[16 + i][2], raw[16 + i][3]);
        asm volatile("" ::: "memory");
        DEC_ISSUE(tt < 7 ? tt + 1 : 7);
        f32x4 s[2];
#pragma unroll
        for (int j = 0; j < 2; ++j) {
            s[j] = (f32x4){0.f, 0.f, 0.f, 0.f};
#pragma unroll
            for (int ks = 0; ks < 4; ++ks) {
                const bf16x8 kf = *(const bf16x8*)(IMG + 4096 * j + (RB0 ^ (ks << 6)));
                s[j] = mfma16(kf, qf[ks], s[j]);
            }
            const bf16x8 kf = *(const bf16x8*)(KRI + (16 * j + l15) * DVS + 16 * q4);
            s[j] = mfma16(kf, qf[4], s[j]);
        }
        float mx = fmaxf(fmaxf(fmaxf(s[0][0], s[0][1]), fmaxf(s[0][2], s[0][3])), fmaxf(fmaxf(s[1][0], s[1][1]), fmaxf(s[1][2], s[1][3])));
        mx = fmaxf(mx, __shfl_xor(mx, 16)); mx = fmaxf(mx, __shfl_xor(mx, 32));
        const float mn = fmaxf(m, mx), alpha = ex2(m - mn);
        m = mn;
        float ps = 0.f;
#pragma unroll
        for (int j = 0; j < 2; ++j)
#pragma unroll
            for (int r = 0; r < 4; ++r) { s[j][r] = ex2(s[j][r] - mn); ps += s[j][r]; }
        l = l * alpha + ps;
#pragma unroll
        for (int t = 0; t < 8; ++t) o[t] *= alpha;
#pragma unroll
        for (int j = 0; j < 2; ++j) *(u32x2*)(WP + l15 * DVS + (16 * j + 4 * q4) * 2) = pk4(s[j][0], s[j][1], s[j][2], s[j][3]);
        {
            const bf16x8 pf = *(const bf16x8*)(WP + l15 * DVS + 8 * q4 * 2);
#pragma unroll
            for (int t = 0; t < 8; ++t) {
                const s16x4 v0 = lds_tr16(IMG + (T00 ^ (t << 5))), v1 = lds_tr16(IMG + (T01 ^ (t << 5)));
                typedef short s16x8 __attribute__((ext_vector_type(8)));
                const s16x8 vv = {v0[0], v0[1], v0[2], v0[3], v1[0], v1[1], v1[2], v1[3]};
                o[t] = mfma16(__builtin_bit_cast(bf16x8, vv), pf, o[t]);
            }
        }
    }
#undef DEC_ISSUE
    float lt = l + __shfl_xor(l, 16); lt += __shfl_xor(lt, 32);
    __syncthreads();
    float* MG = (float*)(lds + LDS_BASE);
    if (l15 < 8) {
        float* rec = MG + (w * 8 + l15) * 132;
        if (q4 == 0) { rec[0] = m; rec[1] = lt; }
#pragma unroll
        for (int t = 0; t < 8; ++t) *(f32x4*)(rec + 4 + 16 * t + 4 * q4) = o[t];
    }
    __syncthreads();
    {
        const int hd = tid >> 6, r2 = 2 * (tid & 63);
        float M = -1e30f;
#pragma unroll
        for (int ww = 0; ww < 8; ++ww) M = fmaxf(M, MG[(ww * 8 + hd) * 132]);
        float L = 0.f, o0 = 0.f, o1 = 0.f;
#pragma unroll
        for (int ww = 0; ww < 8; ++ww) {
            const float* rec = MG + (ww * 8 + hd) * 132;
            const float wt = ex2(rec[0] - M);
            L = fmaf(wt, rec[1], L); o0 = fmaf(wt, rec[4 + r2], o0); o1 = fmaf(wt, rec[5 + r2], o1);
        }
        float* dp = (float*)(p.ws + WS_DPART) + ((size_t)(bs * 4 + split) * 8 + hd) * 132;
        if ((tid & 63) == 0) { dp[0] = M; dp[1] = L; }
        f32x2 ov = {o0, o1};
        *(f32x2*)(dp + 4 + r2) = ov;
    }
    __syncthreads();
}

__device__ void p2_scan(const Params& p, int bh) {
    int tid = threadIdx.x; asm volatile("" : "+v"(tid));
    const int lane = tid & 63, w = tid >> 6, l31 = lane & 31, hh = lane >> 5;
    const int dkt = w & 1, dvt = w >> 1;
    const float* BT = (const float*)(p.ws + WS_BT) + (size_t)bh * 64 * 2048;
    const __bf16* GKT = (const __bf16*)(p.ws + WS_GKT) + (size_t)bh * 64 * 2048;
    const __bf16* GVT = (const __bf16*)(p.ws + WS_GVT) + (size_t)bh * 128 * 2048;
    const float* BL = (const float*)(p.ws + WS_BL) + (size_t)bh * 32 * 64;
    __bf16* ST2 = (__bf16*)(p.ws + WS_ST2) + (size_t)bh * 32 * 128 * 64;
    const int dkA = 32 * dkt + l31, dvB = 32 * dvt + l31;
    f32x16 S;
#pragma unroll
    for (int r = 0; r < 16; ++r) S[r] = 0.f;
    float decN[16], blN; u32x4 kN[4]; f32x4 b0N[4], b1N[4]; bf16x8 vN[4];
#define SCAN_LOAD(c_) do { \
        _Pragma("unroll") for (int r = 0; r < 16; ++r) decN[r] = BL[(c_) * 64 + 32 * dkt + (r & 3) + 8 * (r >> 2) + 4 * hh]; \
        blN = BL[(c_) * 64 + dkA]; \
        _Pragma("unroll") for (int ks = 0; ks < 4; ++ks) { const size_t k16 = (size_t)(c_) * 4 + ks; \
            kN[ks] = *(const u32x4*)(GKT + ((k16 * 2 + dkt) * 64 + lane) * 8); \
            b0N[ks] = *(const f32x4*)(BT + ((k16 * 2 + dkt) * 64 + lane) * 8); b1N[ks] = *(const f32x4*)(BT + ((k16 * 2 + dkt) * 64 + lane) * 8 + 4); \
            vN[ks] = *(const bf16x8*)(GVT + ((k16 * 4 + dvt) * 64 + lane) * 8); } \
    } while (0)
    SCAN_LOAD(0);
#pragma unroll 1
    for (int c = 0; c < 32; ++c) {
        float dec[16]; u32x4 kC[4]; f32x4 b0C[4], b1C[4]; bf16x8 vC[4];
        const float blast = blN;
#pragma unroll
        for (int r = 0; r < 16; ++r) dec[r] = decN[r];
#pragma unroll
        for (int ks = 0; ks < 4; ++ks) { kC[ks] = kN[ks]; b0C[ks] = b0N[ks]; b1C[ks] = b1N[ks]; vC[ks] = vN[ks]; }
        SCAN_LOAD(c + 1);
        __builtin_amdgcn_sched_barrier(0);
#pragma unroll
        for (int g = 0; g < 4; ++g)
            *(u32x2*)(ST2 + ((size_t)c * 128 + dvB) * 64 + 32 * dkt + 8 * g + 4 * hh) = pk4(S[4 * g], S[4 * g + 1], S[4 * g + 2], S[4 * g + 3]);
#pragma unroll
        for (int r = 0; r < 16; ++r) S[r] *= __expf(dec[r]);
#pragma unroll
        for (int ks = 0; ks < 4; ++ks) {
            float kv[8]; unpack8(kC[ks], kv);
            bf16x8 ka;
#pragma unroll
            for (int e = 0; e < 4; ++e) { ka[e] = (__bf16)(kv[e] * __expf(blast - b0C[ks][e])); ka[4 + e] = (__bf16)(kv[4 + e] * __expf(blast - b1C[ks][e])); }
            S = mfma32(ka, vC[ks], S);
        }
        __builtin_amdgcn_sched_barrier(0);
    }
#undef SCAN_LOAD
    float* stp = p.out + OUT_STP + (size_t)bh * 64 * 128;
#pragma unroll
    for (int r = 0; r < 16; ++r) {
        const int dkr = 32 * dkt + (r & 3) + 8 * (r >> 2) + 4 * hh;
        stp[(size_t)dkr * 128 + dvB] = S[r];
    }
}

__device__ void p2_glarec(const Params& p, int bs, unsigned char* lds) {
    int tid = threadIdx.x; asm volatile("" : "+v"(tid));
    float* sq = (float*)(lds + LDS_BASE); float* sk = sq + 256; float* se = sk + 256;
    const __bf16* GQ = (const __bf16*)(p.ws + WS_GQ) + (size_t)(NTOK + bs) * 256;
    const __bf16* GK = (const __bf16*)(p.ws + WS_GK) + (size_t)(NTOK + bs) * 256;
    const float* LAB = (const float*)(p.ws + WS_LAB) + (size_t)(NTOK + bs) * 256;
    if (tid < 256) { sq[tid] = (float)GQ[tid]; sk[tid] = (float)GK[tid]; se[tid] = __expf(LAB[tid]); }
    __syncthreads();
    const int h = tid >> 7, dv = tid & 127;
    const float v = (float)((const __bf16*)(p.ws + WS_GV))[(size_t)(NTOK + bs) * 512 + h * 128 + dv];
    const float* s0 = p.state_gla + ((size_t)(bs * 4 + h) * 64) * 128 + dv;
    float* s1 = p.out + OUT_STS + ((size_t)(bs * 4 + h) * 64) * 128 + dv;
    float o = 0.f;
#pragma unroll 8
    for (int dk = 0; dk < 64; ++dk) {
        const float ns = se[h * 64 + dk] * s0[(size_t)dk * 128] + sk[h * 64 + dk] * v;
        s1[(size_t)dk * 128] = ns;
        o = fmaf(sq[h * 64 + dk], ns, o);
    }
    ((float*)(p.ws + WS_GLAOS))[(size_t)(bs * 4 + h) * 128 + dv] = o;
    __syncthreads();
}

__device__ __forceinline__ void p3_outproj(const Params& p, int it, unsigned char* lds);
__device__ void p3_stripe(const Params& p, int it, unsigned char* lds) {
    int tid = threadIdx.x; asm volatile("" : "+v"(tid));
    const int lane = tid & 63, w = tid >> 6, l31 = lane & 31, hh = lane >> 5;
    const bool is_s = it >= 512;
    const int srow0 = is_s ? (it - 512) * 32 : 0;
    const int st = it >> 1, half = it & 1;
    const int tok0 = is_s ? NTOK + srow0 : st * 64 + 32 * half;
    const int b = st >> 5, c = st & 31, s0 = c * 64;
    unsigned char* A = lds + LDS_BASE;
    const __bf16* GM = (const __bf16*)(p.ws + WS_GM);
    const __bf16* GG = (const __bf16*)(p.ws + WS_GG);
    if (!is_s) {
        const __bf16* AO = (const __bf16*)(p.ws + WS_AO);
        const int h = w >> 1, dvh = w & 1, bh = b * 4 + h;
        const int ti = 32 * half + l31;
        const size_t trow = (size_t)(st * 64 + ti);
        const __bf16* GQ = (const __bf16*)(p.ws + WS_GQ);
        const __bf16* GK = (const __bf16*)(p.ws + WS_GK);
        const float* LAB = (const float*)(p.ws + WS_LAB);
        const __bf16* GVT = (const __bf16*)(p.ws + WS_GVT) + (size_t)bh * 128 * 2048;
        const __bf16* ST2 = (const __bf16*)(p.ws + WS_ST2) + ((size_t)bh * 32 + c) * 128 * 64;
        bf16x8 qf[4], kf0[4], vf0[2][2];
        {
            u32x4 av[4], gv[4];
            u32x4 qr[4], kr[4]; f32x4 qb0[4], qb1[4], kb0[4], kb1[4];
            const size_t jrow = (size_t)(st * 64 + l31);
#pragma unroll
            for (int i = 0; i < 4; ++i) {
                const int idx = i * NTHR + tid, row = idx >> 6, ch = idx & 63;
                av[i] = *(const u32x4*)(AO + (size_t)(tok0 + row) * 512 + 8 * ch);
                gv[i] = *(const u32x4*)(GM + (size_t)(tok0 + row) * 512 + 8 * ch);
            }
#pragma unroll
            for (int ks = 0; ks < 4; ++ks) {
                const int dk0 = h * 64 + 16 * ks + 8 * hh;
                qr[ks] = *(const u32x4*)(GQ + trow * 256 + dk0);
                qb0[ks] = *(const f32x4*)(LAB + trow * 256 + dk0); qb1[ks] = *(const f32x4*)(LAB + trow * 256 + dk0 + 4);
                kr[ks] = *(const u32x4*)(GK + jrow * 256 + dk0);
                kb0[ks] = *(const f32x4*)(LAB + jrow * 256 + dk0); kb1[ks] = *(const f32x4*)(LAB + jrow * 256 + dk0 + 4);
            }
#pragma unroll
            for (int sk = 0; sk < 2; ++sk)
#pragma unroll
                for (int t = 0; t < 2; ++t) vf0[sk][t] = *(const bf16x8*)(GVT + ((((size_t)(s0 >> 4) + sk) * 4 + 2 * dvh + t) * 64 + lane) * 8);
            __builtin_amdgcn_sched_barrier(0);
#pragma unroll
            for (int i = 0; i < 4; ++i) {
                const int idx = i * NTHR + tid, row = idx >> 6, ch = idx & 63;
                float af[8], gf[8]; unpack8(av[i], af); unpack8(gv[i], gf);
                u32x4 o; o.x = pk2(af[0] * gf[0], af[1] * gf[1]); o.y = pk2(af[2] * gf[2], af[3] * gf[3]); o.z = pk2(af[4] * gf[4], af[5] * gf[5]); o.w = pk2(af[6] * gf[6], af[7] * gf[7]);
                *(u32x4*)(A + row * XS + ch * 16) = o;
            }
#pragma unroll
            for (int ks = 0; ks < 4; ++ks) {
                float qv[8], kv[8]; unpack8(qr[ks], qv); unpack8(kr[ks], kv);
#pragma unroll
                for (int e = 0; e < 4; ++e) {
                    qf[ks][e] = (__bf16)(qv[e] * __expf(qb0[ks][e])); qf[ks][4 + e] = (__bf16)(qv[4 + e] * __expf(qb1[ks][e]));
                    kf0[ks][e] = (__bf16)(kv[e] * __expf(-kb0[ks][e])); kf0[ks][4 + e] = (__bf16)(kv[4 + e] * __expf(-kb1[ks][e]));
                }
            }
        }
        bf16x8 sf[4][2], vf1[2][2]; u32x4 kr1[4]; f32x4 kb10[4], kb11[4], gn[2][4]; u32x2 gg[2][4];
        {
            const size_t jrow1 = (size_t)(st * 64 + 32 + l31);
#pragma unroll
            for (int ks = 0; ks < 4; ++ks) {
                const int dk0 = h * 64 + 16 * ks + 8 * hh;
#pragma unroll
                for (int t = 0; t < 2; ++t) sf[ks][t] = *(const bf16x8*)(ST2 + (size_t)(32 * (2 * dvh + t) + l31) * 64 + 16 * ks + 8 * hh);
                kr1[ks] = *(const u32x4*)(GK + jrow1 * 256 + dk0);
                kb10[ks] = *(const f32x4*)(LAB + jrow1 * 256 + dk0); kb11[ks] = *(const f32x4*)(LAB + jrow1 * 256 + dk0 + 4);
            }
#pragma unroll
            for (int sk = 0; sk < 2; ++sk)
#pragma unroll
                for (int t = 0; t < 2; ++t) vf1[sk][t] = *(const bf16x8*)(GVT + ((((size_t)(s0 >> 4) + 2 + sk) * 4 + 2 * dvh + t) * 64 + lane) * 8);
#pragma unroll
            for (int t = 0; t < 2; ++t)
#pragma unroll
                for (int g = 0; g < 4; ++g) {
                    const int dv = 32 * (2 * dvh + t) + 8 * g + 4 * hh;
                    gn[t][g] = *(const f32x4*)(p.gla_norm_g + h * 128 + dv);
                    gg[t][g] = *(const u32x2*)(GG + trow * 512 + h * 128 + dv);
                }
        }
        __builtin_amdgcn_sched_barrier(0);
        f32x16 o[2];
#pragma unroll
        for (int t = 0; t < 2; ++t)
#pragma unroll
            for (int r = 0; r < 16; ++r) o[t][r] = 0.f;
        {
            f32x16 att;
#pragma unroll
            for (int r = 0; r < 16; ++r) att[r] = 0.f;
#pragma unroll
            for (int ks = 0; ks < 4; ++ks) att = mfma32(kf0[ks], qf[ks], att);
            if (half == 0) {
#pragma unroll
                for (int r = 0; r < 16; ++r) { const int j = (r & 3) + 8 * (r >> 2) + 4 * hh; if (j > l31) att[r] = 0.f; }
            }
#pragma unroll
            for (int sk = 0; sk < 2; ++sk) {
                bf16x8 pf;
#pragma unroll
                for (int e = 0; e < 8; ++e) pf[e] = (__bf16)att[8 * sk + e];
#pragma unroll
                for (int t = 0; t < 2; ++t) o[t] = mfma32(vf0[sk][t], pf, o[t]);
            }
        }
        __builtin_amdgcn_sched_barrier(0);
        if (half == 1) {
            f32x16 att;
#pragma unroll
            for (int r = 0; r < 16; ++r) att[r] = 0.f;
#pragma unroll
            for (int ks = 0; ks < 4; ++ks) {
                float kv[8]; unpack8(kr1[ks], kv);
                bf16x8 kf;
#pragma unroll
                for (int e = 0; e < 4; ++e) { kf[e] = (__bf16)(kv[e] * __expf(-kb10[ks][e])); kf[4 + e] = (__bf16)(kv[4 + e] * __expf(-kb11[ks][e])); }
                att = mfma32(kf, qf[ks], att);
            }
#pragma unroll
            for (int r = 0; r < 16; ++r) { const int j = (r & 3) + 8 * (r >> 2) + 4 * hh; if (j > l31) att[r] = 0.f; }
#pragma unroll
            for (int sk = 0; sk < 2; ++sk) {
                bf16x8 pf;
#pragma unroll
                for (int e = 0; e < 8; ++e) pf[e] = (__bf16)att[8 * sk + e];
#pragma unroll
                for (int t = 0; t < 2; ++t) o[t] = mfma32(vf1[sk][t], pf, o[t]);
            }
        }
#pragma unroll
        for (int ks = 0; ks < 4; ++ks)
#pragma unroll
            for (int t = 0; t < 2; ++t) o[t] = mfma32(sf[ks][t], qf[ks], o[t]);
        float ss = 0.f;
#pragma unroll
        for (int t = 0; t < 2; ++t)
#pragma unroll
            for (int r = 0; r < 16; ++r) ss = fmaf(o[t][r], o[t][r], ss);
        ss += __shfl_xor(ss, 32);
        float* SSX = (float*)(lds + LDS_BASE + 64 * XS);
        if (hh == 0) SSX[w * 32 + l31] = ss;
        __syncthreads();
        ss += SSX[(w ^ 1) * 32 + l31];
        const float inv = rsqrtf(ss * (1.f / 128.f) + NORM_EPS);
#pragma unroll
        for (int t = 0; t < 2; ++t)
#pragma unroll
            for (int g = 0; g < 4; ++g) {
                const int dv = 32 * (2 * dvh + t) + 8 * g + 4 * hh;
                *(u32x2*)(A + l31 * XS + (512 + h * 128 + dv) * 2) =
                    pk4(o[t][4 * g] * inv * gn[t][g][0] * bflo(gg[t][g].x), o[t][4 * g + 1] * inv * gn[t][g][1] * bfhi(gg[t][g].x),
                        o[t][4 * g + 2] * inv * gn[t][g][2] * bflo(gg[t][g].y), o[t][4 * g + 3] * inv * gn[t][g][3] * bfhi(gg[t][g].y));
            }
    }
    __syncthreads();
    p3_outproj(p, it, lds);
}

__device__ __forceinline__ void p3_outproj(const Params& p, int it, unsigned char* lds) {
    int tid = threadIdx.x; asm volatile("" : "+v"(tid));
    const int lane = tid & 63, w = tid >> 6, l31 = lane & 31, hh = lane >> 5;
    const bool is_s = it >= 512;
    const int srow0 = is_s ? (it - 512) * 32 : 0;
    const int st = it >> 1, half = it & 1, b = st >> 5;
    unsigned char* A = lds + LDS_BASE;
    const u32x4* woutf = (const u32x4*)(p.ws + WS_WOUTF);
    const float* mod = (const float*)(p.ws + WS_MOD);
    float s1 = 0.f, s2 = 0.f;
    const size_t row0 = is_s ? (size_t)srow0 : (size_t)st * 64 + 32 * half;
    const float* xb0 = (is_s ? p.x_sample : p.x_prompt) + (row0 + l31) * 1024 + 64 * w + 4 * hh;
    const float* gb0 = mod + (size_t)(is_s ? (8 + srow0 + l31) : b) * 3072 + 2048 + 64 * w + 4 * hh;
    float* yb0 = p.out + (is_s ? OUT_YS : OUT_YP) + (row0 + l31) * 1024 + 64 * w + 4 * hh;
    f32x16 vacc[2][2];
#pragma unroll
    for (int q = 0; q < 2; ++q) {
        f32x16 acc[2];
#pragma unroll
        for (int nt = 0; nt < 2; ++nt)
#pragma unroll
            for (int r = 0; r < 16; ++r) acc[nt][r] = 0.f;
        f32x4 xv[2][4];
        {
            const unsigned char* x0 = A + l31 * XS + hh * 16;
            const u32x4* w0 = woutf + (size_t)(w + 8 * q) * 2 * 64 * 64 + lane;
            const u32x4* w1 = w0 + 64 * 64;
            u32x4 ra[8], rb[8];
#pragma unroll
            for (int u = 0; u < 8; ++u) { ra[u] = w0[u * 64]; rb[u] = w1[u * 64]; }
#pragma unroll
            for (int g = 0; g < 4; ++g) xv[0][g] = *(const f32x4*)(xb0 + 512 * q + 8 * g);
            const float xtouch = xb0[512 * q + 32];
            bf16x8 b0 = *(const bf16x8*)(x0);
#pragma unroll 1
            for (int k0 = 0; k0 < 64; k0 += 8) {
#pragma unroll
                for (int u = 0; u < 8; ++u) {
                    const int ks = k0 + u;
                    const bf16x8 nb0 = *(const bf16x8*)(x0 + (ks + 1) * 32);
                    const bf16x8 a0 = __builtin_bit_cast(bf16x8, ra[u]), a1 = __builtin_bit_cast(bf16x8, rb[u]);
                    ra[u] = w0[(ks + 8) * 64]; rb[u] = w1[(ks + 8) * 64];
                    __builtin_amdgcn_sched_barrier(0);
                    acc[0] = mfma32(a0, b0, acc[0]); acc[1] = mfma32(a1, b0, acc[1]);
                    __builtin_amdgcn_sched_barrier(0);
                    b0 = nb0;
                }
            }
            asm volatile("" :: "v"(xtouch));
        }
        f32x4 gt[2][4];
#pragma unroll
        for (int nt = 0; nt < 2; ++nt)
#pragma unroll
            for (int g = 0; g < 4; ++g) gt[nt][g] = *(const f32x4*)(gb0 + 512 * q + 32 * nt + 8 * g);
#pragma unroll
        for (int g = 0; g < 4; ++g) xv[1][g] = *(const f32x4*)(xb0 + 512 * q + 32 + 8 * g);
        __builtin_amdgcn_sched_barrier(0);
#pragma unroll
        for (int nt = 0; nt < 2; ++nt)
#pragma unroll
            for (int g = 0; g < 4; ++g)
#pragma unroll
                for (int i = 0; i < 4; ++i) {
                    const float v = DN_ALPHA * xv[nt][g][i] + gt[nt][g][i] * acc[nt][4 * g + i];
                    vacc[q][nt][4 * g + i] = v;
                    s1 += v; s2 = fmaf(v, v, s2);
                }
        __builtin_amdgcn_sched_barrier(0);
    }
    float* LNP = (float*)(lds + LDS_BASE + 64 * XS);
    s1 += __shfl_xor(s1, 32); s2 += __shfl_xor(s2, 32);
    __syncthreads();
    if (hh == 0) { LNP[(w * 32 + l31) * 2] = s1; LNP[(w * 32 + l31) * 2 + 1] = s2; }
    __syncthreads();
    float mean, rstd;
    {
        float a = 0.f, bq = 0.f;
#pragma unroll
        for (int ww = 0; ww < 8; ++ww) { a += LNP[(ww * 32 + l31) * 2]; bq += LNP[(ww * 32 + l31) * 2 + 1]; }
        mean = a * (1.f / 1024.f);
        const float var = fmaxf(bq * (1.f / 1024.f) - mean * mean, 0.f);
        rstd = rsqrtf(var + NORM_EPS);
    }
    const float* lgb = p.ln_g + 64 * w + 4 * hh;
    const float* lbb = p.ln_b + 64 * w + 4 * hh;
#pragma unroll
    for (int q = 0; q < 2; ++q) {
        f32x4 lg[2][4], lb[2][4];
#pragma unroll
        for (int nt = 0; nt < 2; ++nt)
#pragma unroll
            for (int g = 0; g < 4; ++g) {
                const int off = 512 * q + 32 * nt + 8 * g;
                lg[nt][g] = *(const f32x4*)(lgb + off); lb[nt][g] = *(const f32x4*)(lbb + off);
            }
        __builtin_amdgcn_sched_barrier(0);
#pragma unroll
        for (int nt = 0; nt < 2; ++nt)
#pragma unroll
            for (int g = 0; g < 4; ++g) {
                const int off = 512 * q + 32 * nt + 8 * g;
                f32x4 y;
#pragma unroll
                for (int i = 0; i < 4; ++i) y[i] = (vacc[q][nt][4 * g + i] - mean) * rstd * lg[nt][g][i] + lb[nt][g][i];
                *(f32x4*)(yb0 + off) = y;
            }
        __builtin_amdgcn_sched_barrier(0);
    }
    __syncthreads();
}


__device__ void p3s_arows(const Params& p, int k, unsigned char* lds) {
    int tid = threadIdx.x; asm volatile("" : "+v"(tid));
    const int lane = tid & 63, w = tid >> 6, l31 = lane & 31, hh = lane >> 5;
    const int r0 = 8 * k, h = w;
    const __bf16* QLR = (const __bf16*)(p.ws + WS_QLR);
    const float* DP = (const float*)(p.ws + WS_DPART);
    const float* lat_s = p.out + OUT_LATS;
    const float* kr_s = p.out + OUT_KRS;
    const __bf16* GM = (const __bf16*)(p.ws + WS_GM);
    const __bf16* GG = (const __bf16*)(p.ws + WS_GG);
    __bf16* AS = (__bf16*)(p.ws + WS_AS);
    unsigned char* OL = lds + LDS_BASE + w * 2304;
#pragma unroll 1
    for (int q0 = 0; q0 < 8; q0 += 4) {
        float qa[4], qb[4], qc[4], la[4], lb2[4], kc[4], mi[4][4], li[4][4];
        f32x2 ln[4], ov[4][4];
#pragma unroll
        for (int u = 0; u < 4; ++u) {
            const int bs = r0 + q0 + u;
            const __bf16* ql = QLR + ((size_t)bs * 8 + h) * 160;
            qa[u] = (float)ql[lane]; qb[u] = (float)ql[64 + lane]; qc[u] = (float)ql[128 + (lane & 31)];
            la[u] = lat_s[(size_t)bs * 128 + lane]; lb2[u] = lat_s[(size_t)bs * 128 + 64 + lane]; kc[u] = kr_s[(size_t)bs * 32 + (lane & 31)];
            ln[u] = *(const f32x2*)(lat_s + (size_t)bs * 128 + 2 * lane);
#pragma unroll
            for (int sp = 0; sp < 4; ++sp) {
                const float* d = DP + ((size_t)(bs * 4 + sp) * 8 + h) * 132;
                mi[u][sp] = d[0]; li[u][sp] = d[1]; ov[u][sp] = *(const f32x2*)(d + 4 + 2 * lane);
            }
        }
        __builtin_amdgcn_sched_barrier(0);
#pragma unroll
        for (int u = 0; u < 4; ++u) {
            float part = qa[u] * la[u] + qb[u] * lb2[u];
            if (lane < 32) part += qc[u] * kc[u];
            const float sn = wave_sum(part);
            float M = sn;
#pragma unroll
            for (int sp = 0; sp < 4; ++sp) M = fmaxf(M, mi[u][sp]);
            const float wn = ex2(sn - M);
            float L = wn, o0 = wn * ln[u][0], o1 = wn * ln[u][1];
#pragma unroll
            for (int sp = 0; sp < 4; ++sp) {
                const float wt = ex2(mi[u][sp] - M);
                L = fmaf(wt, li[u][sp], L); o0 = fmaf(wt, ov[u][sp][0], o0); o1 = fmaf(wt, ov[u][sp][1], o1);
            }
            const float inv = __builtin_amdgcn_rcpf(L);
            *(unsigned*)(OL + (q0 + u) * 288 + 4 * lane) = pk2(o0 * inv, o1 * inv);
        }
    }
    asm volatile("s_waitcnt lgkmcnt(0)" ::: "memory");
    {
        const __bf16* wuvt = (const __bf16*)(p.ws + WS_WUVT);
        f32x16 mo[2];
#pragma unroll
        for (int vt = 0; vt < 2; ++vt)
#pragma unroll
            for (int r = 0; r < 16; ++r) mo[vt][r] = 0.f;
        bf16x8 ob[8], wa[2][8];
        const int tk = (l31 < 8) ? l31 : 7;
#pragma unroll
        for (int ks = 0; ks < 8; ++ks) {
            ob[ks] = *(const bf16x8*)(OL + tk * 288 + (16 * ks + 8 * hh) * 2);
            wa[0][ks] = *(const bf16x8*)(wuvt + ((size_t)h * 64 + l31) * 128 + 16 * ks + 8 * hh);
            wa[1][ks] = *(const bf16x8*)(wuvt + ((size_t)h * 64 + 32 + l31) * 128 + 16 * ks + 8 * hh);
        }
        __builtin_amdgcn_sched_barrier(0);
#pragma unroll
        for (int ks = 0; ks < 8; ++ks)
#pragma unroll
            for (int vt = 0; vt < 2; ++vt) mo[vt] = mfma32(wa[vt][ks], ob[ks], mo[vt]);
        if (l31 < 8) {
#pragma unroll
            for (int vt = 0; vt < 2; ++vt)
#pragma unroll
                for (int g = 0; g < 4; ++g) {
                    const int v = 32 * vt + 8 * g + 4 * hh;
                    const u32x2 gm = *(const u32x2*)(GM + (size_t)(NTOK + r0 + l31) * 512 + h * 64 + v);
                    *(u32x2*)(AS + (size_t)(r0 + l31) * 1024 + h * 64 + v) =
                        pk4(mo[vt][4 * g] * bflo(gm.x), mo[vt][4 * g + 1] * bfhi(gm.x), mo[vt][4 * g + 2] * bflo(gm.y), mo[vt][4 * g + 3] * bfhi(gm.y));
                }
        }
    }
    {
        const float* GLAOS = (const float*)(p.ws + WS_GLAOS);
        f32x2 ov[4], gn[4]; unsigned gg[4];
#pragma unroll
        for (int u = 0; u < 4; ++u) {
            const int pr = w * 4 + u, t = pr >> 2, hg = pr & 3, bs = r0 + t;
            ov[u] = *(const f32x2*)(GLAOS + ((size_t)bs * 4 + hg) * 128 + 2 * lane);
            gn[u] = *(const f32x2*)(p.gla_norm_g + hg * 128 + 2 * lane);
            gg[u] = *(const unsigned*)(GG + (size_t)(NTOK + bs) * 512 + hg * 128 + 2 * lane);
        }
        __builtin_amdgcn_sched_barrier(0);
#pragma unroll
        for (int u = 0; u < 4; ++u) {
            const int pr = w * 4 + u, t = pr >> 2, hg = pr & 3, bs = r0 + t;
            const float ss = wave_sum(ov[u][0] * ov[u][0] + ov[u][1] * ov[u][1]);
            const float inv = rsqrtf(ss * (1.f / 128.f) + NORM_EPS);
            *(unsigned*)(AS + (size_t)bs * 1024 + 512 + hg * 128 + 2 * lane) = pk2(ov[u][0] * inv * gn[u][0] * bflo(gg[u]), ov[u][1] * inv * gn[u][1] * bfhi(gg[u]));
        }
    }
    __syncthreads();
}
__device__ void p3s_cols(const Params& p, int k, unsigned char* lds) {
    int tid = threadIdx.x; asm volatile("" : "+v"(tid));
    const int lane = tid & 63, w = tid >> 6, l31 = lane & 31, hh = lane >> 5;
    const int nt = w >> 1, mt = w & 1;
    unsigned char* A = lds + LDS_BASE;
    const __bf16* AS = (const __bf16*)(p.ws + WS_AS);
    const u32x4* woutf = (const u32x4*)(p.ws + WS_WOUTF);
    const float* mod = (const float*)(p.ws + WS_MOD);
    float* ST = (float*)(lds + LDS_BASE + 64 * XS);
    float* STATS = (float*)(p.ws + WS_STATS);
#pragma unroll 1
    for (int pass = 0; pass < 2; ++pass) {
        {
            u32x4 t[16];
#pragma unroll
            for (int i = 0; i < 16; ++i) { const int idx = i * NTHR + tid, row = idx >> 7, ch = idx & 127; t[i] = *(const u32x4*)(AS + (size_t)(64 * pass + row) * 1024 + 8 * ch); }
            __builtin_amdgcn_sched_barrier(0);
#pragma unroll
            for (int i = 0; i < 16; ++i) { const int idx = i * NTHR + tid, row = idx >> 7, ch = idx & 127; *(u32x4*)(A + row * XS + ch * 16) = t[i]; }
        }
        __syncthreads();
        f32x16 acc;
#pragma unroll
        for (int r = 0; r < 16; ++r) acc[r] = 0.f;
        const int row = 64 * pass + 32 * mt + l31;
        const int ncol = 128 * k + 32 * nt + 4 * hh;
        f32x4 xv[4], gt[4];
#pragma unroll
        for (int g = 0; g < 4; ++g) { xv[g] = *(const f32x4*)(p.x_sample + (size_t)row * 1024 + ncol + 8 * g); gt[g] = *(const f32x4*)(mod + (size_t)(8 + row) * 3072 + 2048 + ncol + 8 * g); }
        {
            const unsigned char* x0 = A + (32 * mt + l31) * XS + hh * 16;
            const u32x4* w0 = woutf + (size_t)(4 * k + nt) * 64 * 64 + lane;
            u32x4 ra[8];
#pragma unroll
            for (int u = 0; u < 8; ++u) ra[u] = w0[u * 64];
#pragma unroll 1
            for (int k0 = 0; k0 < 64; k0 += 8) {
#pragma unroll
                for (int u = 0; u < 8; ++u) {
                    const int ks = k0 + u;
                    const bf16x8 b0 = *(const bf16x8*)(x0 + ks * 32);
                    const bf16x8 a0 = __builtin_bit_cast(bf16x8, ra[u]);
                    ra[u] = w0[(ks + 8) * 64];
                    __builtin_amdgcn_sched_barrier(0);
                    acc = mfma32(a0, b0, acc);
                    __builtin_amdgcn_sched_barrier(0);
                }
            }
        }
        float s1 = 0.f, s2 = 0.f;
        float* yb = p.out + OUT_YS + (size_t)row * 1024 + ncol;
#pragma unroll
        for (int g = 0; g < 4; ++g) {
            f32x4 v;
#pragma unroll
            for (int i = 0; i < 4; ++i) { v[i] = DN_ALPHA * xv[g][i] + gt[g][i] * acc[4 * g + i]; s1 += v[i]; s2 = fmaf(v[i], v[i], s2); }
            *(f32x4*)(yb + 8 * g) = v;
        }
        s1 += __shfl_xor(s1, 32); s2 += __shfl_xor(s2, 32);
        if (hh == 0) { ST[(w * 32 + l31) * 2] = s1; ST[(w * 32 + l31) * 2 + 1] = s2; }
        __syncthreads();
        if (tid < 64) {
            const int m2 = tid >> 5, tk = tid & 31;
            float a = 0.f, bq = 0.f;
#pragma unroll
            for (int n2 = 0; n2 < 4; ++n2) { a += ST[((2 * n2 + m2) * 32 + tk) * 2]; bq += ST[((2 * n2 + m2) * 32 + tk) * 2 + 1]; }
            STATS[((size_t)k * NDEC + 64 * pass + tid) * 2] = a; STATS[((size_t)k * NDEC + 64 * pass + tid) * 2 + 1] = bq;
        }
        __syncthreads();
    }
}
__device__ void p3s_ln(const Params& p, int k, unsigned char* lds) {
    int tid = threadIdx.x; asm volatile("" : "+v"(tid));
    const int row = 32 * k + (tid >> 4), c0 = (tid & 15) * 64;
    const float* STATS = (const float*)(p.ws + WS_STATS);
    float a = 0.f, bq = 0.f;
#pragma unroll
    for (int j = 0; j < 8; ++j) { a += STATS[((size_t)j * NDEC + row) * 2]; bq += STATS[((size_t)j * NDEC + row) * 2 + 1]; }
    const float mean = a * (1.f / 1024.f);
    const float rstd = rsqrtf(fmaxf(bq * (1.f / 1024.f) - mean * mean, 0.f) + NORM_EPS);
    float* y = p.out + OUT_YS + (size_t)row * 1024 + c0;
    f32x4 v[16];
#pragma unroll
    for (int i = 0; i < 16; ++i) v[i] = *(const f32x4*)(y + 4 * i);
    __builtin_amdgcn_sched_barrier(0);
#pragma unroll
    for (int i = 0; i < 16; ++i) {
        const f32x4 lg = *(const f32x4*)(p.ln_g + c0 + 4 * i), lb = *(const f32x4*)(p.ln_b + c0 + 4 * i);
        f32x4 o;
#pragma unroll
        for (int e = 0; e < 4; ++e) o[e] = (v[i][e] - mean) * rstd * lg[e] + lb[e];
        *(f32x4*)(y + 4 * i) = o;
    }
}

__device__ __forceinline__ int q_next(unsigned* cnt, unsigned char* lds) {
    volatile LAS unsigned* slot = (volatile LAS unsigned*)(lds + 16);
    __syncthreads();
    if (threadIdx.x == 0) *slot = __hip_atomic_fetch_add(cnt, 1u, __ATOMIC_RELAXED, __HIP_MEMORY_SCOPE_AGENT);
    __syncthreads();
    return (int)*slot;
}
__device__ __forceinline__ void signal_done(unsigned* cnt) {
    asm volatile("s_waitcnt vmcnt(0)" ::: "memory");
    __syncthreads();
    if (threadIdx.x == 0) {
        __builtin_amdgcn_fence(__ATOMIC_RELEASE, "agent");
        asm volatile("s_waitcnt vmcnt(0)" ::: "memory");
        (void)__hip_atomic_fetch_add(cnt, 1u, __ATOMIC_RELAXED, __HIP_MEMORY_SCOPE_AGENT);
    }
}
__device__ __forceinline__ void wait_count(unsigned* bar, unsigned* cnt, unsigned want) {
    if (threadIdx.x == 0) {
        XB_SPIN(xb_ld(cnt) < want, bar);
        __builtin_amdgcn_fence(__ATOMIC_ACQUIRE, "agent");
        asm volatile("s_waitcnt vmcnt(0)" ::: "memory");
    }
    __syncthreads();
}

__global__ void __launch_bounds__(NTHR) fwd_mega(Params p, int ph_lo, int ph_hi, int use_bar) {
    extern __shared__ __attribute__((aligned(16))) unsigned char lds[];
    const int tid = threadIdx.x;
    if (use_bar) {
        if (tid == 0) { *(u32x4*)lds = (u32x4){0u, 0u, 0u, 0u}; }
        __syncthreads();
        (void)xcd_barrier_post((unsigned*)(p.ws + WS_CTL), (volatile LAS unsigned*)lds);
    }
    const int G = gridDim.x, bid = blockIdx.x;
    unsigned* ctl = (unsigned*)(p.ws + WS_CTL);
    for (int ph = ph_lo; ph < ph_hi; ++ph) {
        for (int rep = 0; rep < ((ph == REP_PH) ? 2 : 1); ++rep) {
        if (ph == 0) {
            for (int item = bid; item < 96; item += G) p0_mod_item(p, item, lds);
            p0_convert(p);
        } else if (ph == 1 || ph == 2) {
            bool sample_ok = false;
            int local = 0;
            for (;;) {
                int kind, a0, a1;
                if (ph == 1) { a0 = bid + local * G; ++local; if (a0 >= 256) break; kind = 0; a1 = 0; }
                else {
                    const int i = q_next(ctl + CW_Q2 + 16 * rep, lds);
                    if (i >= 1194) break;
                    if (i < 2) { kind = 0; a0 = 256 + i; a1 = 1; }
                    else if (i < 10) { kind = 0; a0 = 256 + ((i - 2) >> 2); a1 = 2 + ((i - 2) & 3); }
                    else if (i < 42) { kind = 1; a0 = i - 10; a1 = 0; }
                    else if (i < 298) { kind = 2; a0 = (i - 42) & 63; a1 = 7 - ((i - 42) >> 6); }
                    else if (i < 426) { kind = 3; a0 = i - 298; a1 = 0; }
                    else if (i < 938) { kind = 4; a0 = (i - 426) >> 2; a1 = (i - 426) & 3; }
                    else { kind = 2; a0 = (i - 938) & 63; a1 = 3 - ((i - 938) >> 6); }
                }
                if (kind >= 3 && !sample_ok) { wait_count(ctl, ctl + CW_SAMPLE, 10u * (rep + 1)); sample_ok = true; }
                if (kind == 0) { p1_stripe(p, a0, a1, lds); if (ph == 2) signal_done(ctl + CW_SAMPLE); }
                else if (kind == 1) p2_scan(p, a0);
                else if (kind == 2) p2_attn(p, a0, a1, lds);
                else if (kind == 3) p2_glarec(p, a0, lds);
                else p2_decode(p, a0, a1, lds);
            }
        } else {
            for (;;) {
                const int qi = q_next(ctl + CW_Q3 + 16 * rep, lds);
                if (qi >= 540) break;
                if (qi < 16) { p3s_arows(p, qi, lds); signal_done(ctl + CW_AS); }
                else if (qi < 272) p3_stripe(p, qi - 16, lds);
                else if (qi < 280) { wait_count(ctl, ctl + CW_AS, 16u * (rep + 1)); p3s_cols(p, qi - 272, lds); signal_done(ctl + CW_COL); }
                else if (qi < 536) p3_stripe(p, qi - 280 + 256, lds);
                else { wait_count(ctl, ctl + CW_COL, 8u * (rep + 1)); p3s_ln(p, qi - 536, lds); }
            }
        }
        }
        if (use_bar && ph + 1 < ph_hi) {
            XcdBarrier xb; xb.bar = (unsigned*)(p.ws + WS_CTL); xb.x = xb_xcc_id(); xb.st = (volatile LAS unsigned*)lds;
            xcd_barrier(xb);
        }
    }
}


extern "C" void kernel_launch(void* const* d_in, const int* in_sizes, int n_in, void* d_out, int out_size, void* d_ws, size_t ws_size, hipStream_t stream) {
    static int grid = 0;
    if (grid == 0) {
        if (n_in != 22 || (size_t)out_size != OUT_END || ws_size < WS_END) { fprintf(stderr, "kernel_launch: unexpected shapes (n_in %d out %d ws %zu)\n", n_in, out_size, ws_size); grid = -1; return; }
        int dev = 0, cus = 0, per_cu = 0;
        if (hipGetDevice(&dev) != hipSuccess || hipDeviceGetAttribute(&cus, hipDeviceAttributeMultiprocessorCount, dev) != hipSuccess) { grid = -1; return; }
        if (hipFuncSetAttribute((const void*)fwd_mega, hipFuncAttributeMaxDynamicSharedMemorySize, LDS_BYTES) != hipSuccess) { fprintf(stderr, "kernel_launch: hipFuncSetAttribute failed\n"); grid = -1; return; }
        if (hipOccupancyMaxActiveBlocksPerMultiprocessor(&per_cu, (const void*)fwd_mega, NTHR, LDS_BYTES) != hipSuccess || per_cu < 1) { fprintf(stderr, "kernel_launch: occupancy query says %d\n", per_cu); grid = -1; return; }
        (void)hipGetLastError();
        grid = cus;
    }
    if (grid < 0) return;
    Params p{};
    p.x_prompt = (const float*)d_in[0]; p.x_sample = (const float*)d_in[1]; p.cache_lat = (const float*)d_in[2]; p.cache_kr = (const float*)d_in[3];
    p.state_gla = (const float*)d_in[4]; p.page_table = (const int*)d_in[5]; p.c_prompt = (const float*)d_in[6]; p.c_sample = (const float*)d_in[7];
    p.w_ada = (const float*)d_in[8]; p.b_ada = (const float*)d_in[9]; p.w_in = (const float*)d_in[10]; p.q_norm_g = (const float*)d_in[11];
    p.w_uq = (const float*)d_in[12]; p.kv_norm_g = (const float*)d_in[13]; p.w_uk = (const float*)d_in[14]; p.w_uv = (const float*)d_in[15];
    p.w_gate_up = (const float*)d_in[16]; p.b_gate = (const float*)d_in[17]; p.gla_norm_g = (const float*)d_in[18]; p.w_out = (const float*)d_in[19];
    p.ln_g = (const float*)d_in[20]; p.ln_b = (const float*)d_in[21];
    p.out = (float*)d_out; p.ws = (unsigned char*)d_ws;
    if (hipMemsetAsync((char*)d_ws + WS_CTL, 0, CTL_BYTES, stream) != hipSuccess) { fprintf(stderr, "kernel_launch: memset failed\n"); return; }
#if N_LAUNCHES == 1
    hipLaunchKernelGGL(fwd_mega, dim3(grid), dim3(NTHR), LDS_BYTES, stream, p, 0, 4, 1);
#else
    for (int ph = 0; ph < 4; ++ph) hipLaunchKernelGGL(fwd_mega, dim3(grid), dim3(NTHR), LDS_BYTES, stream, p, ph, ph + 1, 0);
#endif
    const hipError_t le = hipPeekAtLastError();
    if (le != hipSuccess) fprintf(stderr, "kernel_launch: launch failed: %s\n", hipGetErrorName(le));
}
```

```cpp
#include <hip/hip_runtime.h>
#include <cstdint>
#include <cstdio>

typedef __bf16 bf16x8 __attribute__((ext_vector_type(8)));
typedef __bf16 bf16x4 __attribute__((ext_vector_type(4)));
typedef __bf16 bf16x2 __attribute__((ext_vector_type(2)));
typedef float f32x16 __attribute__((ext_vector_type(16)));
typedef float f32x4 __attribute__((ext_vector_type(4)));
typedef float f32x2 __attribute__((ext_vector_type(2)));
typedef unsigned u32x4 __attribute__((ext_vector_type(4)));
typedef unsigned u32x2 __attribute__((ext_vector_type(2)));

#define NTHR 512
#define N_LAUNCHES 1
#define REP_PH (-1)
#define LDS_BYTES 143360
#define LDS_BASE 256

constexpr int DM = 1024, SEQ = 2048, NB = 8, NTOK = 16384, NDEC = 128, RT = NTOK + NDEC;
constexpr int NPAGES = 64;
constexpr float NORM_EPS = 1e-6f;
constexpr float LOG2E = 1.4426950408889634f;
constexpr float QSCALE = 0.10206207261596577f * 1.4426950408889634f;
constexpr float DN_ALPHA = 1.189207115002721f;

constexpr size_t OUT_YP = 0;
constexpr size_t OUT_YS = OUT_YP + (size_t)NTOK * 1024;
constexpr size_t OUT_LATP = OUT_YS + (size_t)NDEC * 1024;
constexpr size_t OUT_KRP = OUT_LATP + (size_t)NTOK * 128;
constexpr size_t OUT_STP = OUT_KRP + (size_t)NTOK * 32;
constexpr size_t OUT_LATS = OUT_STP + (size_t)NB * 4 * 64 * 128;
constexpr size_t OUT_KRS = OUT_LATS + (size_t)NDEC * 128;
constexpr size_t OUT_STS = OUT_KRS + (size_t)NDEC * 32;
constexpr size_t OUT_END = OUT_STS + (size_t)NDEC * 4 * 64 * 128;

constexpr size_t al256(size_t x) { return (x + 255) & ~(size_t)255; }
constexpr size_t WS_CTL = 0;
constexpr size_t CTL_BYTES = 16384;
constexpr size_t WS_MOD = WS_CTL + CTL_BYTES;
constexpr size_t WS_ROPE = WS_MOD + al256((size_t)136 * 3072 * 4);
constexpr size_t WS_WINF = WS_ROPE + al256((size_t)2049 * 32 * 4);
constexpr size_t WS_WUQF = WS_WINF + (size_t)78 * 64 * 1024;
constexpr size_t WS_WKVF = WS_WUQF + (size_t)24 * 16 * 1024;
constexpr size_t WS_WOUTF = WS_WKVF + (size_t)32 * 8 * 1024;
constexpr size_t WS_WUKB = WS_WOUTF + (size_t)32 * 64 * 1024;
constexpr size_t WS_WUVT = WS_WUKB + (size_t)65536 * 2;
constexpr size_t WS_GM = WS_WUVT + (size_t)65536 * 2;
constexpr size_t WS_GQ = WS_GM + al256((size_t)RT * 512 * 2);
constexpr size_t WS_GK = WS_GQ + al256((size_t)RT * 256 * 2);
constexpr size_t WS_GV = WS_GK + al256((size_t)RT * 256 * 2);
constexpr size_t WS_GG = WS_GV + al256((size_t)RT * 512 * 2);
constexpr size_t WS_LAB = WS_GG + al256((size_t)RT * 512 * 2);
constexpr size_t WS_BT = WS_LAB + al256((size_t)RT * 256 * 4);
constexpr size_t WS_GKT = WS_BT + (size_t)NB * 4 * 64 * 2048 * 4;
constexpr size_t WS_GVT = WS_GKT + (size_t)NB * 4 * 64 * 2048 * 2;
constexpr size_t WS_Q = WS_GVT + (size_t)NB * 4 * 128 * 2048 * 2;
constexpr size_t WS_KN = WS_Q + (size_t)NB * 8 * 2048 * 96 * 2;
constexpr size_t WS_KR = WS_KN + (size_t)NB * 8 * 2048 * 64 * 2;
constexpr size_t WS_VT = WS_KR + (size_t)NB * 2048 * 32 * 2;
constexpr size_t WS_AO = WS_VT + (size_t)NB * 8 * 64 * 2048 * 2;
constexpr size_t WS_ST2 = WS_AO + (size_t)NTOK * 512 * 2;
constexpr size_t WS_BL = WS_ST2 + (size_t)NB * 4 * 32 * 128 * 64 * 2;
constexpr size_t WS_QLR = WS_BL + (size_t)NB * 4 * 32 * 64 * 4;
constexpr size_t WS_DPART = WS_QLR + al256((size_t)NDEC * 8 * 160 * 2);
constexpr size_t WS_GLAOS = WS_DPART + al256((size_t)NDEC * 4 * 8 * 132 * 4);
constexpr size_t WS_OLAT = WS_GLAOS + al256((size_t)NDEC * 4 * 128 * 4);
constexpr size_t WS_AS = WS_OLAT + al256((size_t)NDEC * 8 * 128 * 2);
constexpr size_t WS_STATS = WS_AS + (size_t)NDEC * 1024 * 2;
constexpr size_t WS_END = WS_STATS + (size_t)8 * NDEC * 2 * 4;

struct Params {
    const float* x_prompt; const float* x_sample; const float* cache_lat; const float* cache_kr; const float* state_gla;
    const int* page_table; const float* c_prompt; const float* c_sample;
    const float* w_ada; const float* b_ada; const float* w_in; const float* q_norm_g; const float* w_uq; const float* kv_norm_g;
    const float* w_uk; const float* w_uv; const float* w_gate_up; const float* b_gate; const float* gla_norm_g;
    const float* w_out; const float* ln_g; const float* ln_b;
    float* out; unsigned char* ws;
};

__device__ __forceinline__ f32x16 mfma32(bf16x8 a, bf16x8 b, f32x16 c) { return __builtin_amdgcn_mfma_f32_32x32x16_bf16(a, b, c, 0, 0, 0); }
__device__ __forceinline__ unsigned pk2(float lo, float hi) { bf16x2 v = {(__bf16)lo, (__bf16)hi}; return __builtin_bit_cast(unsigned, v); }
__device__ __forceinline__ u32x2 pk4(float a, float b, float c, float d) { u32x2 r; r.x = pk2(a, b); r.y = pk2(c, d); return r; }
__device__ __forceinline__ float bflo(unsigned u) { return __builtin_bit_cast(float, u << 16); }
__device__ __forceinline__ float bfhi(unsigned u) { return __builtin_bit_cast(float, u & 0xffff0000u); }
__device__ __forceinline__ float siluf(float x) { return x * __builtin_amdgcn_rcpf(1.f + __expf(-x)); }
__device__ __forceinline__ float ex2(float x) { return __builtin_amdgcn_exp2f(x); }
__device__ __forceinline__ float wave_sum(float v) {
#pragma unroll
    for (int o = 1; o < 64; o <<= 1) v += __shfl_xor(v, o);
    return v;
}
__device__ __forceinline__ bf16x8 cvt8(f32x4 a, f32x4 b) {
    bf16x8 r; r[0] = (__bf16)a[0]; r[1] = (__bf16)a[1]; r[2] = (__bf16)a[2]; r[3] = (__bf16)a[3]; r[4] = (__bf16)b[0]; r[5] = (__bf16)b[1]; r[6] = (__bf16)b[2]; r[7] = (__bf16)b[3]; return r;
}
__device__ __forceinline__ void unpack8(u32x4 u, float (&f)[8]) {
    f[0] = bflo(u.x); f[1] = bfhi(u.x); f[2] = bflo(u.y); f[3] = bfhi(u.y); f[4] = bflo(u.z); f[5] = bfhi(u.z); f[6] = bflo(u.w); f[7] = bfhi(u.w);
}
__device__ __forceinline__ int permpos(int s) { return (s & ~12) | ((s & 4) << 1) | ((s & 8) >> 1); }

#define XB_TMO      128
#define XB_XCNT(j)  (256  + 64 * (j))
#define XB_XSUB(j)  (1280 + 64 * (j))
#define XB_XGEN(j)  (2304 + 64 * (j))
#define XB_TOP      3328
#define XB_TOPGEN   3392
#define XCD_BAR_WORDS 3456
#define CW_Q2 3520
#define CW_Q3 3584
#define CW_SAMPLE 3648
#define CW_AS 3712
#define CW_COL 3776
#define XB_SPIN_CAP (1u << 22)
#define LAS __attribute__((address_space(3)))
__device__ __forceinline__ unsigned xb_ld(unsigned* p)              { return __hip_atomic_load(p, __ATOMIC_RELAXED, __HIP_MEMORY_SCOPE_AGENT); }
__device__ __forceinline__ unsigned xb_add(unsigned* p, unsigned v) { return __hip_atomic_fetch_add(p, v, __ATOMIC_RELAXED, __HIP_MEMORY_SCOPE_AGENT); }
__device__ __forceinline__ unsigned xb_xcc_id() { return (unsigned)__builtin_amdgcn_s_getreg((3 << 11) | 20) & 0xFu; }
#define XB_SPIN(cond, bar) do { unsigned _sp = 0; while (cond) { __builtin_amdgcn_s_sleep(1); \
    if ((++_sp & 255u) == 0u) { if (xb_ld(&(bar)[XB_TMO])) break; if (_sp > XB_SPIN_CAP) { atomicAdd(&(bar)[XB_TMO], 1u); break; } } } } while (0)
struct XcdBarrier { unsigned* bar; unsigned x; volatile LAS unsigned* st; };
__device__ __forceinline__ XcdBarrier xcd_barrier_post(unsigned* bar, volatile LAS unsigned* st) {
    XcdBarrier b; b.bar = bar; b.x = xb_xcc_id(); b.st = st;
    if (threadIdx.x == 0) (void)xb_add(&bar[XB_XCNT(b.x)], 1u);
    return b;
}
__device__ __forceinline__ void xcd_barrier_complete(unsigned* bar, unsigned x, unsigned& nloc, unsigned& nx) {
    const unsigned G = gridDim.x * gridDim.y * gridDim.z;
    unsigned sum, cnt, mine, sp = 0u;
    for (;;) {
        sum = 0u; cnt = 0u; mine = 0u;
#pragma unroll
        for (unsigned j = 0; j < 16; ++j) { const unsigned c = xb_ld(&bar[XB_XCNT(j)]); sum += c; cnt += (c > 0u) ? 1u : 0u; mine = (j == x) ? c : mine; }
        if (sum == G) break;
        __builtin_amdgcn_s_sleep(1);
        if ((++sp & 255u) == 0u) { if (xb_ld(&bar[XB_TMO])) break; if (sp > XB_SPIN_CAP) { atomicAdd(&bar[XB_TMO], 1u); break; } }
    }
    nloc = mine > 0u ? mine : 1u; nx = cnt > 0u ? cnt : 1u;
}
__device__ __forceinline__ void xcd_barrier(const XcdBarrier& b) {
    asm volatile("s_waitcnt vmcnt(0)" ::: "memory");
    __syncthreads();
    if (threadIdx.x == 0) {
        unsigned* bar = b.bar;
        __builtin_amdgcn_s_waitcnt(0);
        unsigned nloc = b.st[0], nx = b.st[1];
        if (nloc == 0u) { xcd_barrier_complete(bar, b.x, nloc, nx); b.st[0] = nloc; b.st[1] = nx; }
        const unsigned old = xb_add(&bar[XB_XSUB(b.x)], 1u);
        const unsigned gen = old / nloc;
        if (old + 1u == (gen + 1u) * nloc) {
            __builtin_amdgcn_fence(__ATOMIC_RELEASE, "agent");
            asm volatile("s_waitcnt vmcnt(0)" ::: "memory");
            const unsigned og = xb_add(&bar[XB_TOP], 1u);
            const unsigned tg = og / nx;
            if (og + 1u == (tg + 1u) * nx) xb_add(&bar[XB_TOPGEN], 1u);
            else XB_SPIN(xb_ld(&bar[XB_TOPGEN]) == tg, bar);
            __builtin_amdgcn_fence(__ATOMIC_ACQUIRE, "agent");
            xb_add(&bar[XB_XGEN(b.x)], 1u);
            asm volatile("s_waitcnt vmcnt(0)" ::: "memory");
        } else {
            XB_SPIN(xb_ld(&bar[XB_XGEN(b.x)]) == gen, bar);
            __builtin_amdgcn_fence(__ATOMIC_ACQUIRE, "agent");
            asm volatile("s_waitcnt vmcnt(0)" ::: "memory");
        }
    }
    __syncthreads();
}

template <int KS, bool SW>
__device__ __forceinline__ void gemm_2x2(const u32x4* __restrict__ wf, const unsigned char* xl, int xstride, int lane, f32x16 (&acc)[2][2]) {
    constexpr int PF = 8;
    static_assert(KS % PF == 0, "KS must be a multiple of the prefetch depth");
    const int l31 = lane & 31, hh = lane >> 5;
    const unsigned char* x0 = xl + l31 * xstride + hh * 16;
    const unsigned char* x1 = x0 + 32 * xstride;
    const u32x4* w0 = wf + lane;
    const u32x4* w1 = wf + KS * 64 + lane;
    u32x4 ra[PF], rb[PF];
#pragma unroll
    for (int u = 0; u < PF; ++u) { ra[u] = w0[u * 64]; rb[u] = w1[u * 64]; }
#pragma unroll 1
    for (int k0 = 0; k0 < KS; k0 += PF) {
#pragma unroll
        for (int u = 0; u < PF; ++u) {
            const int ks = k0 + u;
            const bf16x8 b0 = *(const bf16x8*)(x0 + ks * 32);
            const bf16x8 b1 = *(const bf16x8*)(x1 + ks * 32);
            const bf16x8 a0 = __builtin_bit_cast(bf16x8, ra[u]);
            const bf16x8 a1 = __builtin_bit_cast(bf16x8, rb[u]);
            if (KS > PF) { ra[u] = w0[(ks + PF) * 64]; rb[u] = w1[(ks + PF) * 64]; }
            __builtin_amdgcn_sched_barrier(0);
            if (SW) {
                acc[0][0] = mfma32(a0, b0, acc[0][0]); acc[0][1] = mfma32(a0, b1, acc[0][1]);
                acc[1][0] = mfma32(a1, b0, acc[1][0]); acc[1][1] = mfma32(a1, b1, acc[1][1]);
            } else {
                acc[0][0] = mfma32(b0, a0, acc[0][0]); acc[0][1] = mfma32(b1, a0, acc[0][1]);
                acc[1][0] = mfma32(b0, a1, acc[1][0]); acc[1][1] = mfma32(b1, a1, acc[1][1]);
            }
            __builtin_amdgcn_sched_barrier(0);
        }
    }
}
constexpr int GPF = 8;
template <int KS, bool SW>
__device__ __forceinline__ void gemm_2x2_stream(const u32x4* __restrict__ wf, const u32x4* __restrict__ wfn, bool fill, const unsigned char* xl, int xstride, int lane,
                                                f32x16 (&acc)[2][2], u32x4 (&ra)[GPF], u32x4 (&rb)[GPF]) {
    static_assert(KS % GPF == 0 && KS >= 2 * GPF, "KS must be a multiple of (and larger than) the prefetch depth");
    const int l31 = lane & 31, hh = lane >> 5;
    const unsigned char* x0 = xl + l31 * xstride + hh * 16;
    const unsigned char* x1 = x0 + 32 * xstride;
    const u32x4* w0 = wf + lane;
    const u32x4* w1 = wf + KS * 64 + lane;
    if (fill) {
#pragma unroll
        for (int u = 0; u < GPF; ++u) { ra[u] = w0[u * 64]; rb[u] = w1[u * 64]; }
    }
    bf16x8 b0 = *(const bf16x8*)(x0), b1 = *(const bf16x8*)(x1);
#pragma unroll 1
    for (int k0 = 0; k0 < KS; k0 += GPF) {
        const bool last = (k0 + GPF >= KS);
        const u32x4* n0 = last ? (wfn + lane) : (w0 + (k0 + GPF) * 64);
        const u32x4* n1 = last ? (wfn + KS * 64 + lane) : (w1 + (k0 + GPF) * 64);
#pragma unroll
        for (int u = 0; u < GPF; ++u) {
            const int ks = k0 + u;
            const bf16x8 nb0 = *(const bf16x8*)(x0 + (ks + 1) * 32);
            const bf16x8 nb1 = *(const bf16x8*)(x1 + (ks + 1) * 32);
            const bf16x8 a0 = __builtin_bit_cast(bf16x8, ra[u]);
            const bf16x8 a1 = __builtin_bit_cast(bf16x8, rb[u]);
            ra[u] = n0[u * 64]; rb[u] = n1[u * 64];
            __builtin_amdgcn_sched_barrier(0);
            if (SW) {
                acc[0][0] = mfma32(a0, b0, acc[0][0]); acc[0][1] = mfma32(a0, b1, acc[0][1]);
                acc[1][0] = mfma32(a1, b0, acc[1][0]); acc[1][1] = mfma32(a1, b1, acc[1][1]);
            } else {
                acc[0][0] = mfma32(b0, a0, acc[0][0]); acc[0][1] = mfma32(b1, a0, acc[0][1]);
                acc[1][0] = mfma32(b0, a1, acc[1][0]); acc[1][1] = mfma32(b1, a1, acc[1][1]);
            }
            __builtin_amdgcn_sched_barrier(0);
            b0 = nb0; b1 = nb1;
        }
    }
}
__device__ __forceinline__ void zero_acc(f32x16 (&acc)[2][2]) {
#pragma unroll
    for (int a = 0; a < 2; ++a)
#pragma unroll
        for (int b = 0; b < 2; ++b)
#pragma unroll
            for (int r = 0; r < 16; ++r) acc[a][b][r] = 0.f;
}
template <int MODE>
__device__ __forceinline__ void store_nat(const f32x16 (&acc)[2][2], __bf16* dst, int ld, int col0, int lane) {
    const int l31 = lane & 31, hh = lane >> 5;
#pragma unroll
    for (int nt = 0; nt < 2; ++nt)
#pragma unroll
        for (int mt = 0; mt < 2; ++mt)
#pragma unroll
            for (int g = 0; g < 4; ++g) {
                float v[4];
#pragma unroll
                for (int i = 0; i < 4; ++i) {
                    float t = acc[nt][mt][4 * g + i];
                    if (MODE == 1) t = siluf(t);
                    if (MODE == 2) t *= 0.125f;
                    if (MODE == 3) t *= QSCALE;
                    v[i] = t;
                }
                *(u32x2*)(dst + (size_t)(32 * mt + l31) * ld + col0 + 32 * nt + 8 * g + 4 * hh) = pk4(v[0], v[1], v[2], v[3]);
            }
}
__device__ __forceinline__ void store_tr(const f32x16 (&acc)[2][2], __bf16* dst, int group, int NT, int rowtile0, int s0, int lane) {
#pragma unroll
    for (int nt = 0; nt < 2; ++nt)
#pragma unroll
        for (int mt = 0; mt < 2; ++mt)
#pragma unroll
            for (int g = 0; g < 4; ++g) {
                const int k16 = (s0 >> 4) + 2 * mt + (g >> 1);
                *(u32x2*)(dst + ((((size_t)group * 128 + k16) * NT + rowtile0 + nt) * 64 + lane) * 8 + 4 * (g & 1)) =
                    pk4(acc[nt][mt][4 * g], acc[nt][mt][4 * g + 1], acc[nt][mt][4 * g + 2], acc[nt][mt][4 * g + 3]);
            }
}

__device__ __forceinline__ int win_col(int np) {
    if (np < 384) return np;
    if (np < 896) return 416 + (np - 384);
    if (np < 1152) return 928 + (np - 896);
    if (np < 1408) return 1184 + (np - 1152);
    if (np < 1920) return 1440 + (np - 1408);
    if (np < 2432) return 1968 + (np - 1920);
    if (np < 2464) return 384 + (np - 2432);
    if (np < 2480) return 1952 + (np - 2464);
    return -1;
}
__device__ void p0_mod_item(const Params& p, int item, unsigned char* lds) {
    int tid = threadIdx.x; asm volatile("" : "+v"(tid));
    const int lane = tid & 63, w = tid >> 6, l31 = lane & 31, hh = lane >> 5;
    const int n0 = item * 32;
    float* mod = (float*)(p.ws + WS_MOD);
    f32x16 acc[5];
#pragma unroll
    for (int m = 0; m < 5; ++m)
#pragma unroll
        for (int r = 0; r < 16; ++r) acc[m][r] = 0.f;
    float aN[8]; f32x4 c0N[5], c1N[5];
    const float* cp[5];
#pragma unroll
    for (int m = 0; m < 5; ++m) { const int row = min(32 * m + l31, 135); cp[m] = (row < 8) ? (p.c_prompt + (size_t)row * 1024) : (p.c_sample + (size_t)(row - 8) * 1024); }
#define MOD_LOAD(k8_) do { const int k0_ = 16 * (8 * w + (k8_)) + 8 * hh; \
        _Pragma("unroll") for (int j = 0; j < 8; ++j) aN[j] = p.w_ada[(size_t)(k0_ + j) * 3072 + n0 + l31]; \
        _Pragma("unroll") for (int m = 0; m < 5; ++m) { c0N[m] = *(const f32x4*)(cp[m] + k0_); c1N[m] = *(const f32x4*)(cp[m] + k0_ + 4); } } while (0)
    MOD_LOAD(0);
#pragma unroll 1
    for (int k8 = 0; k8 < 8; ++k8) {
        float aC[8]; f32x4 c0C[5], c1C[5];
#pragma unroll
        for (int j = 0; j < 8; ++j) aC[j] = aN[j];
#pragma unroll
        for (int m = 0; m < 5; ++m) { c0C[m] = c0N[m]; c1C[m] = c1N[m]; }
        MOD_LOAD(k8 < 7 ? k8 + 1 : 7);
        __builtin_amdgcn_sched_barrier(0);
        bf16x8 a;
#pragma unroll
        for (int j = 0; j < 8; ++j) a[j] = (__bf16)aC[j];
#pragma unroll
        for (int m = 0; m < 5; ++m) {
            bf16x8 bq;
            const bool live = (32 * m + l31) < 136;
#pragma unroll
            for (int j = 0; j < 4; ++j) { bq[j] = (__bf16)(live ? siluf(c0C[m][j]) : 0.f); bq[4 + j] = (__bf16)(live ? siluf(c1C[m][j]) : 0.f); }
            acc[m] = mfma32(a, bq, acc[m]);
        }
        __builtin_amdgcn_sched_barrier(0);
    }
#undef MOD_LOAD
    float* red = (float*)(lds + LDS_BASE);
#pragma unroll
    for (int m = 0; m < 5; ++m) {
#pragma unroll
        for (int r = 0; r < 16; ++r) red[(w * 16 + r) * 64 + lane] = acc[m][r];
        __syncthreads();
#pragma unroll
        for (int q = 0; q < 2; ++q) {
            const int o = tid + 512 * q, r = o >> 6, ln = o & 63;
            float s = 0.f;
#pragma unroll
            for (int ww = 0; ww < 8; ++ww) s += red[(ww * 16 + r) * 64 + ln];
            const int n = n0 + (r & 3) + 8 * (r >> 2) + 4 * (ln >> 5), row = 32 * m + (ln & 31);
            if (row < 136) mod[(size_t)row * 3072 + n] = s + p.b_ada[n];
        }
        __syncthreads();
    }
}
__device__ void p0_convert(const Params& p) {
    int tid0 = threadIdx.x; asm volatile("" : "+v"(tid0));
    const int nmod = (gridDim.x > 128) ? 96 : 0;
    if ((int)blockIdx.x < nmod) return;
    const int gt = ((int)blockIdx.x - nmod) * NTHR + tid0, GT = ((int)gridDim.x - nmod) * NTHR;
    u32x4* winf = (u32x4*)(p.ws + WS_WINF);
    for (int idx = gt; idx < 78 * 64 * 64; idx += GT) {
        const int lane = idx & 63, fk = idx >> 6, ks = fk & 63, nt = fk >> 6;
        const int col = win_col(nt * 32 + (lane & 31)), k0 = ks * 16 + 8 * (lane >> 5);
        float v[8];
#pragma unroll
        for (int j = 0; j < 8; ++j) v[j] = (col >= 0) ? p.w_in[(size_t)(k0 + j) * 2480 + col] : 0.f;
        u32x4 o; o.x = pk2(v[0], v[1]); o.y = pk2(v[2], v[3]); o.z = pk2(v[4], v[5]); o.w = pk2(v[6], v[7]);
        winf[idx] = o;
    }
    u32x4* wuqf = (u32x4*)(p.ws + WS_WUQF);
    for (int idx = gt; idx < 24 * 16 * 64; idx += GT) {
        const int lane = idx & 63, fk = idx >> 6, ks = fk & 15, nt = fk >> 4;
        const int n = nt * 32 + (lane & 31), k0 = ks * 16 + 8 * (lane >> 5);
        float v[8];
#pragma unroll
        for (int j = 0; j < 8; ++j) v[j] = p.w_uq[(size_t)(k0 + j) * 768 + n];
        u32x4 o; o.x = pk2(v[0], v[1]); o.y = pk2(v[2], v[3]); o.z = pk2(v[4], v[5]); o.w = pk2(v[6], v[7]);
        wuqf[idx] = o;
    }
    u32x4* wkvf = (u32x4*)(p.ws + WS_WKVF);
    for (int idx = gt; idx < 32 * 8 * 64; idx += GT) {
        const int lane = idx & 63, fk = idx >> 6, ks = fk & 7, nt = fk >> 3;
        const int n = nt * 32 + (lane & 31), k0 = ks * 16 + 8 * (lane >> 5);
        float v[8];
#pragma unroll
        for (int j = 0; j < 8; ++j) v[j] = (n < 512) ? p.w_uk[(size_t)(k0 + j) * 512 + n] : p.w_uv[(size_t)(k0 + j) * 512 + (n - 512)];
        u32x4 o; o.x = pk2(v[0], v[1]); o.y = pk2(v[2], v[3]); o.z = pk2(v[4], v[5]); o.w = pk2(v[6], v[7]);
        wkvf[idx] = o;
    }
    u32x4* woutf = (u32x4*)(p.ws + WS_WOUTF);
    for (int idx = gt; idx < 32 * 64 * 64; idx += GT) {
        const int lane = idx & 63, fk = idx >> 6, ks = fk & 63, nt = fk >> 6;
        const int n = nt * 32 + (lane & 31), k0 = ks * 16 + 8 * (lane >> 5);
        float v[8];
#pragma unroll
        for (int j = 0; j < 8; ++j) v[j] = p.w_out[(size_t)(k0 + j) * 1024 + n];
        u32x4 o; o.x = pk2(v[0], v[1]); o.y = pk2(v[2], v[3]); o.z = pk2(v[4], v[5]); o.w = pk2(v[6], v[7]);
        woutf[idx] = o;
    }
    __bf16* wukb = (__bf16*)(p.ws + WS_WUKB);
    __bf16* wuvt = (__bf16*)(p.ws + WS_WUVT);
    for (int idx = gt; idx < 65536; idx += GT) {
        wukb[idx] = (__bf16)p.w_uk[idx];
        const int r = idx & 127, v = (idx >> 7) & 63, h = idx >> 13;
        wuvt[idx] = (__bf16)p.w_uv[(size_t)r * 512 + h * 64 + v];
    }
    float* rope = (float*)(p.ws + WS_ROPE);
    for (int idx = gt; idx < 2049 * 16; idx += GT) {
        const int pi = idx >> 4, i = idx & 15;
        const float pos = (pi == 2048) ? 8192.f : (float)pi;
        const float inv = __builtin_amdgcn_exp2f(-(float)(2 * i) * (13.287712379549449f / 32.f));
        const double rev = (double)(pos * inv) * 0.15915494309189535;
        const float fr = (float)(rev - floor(rev));
        const float s = __builtin_amdgcn_sinf(fr), c = __builtin_amdgcn_cosf(fr);
        rope[pi * 32 + i] = c; rope[pi * 32 + 16 + i] = s;
    }
}

constexpr int XS = 2064;
constexpr int ZS = 1808;

__device__ __forceinline__ void p1_post(const Params& p, int it, unsigned char* lds);
__device__ void p1_stripe(const Params& p, int it, int mode, unsigned char* lds) {
    int tid = threadIdx.x; asm volatile("" : "+v"(tid));
    const int lane = tid & 63, w = tid >> 6, l31 = lane & 31, hh = lane >> 5;
    const bool is_s = it >= 256;
    const int srow0 = is_s ? (it - 256) * 64 : 0;
    const int tok0 = is_s ? NTOK + srow0 : it * 64;
    const int b = it >> 5, s0 = (it & 31) * 64;
    unsigned char* A = lds + LDS_BASE;
    const float* mod = (const float*)(p.ws + WS_MOD);
    const float* rope = (const float*)(p.ws + WS_ROPE);
    {
        const int c4 = tid & 255, rb = tid >> 8;
        if (!is_s) {
            const f32x4 sh = *(const f32x4*)(mod + (size_t)b * 3072 + 4 * c4);
            const f32x4 sc = *(const f32x4*)(mod + (size_t)b * 3072 + 1024 + 4 * c4);
            const float* xr = p.x_prompt + (size_t)(it * 64 + rb) * 1024 + 4 * c4;
            {
                f32x4 x[32];
#pragma unroll
                for (int u = 0; u < 32; ++u) x[u] = *(const f32x4*)(xr + (size_t)u * 2048);
                __builtin_amdgcn_sched_barrier(0);
#pragma unroll
                for (int u = 0; u < 32; ++u)
                    *(u32x2*)(A + (2 * u + rb) * XS + c4 * 8) = pk4(x[u][0] * (1.f + sc[0]) + sh[0], x[u][1] * (1.f + sc[1]) + sh[1], x[u][2] * (1.f + sc[2]) + sh[2], x[u][3] * (1.f + sc[3]) + sh[3]);
            }
        } else {
#pragma unroll 1
            for (int i0 = 0; i0 < 32; i0 += 4) {
                f32x4 x[4], sh[4], sc[4];
#pragma unroll
                for (int u = 0; u < 4; ++u) {
                    const int row = 2 * (i0 + u) + rb;
                    x[u] = *(const f32x4*)(p.x_sample + (size_t)(srow0 + row) * 1024 + 4 * c4);
                    sh[u] = *(const f32x4*)(mod + (size_t)(8 + srow0 + row) * 3072 + 4 * c4);
                    sc[u] = *(const f32x4*)(mod + (size_t)(8 + srow0 + row) * 3072 + 1024 + 4 * c4);
                }
                __builtin_amdgcn_sched_barrier(0);
#pragma unroll
                for (int u = 0; u < 4; ++u)
                    *(u32x2*)(A + (2 * (i0 + u) + rb) * XS + c4 * 8) = pk4(x[u][0] * (1.f + sc[u][0]) + sh[u][0], x[u][1] * (1.f + sc[u][1]) + sh[u][1], x[u][2] * (1.f + sc[u][2]) + sh[u][2], x[u][3] * (1.f + sc[u][3]) + sh[u][3]);
            }
        }
    }
    __syncthreads();
    const u32x4* winf = (const u32x4*)(p.ws + WS_WINF);
    __bf16* GM = (__bf16*)(p.ws + WS_GM); __bf16* GQ = (__bf16*)(p.ws + WS_GQ); __bf16* GK = (__bf16*)(p.ws + WS_GK);
    __bf16* GV = (__bf16*)(p.ws + WS_GV); __bf16* GG = (__bf16*)(p.ws + WS_GG);
    __bf16* GKT = (__bf16*)(p.ws + WS_GKT); __bf16* GVT = (__bf16*)(p.ws + WS_GVT);
    f32x16 acc[2][2];
    u32x4 ringa[GPF], ringb[GPF];
    const int sst = (w < 6) ? w : 38;
    bool fill = true;
#pragma unroll 1
    for (int i = 0; i < 4; ++i) {
        if (mode == 1 || (mode >= 2 && i != mode - 2)) continue;
        const int st = 6 + w + 8 * i;
        const int stn = (mode == 0) ? ((i < 3) ? st + 8 : ((w < 7) ? sst : st)) : st;
        zero_acc(acc);
        const bool tr = (!is_s) && (st >= 22 && st < 30);
        if (tr) gemm_2x2_stream<64, false>(winf + (size_t)st * 2 * 64 * 64, winf + (size_t)stn * 2 * 64 * 64, fill, A, XS, lane, acc, ringa, ringb);
        else    gemm_2x2_stream<64, true >(winf + (size_t)st * 2 * 64 * 64, winf + (size_t)stn * 2 * 64 * 64, fill, A, XS, lane, acc, ringa, ringb);
        fill = (mode != 0);
        int lane2 = lane; asm volatile("" : "+v"(lane2));
        if (st < 14) store_nat<1>(acc, GM + (size_t)tok0 * 512, 512, (st - 6) * 64, lane2);
        else if (st < 18) store_nat<2>(acc, GQ + (size_t)tok0 * 256, 256, (st - 14) * 64, lane2);
        else if (st < 22) {
            store_nat<0>(acc, GK + (size_t)tok0 * 256, 256, (st - 18) * 64, lane2);
            if (!is_s) {
                const int l31b = lane2 & 31, hhb = lane2 >> 5;
                __bf16* gb = GKT + ((((size_t)(b * 4 + (st - 18)) * 128 + (s0 >> 4) + (l31b >> 4)) * 2) * 64 + 32 * ((l31b >> 2) & 1) + 4 * hhb) * 8 + 4 * ((l31b >> 3) & 1) + (l31b & 3);
#pragma unroll
                for (int mt = 0; mt < 2; ++mt)
#pragma unroll
                    for (int nt = 0; nt < 2; ++nt)
#pragma unroll
                        for (int r = 0; r < 16; ++r)
                            gb[(size_t)mt * 2 * 2 * 512 + nt * 512 + ((r & 3) + 8 * (r >> 2)) * 8] = (__bf16)acc[nt][mt][r];
            }
        } else if (st < 30) {
            if (tr) store_tr(acc, GVT, b * 4 + ((st - 22) >> 1), 4, ((st - 22) & 1) * 2, s0, lane2);
            else store_nat<0>(acc, GV + (size_t)tok0 * 512, 512, (st - 22) * 64, lane2);
        } else store_nat<1>(acc, GG + (size_t)tok0 * 512, 512, (st - 30) * 64, lane2);
    }
    if (mode >= 2) { __syncthreads(); return; }
    if (w < 7) { zero_acc(acc); gemm_2x2_stream<64, true>(winf + (size_t)sst * 2 * 64 * 64, winf + (size_t)sst * 2 * 64 * 64, fill, A, XS, lane, acc, ringa, ringb); }
    __syncthreads();
    unsigned char* Z = A;
    if (w < 7) {
        const int cb = (w < 4) ? 64 * w : (w < 6 ? 256 + 64 * (w - 4) : 384);
#pragma unroll
        for (int nt = 0; nt < 2; ++nt)
#pragma unroll
            for (int mt = 0; mt < 2; ++mt)
#pragma unroll
                for (int g = 0; g < 4; ++g) {
                    f32x4 v = {acc[nt][mt][4 * g], acc[nt][mt][4 * g + 1], acc[nt][mt][4 * g + 2], acc[nt][mt][4 * g + 3]};
                    *(f32x4*)(Z + (32 * mt + l31) * ZS + (cb + 32 * nt + 8 * g + 4 * hh) * 4) = v;
                }
    }
    __syncthreads();
    p1_post(p, it, lds);
}

__device__ __forceinline__ void p1_post(const Params& p, int it, unsigned char* lds) {
    int tid = threadIdx.x; asm volatile("" : "+v"(tid));
    const int lane = tid & 63, w = tid >> 6, l31 = lane & 31, hh = lane >> 5;
    const bool is_s = it >= 256;
    const int srow0 = is_s ? (it - 256) * 64 : 0;
    const int tok0 = is_s ? NTOK + srow0 : it * 64;
    const int b = it >> 5, s0 = (it & 31) * 64;
    unsigned char* Z = lds + LDS_BASE;
    const float* rope = (const float*)(p.ws + WS_ROPE);
    f32x16 acc[2][2];
    float* latout = p.out + (is_s ? OUT_LATS + (size_t)srow0 * 128 : OUT_LATP + (size_t)it * 64 * 128);
    for (int rr = 0; rr < 8; ++rr) {
        const int row = 8 * w + rr;
        unsigned char* zr = Z + row * ZS;
        const f32x4 v = *(const f32x4*)(zr + 16 * lane);
        const float ss = wave_sum(v[0] * v[0] + v[1] * v[1] + v[2] * v[2] + v[3] * v[3]);
        const float inv = rsqrtf(ss * (1.f / 256.f) + NORM_EPS);
        const f32x4 g = *(const f32x4*)(p.q_norm_g + 4 * lane);
        const f32x2 c = *(const f32x2*)(zr + 1024 + 8 * lane);
        const float ss2 = wave_sum(c[0] * c[0] + c[1] * c[1]);
        const float inv2 = rsqrtf(ss2 * (1.f / 128.f) + NORM_EPS);
        const f32x2 g2 = *(const f32x2*)(p.kv_norm_g + 2 * lane);
        const float y0 = c[0] * inv2 * g2[0], y1 = c[1] * inv2 * g2[1];
        *(u32x2*)(zr + 8 * lane) = pk4(v[0] * inv * g[0], v[1] * inv * g[1], v[2] * inv * g[2], v[3] * inv * g[3]);
        *(unsigned*)(zr + 1024 + 4 * lane) = pk2(y0, y1);
        f32x2 yo = {y0, y1};
        *(f32x2*)(latout + (size_t)row * 128 + 2 * lane) = yo;
    }
    {
        float* krout = p.out + (is_s ? OUT_KRS + (size_t)srow0 * 32 : OUT_KRP + (size_t)it * 64 * 32);
        __bf16* KR = (__bf16*)(p.ws + WS_KR);
#pragma unroll
        for (int q = 0; q < 2; ++q) {
            const int idx = tid + NTHR * q, row = idx >> 4, i = idx & 15;
            const float* zr = (const float*)(Z + row * ZS);
            const float x1 = zr[384 + i], x2 = zr[400 + i];
            const int pi = is_s ? 2048 : s0 + row;
            const float cs = rope[pi * 32 + i], sn = rope[pi * 32 + 16 + i];
            const float o1 = x1 * cs - x2 * sn, o2 = x2 * cs + x1 * sn;
            krout[row * 32 + i] = o1; krout[row * 32 + 16 + i] = o2;
            if (!is_s) { KR[((size_t)b * 2048 + s0 + row) * 32 + i] = (__bf16)o1; KR[((size_t)b * 2048 + s0 + row) * 32 + 16 + i] = (__bf16)o2; }
        }
    }
    {
        const int n = 32 * w + l31, h = w >> 1, dk = 32 * (w & 1) + l31;
        bf16x8 wb;
#pragma unroll
        for (int e = 0; e < 8; ++e) wb[e] = (__bf16)p.w_gate_up[(8 * hh + e) * 256 + n];
        const float bg = p.b_gate[n];
        f32x16 la[2];
#pragma unroll
        for (int mt = 0; mt < 2; ++mt) {
            const float* zr = (const float*)(Z + (32 * mt + l31) * ZS);
            const bf16x8 ga = cvt8(*(const f32x4*)(zr + 416 + 8 * hh), *(const f32x4*)(zr + 420 + 8 * hh));
#pragma unroll
            for (int r = 0; r < 16; ++r) la[mt][r] = 0.f;
            la[mt] = mfma32(ga, wb, la[mt]);
#pragma unroll
            for (int r = 0; r < 16; ++r) { const float a = la[mt][r] + bg; la[mt][r] = (fminf(a, 0.f) - __logf(1.f + __expf(-fabsf(a)))) * (1.f / 16.f); }
        }
        if (!is_s) {
            float carry = 0.f;
#pragma unroll
            for (int mt = 0; mt < 2; ++mt) {
                float bs[4], ps[4];
#pragma unroll
                for (int g = 0; g < 4; ++g) { bs[g] = (la[mt][4 * g] + la[mt][4 * g + 1]) + (la[mt][4 * g + 2] + la[mt][4 * g + 3]); ps[g] = __shfl_xor(bs[g], 32); }
#pragma unroll
                for (int g = 0; g < 4; ++g) {
                    const float b0s = hh ? ps[g] : bs[g], b1s = hh ? bs[g] : ps[g];
                    float run = carry + (hh ? b0s : 0.f);
#pragma unroll
                    for (int i = 0; i < 4; ++i) { run += la[mt][4 * g + i]; la[mt][4 * g + i] = run; }
                    carry += b0s + b1s;
                }
            }
        }
        float* LAB = (float*)(p.ws + WS_LAB) + (size_t)tok0 * 256 + n;
#pragma unroll
        for (int mt = 0; mt < 2; ++mt)
#pragma unroll
            for (int r = 0; r < 16; ++r) LAB[(size_t)(32 * mt + (r & 3) + 8 * (r >> 2) + 4 * hh) * 256] = la[mt][r];
        if (!is_s) {
            float* BT = (float*)(p.ws + WS_BT);
#pragma unroll
            for (int mt = 0; mt < 2; ++mt)
#pragma unroll
                for (int g = 0; g < 4; ++g) {
                    const int k16 = (s0 >> 4) + 2 * mt + (g >> 1);
                    f32x4 v = {la[mt][4 * g], la[mt][4 * g + 1], la[mt][4 * g + 2], la[mt][4 * g + 3]};
                    *(f32x4*)(BT + ((((size_t)(b * 4 + h) * 128 + k16) * 2 + (w & 1)) * 64 + lane) * 8 + 4 * (g & 1)) = v;
                }
            if (hh) ((float*)(p.ws + WS_BL))[((size_t)(b * 4 + h) * 32 + (s0 >> 6)) * 64 + dk] = la[1][15];
        }
    }
    __syncthreads();
    {
        const u32x4* wuqf = (const u32x4*)(p.ws + WS_WUQF);
        const int h = w;
        const unsigned char* x0 = Z + l31 * ZS + hh * 16;
        const unsigned char* x1 = x0 + 32 * ZS;
        const int qoff = (h < 4) ? 512 + 128 * h : 1280 + 128 * (h - 4);
        __bf16* QLR = (__bf16*)(p.ws + WS_QLR);
        __bf16* Q = (__bf16*)(p.ws + WS_Q) + ((size_t)(b * 8 + h) * 2048 + s0) * 96;
#pragma unroll 1
        for (int j = 0; j < 3; ++j) {
            f32x16 q[2];
#pragma unroll
            for (int m = 0; m < 2; ++m)
#pragma unroll
                for (int r = 0; r < 16; ++r) q[m][r] = 0.f;
            const u32x4* wq = wuqf + (size_t)(3 * h + j) * 16 * 64 + lane;
            u32x4 rq[16];
#pragma unroll
            for (int ks = 0; ks < 16; ++ks) rq[ks] = wq[ks * 64];
            __builtin_amdgcn_sched_barrier(0);
#pragma unroll
            for (int ks = 0; ks < 16; ++ks) {
                const bf16x8 a = __builtin_bit_cast(bf16x8, rq[ks]);
                const bf16x8 b0 = *(const bf16x8*)(x0 + ks * 32), b1 = *(const bf16x8*)(x1 + ks * 32);
                q[0] = mfma32(a, b0, q[0]); q[1] = mfma32(a, b1, q[1]);
            }
            if (j == 2) {
#pragma unroll
                for (int m = 0; m < 2; ++m) {
                    const int pi = is_s ? 2048 : s0 + 32 * m + l31;
#pragma unroll
                    for (int g = 0; g < 2; ++g) {
                        const f32x4 cs = *(const f32x4*)(rope + pi * 32 + 8 * g + 4 * hh);
                        const f32x4 sn = *(const f32x4*)(rope + pi * 32 + 16 + 8 * g + 4 * hh);
#pragma unroll
                        for (int i = 0; i < 4; ++i) {
                            const float x1v = q[m][4 * g + i], x2v = q[m][4 * g + 8 + i];
                            q[m][4 * g + i] = x1v * cs[i] - x2v * sn[i];
                            q[m][4 * g + 8 + i] = x2v * cs[i] + x1v * sn[i];
                        }
                    }
                }
            }
#pragma unroll
            for (int m = 0; m < 2; ++m)
#pragma unroll
                for (int g = 0; g < 4; ++g) {
                    const int tok = 32 * m + l31;
                    if (!is_s) {
                        *(u32x2*)(Q + (size_t)tok * 96 + 32 * j + 8 * g + 4 * hh) = pk4(q[m][4 * g] * QSCALE, q[m][4 * g + 1] * QSCALE, q[m][4 * g + 2] * QSCALE, q[m][4 * g + 3] * QSCALE);
                    } else if (j == 2) {
                        *(u32x2*)(QLR + ((size_t)(srow0 + tok) * 8 + h) * 160 + 128 + 8 * g + 4 * hh) = pk4(q[m][4 * g] * QSCALE, q[m][4 * g + 1] * QSCALE, q[m][4 * g + 2] * QSCALE, q[m][4 * g + 3] * QSCALE);
                    } else {
                        *(u32x2*)(Z + tok * ZS + qoff + (32 * j + 8 * g + 4 * hh) * 2) = pk4(q[m][4 * g], q[m][4 * g + 1], q[m][4 * g + 2], q[m][4 * g + 3]);
                    }
                }
        }
        if (is_s) {
            asm volatile("s_waitcnt lgkmcnt(0)" ::: "memory");
            const __bf16* wukb = (const __bf16*)(p.ws + WS_WUKB);
#pragma unroll 1
            for (int rt = 0; rt < 4; ++rt) {
                f32x16 ql[2];
#pragma unroll
                for (int m = 0; m < 2; ++m)
#pragma unroll
                    for (int r = 0; r < 16; ++r) ql[m][r] = 0.f;
#pragma unroll
                for (int ks = 0; ks < 4; ++ks) {
                    const bf16x8 b0 = *(const bf16x8*)(Z + l31 * ZS + qoff + (16 * ks + 8 * hh) * 2);
                    const bf16x8 b1 = *(const bf16x8*)(Z + (32 + l31) * ZS + qoff + (16 * ks + 8 * hh) * 2);
                    const bf16x8 a = *(const bf16x8*)(wukb + ((size_t)(32 * rt + l31) * 8 + h) * 64 + 16 * ks + 8 * hh);
                    ql[0] = mfma32(a, b0, ql[0]); ql[1] = mfma32(a, b1, ql[1]);
                }
#pragma unroll
                for (int m = 0; m < 2; ++m)
#pragma unroll
                    for (int g = 0; g < 4; ++g)
                        *(u32x2*)(QLR + ((size_t)(srow0 + 32 * m + l31) * 8 + h) * 160 + 32 * rt + 8 * g + 4 * hh) =
                            pk4(ql[m][4 * g] * QSCALE, ql[m][4 * g + 1] * QSCALE, ql[m][4 * g + 2] * QSCALE, ql[m][4 * g + 3] * QSCALE);
            }
        }
    }
    if (!is_s) {
        const u32x4* wkvf = (const u32x4*)(p.ws + WS_WKVF);
        __bf16* KN = (__bf16*)(p.ws + WS_KN);
        __bf16* VT = (__bf16*)(p.ws + WS_VT);
#pragma unroll 1
        for (int pp = 0; pp < 2; ++pp) {
            const int nt0 = 4 * w + 2 * pp;
            zero_acc(acc);
            if (w < 4) {
                gemm_2x2<8, true>(wkvf + (size_t)nt0 * 8 * 64, Z + 1024, ZS, lane, acc);
                const int hd = nt0 >> 1;
                store_nat<0>(acc, KN + ((size_t)(b * 8 + hd) * 2048 + s0) * 64, 64, 0, lane);
            } else {
                gemm_2x2<8, false>(wkvf + (size_t)nt0 * 8 * 64, Z + 1024, ZS, lane, acc);
                const int hd = (nt0 - 16) >> 1;
                store_tr(acc, VT, b * 8 + hd, 2, 0, s0, lane);
            }
        }
    }
    __syncthreads();
}

constexpr int KST = 208, VST = 144;
constexpr int KBUF = 64 * KST, VBUF = 8192;

__device__ void p2_attn(const Params& p, int bh, int qb, unsigned char* lds) {
    int tid = threadIdx.x; asm volatile("" : "+v"(tid));
    const int lane = tid & 63, w = tid >> 6, l31 = lane & 31, hh = lane >> 5;
    const int b = bh >> 3, h = bh & 7;
    const __bf16* Q = (const __bf16*)(p.ws + WS_Q) + (size_t)bh * 2048 * 96;
    const __bf16* KN = (const __bf16*)(p.ws + WS_KN) + (size_t)bh * 2048 * 64;
    const __bf16* KR = (const __bf16*)(p.ws + WS_KR) + (size_t)b * 2048 * 32;
    const __bf16* VT = (const __bf16*)(p.ws + WS_VT) + (size_t)bh * 64 * 2048;
    unsigned char* Kb = lds + LDS_BASE;
    unsigned char* Vb = Kb + 2 * KBUF;
    const int qrow0 = qb * 256 + 32 * w, qi = qrow0 + l31;
    bf16x8 qf[6];
#pragma unroll
    for (int ks = 0; ks < 6; ++ks) qf[ks] = *(const bf16x8*)(Q + (size_t)qi * 96 + 16 * ks + 8 * hh);
    f32x16 o[2];
#pragma unroll
    for (int d = 0; d < 2; ++d)
#pragma unroll
        for (int r = 0; r < 16; ++r) o[d][r] = 0.f;
    float m = -1e30f, l = 0.f;
    const int nkt = (qb + 1) * 4;
    const int key_k = tid >> 3, ch_k = tid & 7, key_r = tid >> 2, ch_r = tid & 3;
    u32x4 kA, rA = {0u, 0u, 0u, 0u}, vA, kB, rB = {0u, 0u, 0u, 0u}, vB;
#define ATT_LOAD(kx, rx, vx, jt_) do { const int jc_ = ((jt_) < nkt) ? (jt_) : (nkt - 1); const int k0_ = 64 * jc_; \
        kx = *(const u32x4*)(KN + (size_t)(k0_ + key_k) * 64 + 8 * ch_k); \
        if (tid < 256) rx = *(const u32x4*)(KR + (size_t)(k0_ + key_r) * 32 + 8 * ch_r); \
        vx = *(const u32x4*)(VT + (size_t)jc_ * 4096 + (size_t)tid * 8); } while (0)
#define ATT_STORE(kx, rx, vx, buf_) do { unsigned char* kn_ = Kb + (buf_) * KBUF; unsigned char* vn_ = Vb + (buf_) * VBUF; \
        *(u32x4*)(kn_ + key_k * KST + ch_k * 16) = kx; \
        if (tid < 256) *(u32x4*)(kn_ + key_r * KST + 128 + ch_r * 16) = rx; \
        *(u32x4*)(vn_ + tid * 16) = vx; } while (0)
#define ATT_COMPUTE(j_, cur_) do { \
        const unsigned char* kb = Kb + (cur_) * KBUF; \
        const unsigned char* vb = Vb + (cur_) * VBUF; \
        _Pragma("unroll") for (int sub = 0; sub < 2; ++sub) { \
            const int key_lo = 64 * (j_) + 32 * sub; \
            if (key_lo <= qrow0 + 31) { \
                f32x16 s; \
                _Pragma("unroll") for (int r = 0; r < 16; ++r) s[r] = 0.f; \
                _Pragma("unroll") for (int ks = 0; ks < 6; ++ks) { \
                    const bf16x8 kf = *(const bf16x8*)(kb + (32 * sub + l31) * KST + (16 * ks + 8 * hh) * 2); \
                    s = mfma32(kf, qf[ks], s); } \
                if (key_lo + 31 > qrow0) { \
                    _Pragma("unroll") for (int r = 0; r < 16; ++r) { const int key = key_lo + (r & 3) + 8 * (r >> 2) + 4 * hh; if (key > qi) s[r] = -1e30f; } } \
                float mx = s[0]; \
                _Pragma("unroll") for (int r = 1; r < 16; ++r) mx = fmaxf(mx, s[r]); \
                mx = fmaxf(mx, __shfl_xor(mx, 32)); \
                const float mn = fmaxf(m, mx), alpha = ex2(m - mn); \
                m = mn; \
                float ps = 0.f; \
                _Pragma("unroll") for (int r = 0; r < 16; ++r) { s[r] = ex2(s[r] - mn); ps += s[r]; } \
                l = l * alpha + ps; \
                _Pragma("unroll") for (int d = 0; d < 2; ++d) _Pragma("unroll") for (int r = 0; r < 16; ++r) o[d][r] *= alpha; \
                _Pragma("unroll") for (int sk = 0; sk < 2; ++sk) { \
                    bf16x8 pf; \
                    _Pragma("unroll") for (int e = 0; e < 8; ++e) pf[e] = (__bf16)s[8 * sk + e]; \
                    _Pragma("unroll") for (int d = 0; d < 2; ++d) { \
                        const bf16x8 vf = *(const bf16x8*)(vb + ((2 * sub + sk) * 2 + d) * 1024 + lane * 16); \
                        o[d] = mfma32(vf, pf, o[d]); } } } } } while (0)
    ATT_LOAD(kA, rA, vA, 0);
    ATT_LOAD(kB, rB, vB, 1);
    ATT_STORE(kA, rA, vA, 0);
    ATT_LOAD(kA, rA, vA, 2);
    __syncthreads();
    for (int j = 0; j < nkt; j += 2) {
        ATT_COMPUTE(j, 0);
        ATT_STORE(kB, rB, vB, 1);
        ATT_LOAD(kB, rB, vB, j + 3);
        __syncthreads();
        ATT_COMPUTE(j + 1, 1);
        ATT_STORE(kA, rA, vA, 0);
        ATT_LOAD(kA, rA, vA, j + 4);
        __syncthreads();
    }
#undef ATT_LOAD
#undef ATT_STORE
#undef ATT_COMPUTE
    const float lt = l + __shfl_xor(l, 32);
    const float inv = 1.f / lt;
    __bf16* AO = (__bf16*)(p.ws + WS_AO) + ((size_t)b * 2048 + qi) * 512 + h * 64;
#pragma unroll
    for (int d = 0; d < 2; ++d)
#pragma unroll
        for (int g = 0; g < 4; ++g)
            *(u32x2*)(AO + 32 * d + 8 * g + 4 * hh) = pk4(o[d][4 * g] * inv, o[d][4 * g + 1] * inv, o[d][4 * g + 2] * inv, o[d][4 * g + 3] * inv);
}

constexpr int DVS = 80;
constexpr int DW_BYTES = 8192 + 32 * DVS + 16 * DVS;
typedef short s16x4 __attribute__((ext_vector_type(4)));
__device__ __forceinline__ f32x4 mfma16(bf16x8 a, bf16x8 b, f32x4 c) { return __builtin_amdgcn_mfma_f32_16x16x32_bf16(a, b, c, 0, 0, 0); }
__device__ __forceinline__ s16x4 lds_tr16(const unsigned char* q) { return __builtin_amdgcn_ds_read_tr16_b64_v4i16((LAS s16x4*)q); }
__device__ void p2_decode(const Params& p, int bs, int split, unsigned char* lds) {
    int tid = threadIdx.x; asm volatile("" : "+v"(tid));
    const int lane = tid & 63, w = tid >> 6, l15 = lane & 15, q4 = lane >> 4;
    unsigned char* IMG = lds + LDS_BASE + w * DW_BYTES;
    unsigned char* KRI = IMG + 8192;
    unsigned char* WP = KRI + 32 * DVS;
    const __bf16* QLR = (const __bf16*)(p.ws + WS_QLR);
    const int pg0 = split * 16 + 2 * w;
    const int phys0 = p.page_table[bs * NPAGES + pg0], phys1 = p.page_table[bs * NPAGES + pg0 + 1];
    f32x4 raw[20];
#define DEC_ISSUE(tt_) do { const int phys_ = ((tt_) >> 2) ? phys1 : phys0; \
        const float* lp_ = p.cache_lat + ((size_t)phys_ * 128 + ((tt_) & 3) * 32) * 128 + 4 * lane; \
        const float* kp_ = p.cache_kr + ((size_t)phys_ * 128 + ((tt_) & 3) * 32) * 32 + 4 * lane; \
        _Pragma("unroll") for (int i = 0; i < 16; ++i) raw[i] = *(const f32x4*)(lp_ + 256 * i); \
        _Pragma("unroll") for (int i = 0; i < 4; ++i) raw[16 + i] = *(const f32x4*)(kp_ + 256 * i); } while (0)
    DEC_ISSUE(0);
    bf16x8 qf[5];
#pragma unroll
    for (int ks = 0; ks < 5; ++ks) {
        u32x4 v = *(const u32x4*)(QLR + ((size_t)bs * 8 + (l15 & 7)) * 160 + 32 * ks + 8 * q4);
        if (l15 >= 8) v = (u32x4){0u, 0u, 0u, 0u};
        qf[ks] = __builtin_bit_cast(bf16x8, v);
    }
    const int hi = lane >> 5;
    const int W0 = 256 * hi + 16 * (((lane & 31) >> 1) ^ (hi << 2)) + 8 * (lane & 1);
    const int KW0 = (lane >> 3) * DVS + 8 * (lane & 7);
    const int RB0 = 256 * l15 + 16 * (q4 ^ (l15 >> 2)) + 64 * (l15 & 3);
    const int TQ = l15 >> 2, TP = lane & 3;
    const int T00 = 256 * (8 * q4 + TQ) + 16 * ((TP >> 1) ^ ((TQ << 2) | ((2 * q4) & 3))) + 8 * (TP & 1);
    const int T01 = 256 * (8 * q4 + 4 + TQ) + 16 * ((TP >> 1) ^ ((TQ << 2) | ((2 * q4 + 1) & 3))) + 8 * (TP & 1);
    f32x4 o[8];
#pragma unroll
    for (int t = 0; t < 8; ++t) o[t] = (f32x4){0.f, 0.f, 0.f, 0.f};
    float m = -1e30f, l = 0.f;
#pragma unroll 1
    for (int tt = 0; tt < 8; ++tt) {
#pragma unroll
        for (int i = 0; i < 16; ++i) {
            const int ci = (((2 * i) & 3) << 2) | ((i >> 1) & 3);
            *(u32x2*)(IMG + 512 * i + (W0 ^ (ci << 4))) = pk4(raw[i][0], raw[i][1], raw[i][2], raw[i][3]);
        }
#pragma unroll
        for (int i = 0; i < 4; ++i) *(u32x2*)(KRI + 8 * i * DVS + KW0) = pk4(raw[16 + i][0], raw[16 + i][1], raw[16 + i][2], raw[16 + i][3]);
        asm volatile("" ::: "memory");
        DEC_ISSUE(tt < 7 ? tt + 1 : 7);
        f32x4 s[2];
#pragma unroll
        for (int j = 0; j < 2; ++j) {
            s[j] = (f32x4){0.f, 0.f, 0.f, 0.f};
#pragma unroll
            for (int ks = 0; ks < 4; ++ks) {
                const bf16x8 kf = *(const bf16x8*)(IMG + 4096 * j + (RB0 ^ (ks << 6)));
                s[j] = mfma16(kf, qf[ks], s[j]);
            }
            const bf16x8 kf = *(const bf16x8*)(KRI + (16 * j + l15) * DVS + 16 * q4);
            s[j] = mfma16(kf, qf[4], s[j]);
        }
        float mx = fmaxf(fmaxf(fmaxf(s[0][0], s[0][1]), fmaxf(s[0][2], s[0][3])), fmaxf(fmaxf(s[1][0], s[1][1]), fmaxf(s[1][2], s[1][3])));
        mx = fmaxf(mx, __shfl_xor(mx, 16)); mx = fmaxf(mx, __shfl_xor(mx, 32));
        const float mn = fmaxf(m, mx), alpha = ex2(m - mn);
        m = mn;
        float ps = 0.f;
#pragma unroll
        for (int j = 0; j < 2; ++j)
#pragma unroll
            for (int r = 0; r < 4; ++r) { s[j][r] = ex2(s[j][r] - mn); ps += s[j][r]; }
        l = l * alpha + ps;
#pragma unroll
        for (int t = 0; t < 8; ++t) o[t] *= alpha;
#pragma unroll
        for (int j = 0; j < 2; ++j) *(u32x2*)(WP + l15 * DVS + (16 * j + 4 * q4) * 2) = pk4(s[j][0], s[j][1], s[j][2], s[j][3]);
        {
            const bf16x8 pf = *(const bf16x8*)(WP + l15 * DVS + 8 * q4 * 2);
#pragma unroll
            for (int t = 0; t < 8; ++t) {
                const s16x4 v0 = lds_tr16(IMG + (T00 ^ (t << 5))), v1 = lds_tr16(IMG + (T01 ^ (t << 5)));
                typedef short s16x8 __attribute__((ext_vector_type(8)));
                const s16x8 vv = {v0[0], v0[1], v0[2], v0[3], v1[0], v1[1], v1[2], v1[3]};
                o[t] = mfma16(__builtin_bit_cast(bf16x8, vv), pf, o[t]);
            }
        }
    }
#undef DEC_ISSUE
    float lt = l + __shfl_xor(l, 16); lt += __shfl_xor(lt, 32);
    __syncthreads();
    float* MG = (float*)(lds + LDS_BASE);
    if (l15 < 8) {
        float* rec = MG + (w * 8 + l15) * 132;
        if (q4 == 0) { rec[0] = m; rec[1] = lt; }
#pragma unroll
        for (int t = 0; t < 8; ++t) *(f32x4*)(rec + 4 + 16 * t + 4 * q4) = o[t];
    }
    __syncthreads();
    {
        const int hd = tid >> 6, r2 = 2 * (tid & 63);
        float M = -1e30f;
#pragma unroll
        for (int ww = 0; ww < 8; ++ww) M = fmaxf(M, MG[(ww * 8 + hd) * 132]);
        float L = 0.f, o0 = 0.f, o1 = 0.f;
#pragma unroll
        for (int ww = 0; ww < 8; ++ww) {
            const float* rec = MG + (ww * 8 + hd) * 132;
            const float wt = ex2(rec[0] - M);
            L = fmaf(wt, rec[1], L); o0 = fmaf(wt, rec[4 + r2], o0); o1 = fmaf(wt, rec[5 + r2], o1);
        }
        float* dp = (float*)(p.ws + WS_DPART) + ((size_t)(bs * 4 + split) * 8 + hd) * 132;
        if ((tid & 63) == 0) { dp[0] = M; dp[1] = L; }
        f32x2 ov = {o0, o1};
        *(f32x2*)(dp + 4 + r2) = ov;
    }
    __syncthreads();
}

__device__ void p2_scan(const Params& p, int bh) {
    int tid = threadIdx.x; asm volatile("" : "+v"(tid));
    const int lane = tid & 63, w = tid >> 6, l31 = lane & 31, hh = lane >> 5;
    const int dkt = w & 1, dvt = w >> 1;
    const float* BT = (const float*)(p.ws + WS_BT) + (size_t)bh * 64 * 2048;
    const __bf16* GKT = (const __bf16*)(p.ws + WS_GKT) + (size_t)bh * 64 * 2048;
    const __bf16* GVT = (const __bf16*)(p.ws + WS_GVT) + (size_t)bh * 128 * 2048;
    const float* BL = (const float*)(p.ws + WS_BL) + (size_t)bh * 32 * 64;
    __bf16* ST2 = (__bf16*)(p.ws + WS_ST2) + (size_t)bh * 32 * 128 * 64;
    const int dkA = 32 * dkt + l31, dvB = 32 * dvt + l31;
    f32x16 S;
#pragma unroll
    for (int r = 0; r < 16; ++r) S[r] = 0.f;
    float decN[16], blN; u32x4 kN[4]; f32x4 b0N[4], b1N[4]; bf16x8 vN[4];
#define SCAN_LOAD(c_) do { \
        _Pragma("unroll") for (int r = 0; r < 16; ++r) decN[r] = BL[(c_) * 64 + 32 * dkt + (r & 3) + 8 * (r >> 2) + 4 * hh]; \
        blN = BL[(c_) * 64 + dkA]; \
        _Pragma("unroll") for (int ks = 0; ks < 4; ++ks) { const size_t k16 = (size_t)(c_) * 4 + ks; \
            kN[ks] = *(const u32x4*)(GKT + ((k16 * 2 + dkt) * 64 + lane) * 8); \
            b0N[ks] = *(const f32x4*)(BT + ((k16 * 2 + dkt) * 64 + lane) * 8); b1N[ks] = *(const f32x4*)(BT + ((k16 * 2 + dkt) * 64 + lane) * 8 + 4); \
            vN[ks] = *(const bf16x8*)(GVT + ((k16 * 4 + dvt) * 64 + lane) * 8); } \
    } while (0)
    SCAN_LOAD(0);
#pragma unroll 1
    for (int c = 0; c < 32; ++c) {
        float dec[16]; u32x4 kC[4]; f32x4 b0C[4], b1C[4]; bf16x8 vC[4];
        const float blast = blN;
#pragma unroll
        for (int r = 0; r < 16; ++r) dec[r] = decN[r];
#pragma unroll
        for (int ks = 0; ks < 4; ++ks) { kC[ks] = kN[ks]; b0C[ks] = b0N[ks]; b1C[ks] = b1N[ks]; vC[ks] = vN[ks]; }
        SCAN_LOAD(c + 1);
        __builtin_amdgcn_sched_barrier(0);
#pragma unroll
        for (int g = 0; g < 4; ++g)
            *(u32x2*)(ST2 + ((size_t)c * 128 + dvB) * 64 + 32 * dkt + 8 * g + 4 * hh) = pk4(S[4 * g], S[4 * g + 1], S[4 * g + 2], S[4 * g + 3]);
#pragma unroll
        for (int r = 0; r < 16; ++r) S[r] *= __expf(dec[r]);
#pragma unroll
        for (int ks = 0; ks < 4; ++ks) {
            float kv[8]; unpack8(kC[ks], kv);
            bf16x8 ka;
#pragma unroll
            for (int e = 0; e < 4; ++e) { ka[e] = (__bf16)(kv[e] * __expf(blast - b0C[ks][e])); ka[4 + e] = (__bf16)(kv[4 + e] * __expf(blast - b1C[ks][e])); }
            S = mfma32(ka, vC[ks], S);
        }
        __builtin_amdgcn_sched_barrier(0);
    }
#undef SCAN_LOAD
    float* stp = p.out + OUT_STP + (size_t)bh * 64 * 128;
#pragma unroll
    for (int r = 0; r < 16; ++r) {
        const int dkr = 32 * dkt + (r & 3) + 8 * (r >> 2) + 4 * hh;
        stp[(size_t)dkr * 128 + dvB] = S[r];
    }
}

__device__ void p2_glarec(const Params& p, int bs, unsigned char* lds) {
    int tid = threadIdx.x; asm volatile("" : "+v"(tid));
    float* sq = (float*)(lds + LDS_BASE); float* sk = sq + 256; float* se = sk + 256;
    const __bf16* GQ = (const __bf16*)(p.ws + WS_GQ) + (size_t)(NTOK + bs) * 256;
    const __bf16* GK = (const __bf16*)(p.ws + WS_GK) + (size_t)(NTOK + bs) * 256;
    const float* LAB = (const float*)(p.ws + WS_LAB) + (size_t)(NTOK + bs) * 256;
    if (tid < 256) { sq[tid] = (float)GQ[tid]; sk[tid] = (float)GK[tid]; se[tid] = __expf(LAB[tid]); }
    __syncthreads();
    const int h = tid >> 7, dv = tid & 127;
    const float v = (float)((const __bf16*)(p.ws + WS_GV))[(size_t)(NTOK + bs) * 512 + h * 128 + dv];
    const float* s0 = p.state_gla + ((size_t)(bs * 4 + h) * 64) * 128 + dv;
    float* s1 = p.out + OUT_STS + ((size_t)(bs * 4 + h) * 64) * 128 + dv;
    float o = 0.f;
#pragma unroll 8
    for (int dk = 0; dk < 64; ++dk) {
        const float ns = se[h * 64 + dk] * s0[(size_t)dk * 128] + sk[h * 64 + dk] * v;
        s1[(size_t)dk * 128] = ns;
        o = fmaf(sq[h * 64 + dk], ns, o);
    }
    ((float*)(p.ws + WS_GLAOS))[(size_t)(bs * 4 + h) * 128 + dv] = o;
    __syncthreads();
}

__device__ __forceinline__ void p3_outproj(const Params& p, int it, unsigned char* lds);
__device__ void p3_stripe(const Params& p, int it, unsigned char* lds) {
    int tid = threadIdx.x; asm volatile("" : "+v"(tid));
    const int lane = tid & 63, w = tid >> 6, l31 = lane & 31, hh = lane >> 5;
    const bool is_s = it >= 512;
    const int srow0 = is_s ? (it - 512) * 32 : 0;
    const int st = it >> 1, half = it & 1;
    const int tok0 = is_s ? NTOK + srow0 : st * 64 + 32 * half;
    const int b = st >> 5, c = st & 31, s0 = c * 64;
    unsigned char* A = lds + LDS_BASE;
    const __bf16* GM = (const __bf16*)(p.ws + WS_GM);
    const __bf16* GG = (const __bf16*)(p.ws + WS_GG);
    if (!is_s) {
        const __bf16* AO = (const __bf16*)(p.ws + WS_AO);
        const int h = w >> 1, dvh = w & 1, bh = b * 4 + h;
        const int ti = 32 * half + l31;
        const size_t trow = (size_t)(st * 64 + ti);
        const __bf16* GQ = (const __bf16*)(p.ws + WS_GQ);
        const __bf16* GK = (const __bf16*)(p.ws + WS_GK);
        const float* LAB = (const float*)(p.ws + WS_LAB);
        const __bf16* GVT = (const __bf16*)(p.ws + WS_GVT) + (size_t)bh * 128 * 2048;
        const __bf16* ST2 = (const __bf16*)(p.ws + WS_ST2) + ((size_t)bh * 32 + c) * 128 * 64;
        bf16x8 qf[4], kf0[4], vf0[2][2];
        {
            u32x4 av[4], gv[4];
            u32x4 qr[4], kr[4]; f32x4 qb0[4], qb1[4], kb0[4], kb1[4];
            const size_t jrow = (size_t)(st * 64 + l31);
#pragma unroll
            for (int i = 0; i < 4; ++i) {
                const int idx = i * NTHR + tid, row = idx >> 6, ch = idx & 63;
                av[i] = *(const u32x4*)(AO + (size_t)(tok0 + row) * 512 + 8 * ch);
                gv[i] = *(const u32x4*)(GM + (size_t)(tok0 + row) * 512 + 8 * ch);
            }
#pragma unroll
            for (int ks = 0; ks < 4; ++ks) {
                const int dk0 = h * 64 + 16 * ks + 8 * hh;
                qr[ks] = *(const u32x4*)(GQ + trow * 256 + dk0);
                qb0[ks] = *(const f32x4*)(LAB + trow * 256 + dk0); qb1[ks] = *(const f32x4*)(LAB + trow * 256 + dk0 + 4);
                kr[ks] = *(const u32x4*)(GK + jrow * 256 + dk0);
                kb0[ks] = *(const f32x4*)(LAB + jrow * 256 + dk0); kb1[ks] = *(const f32x4*)(LAB + jrow * 256 + dk0 + 4);
            }
#pragma unroll
            for (int sk = 0; sk < 2; ++sk)
#pragma unroll
                for (int t = 0; t < 2; ++t) vf0[sk][t] = *(const bf16x8*)(GVT + ((((size_t)(s0 >> 4) + sk) * 4 + 2 * dvh + t) * 64 + lane) * 8);
            __builtin_amdgcn_sched_barrier(0);
#pragma unroll
            for (int i = 0; i < 4; ++i) {
                const int idx = i * NTHR + tid, row = idx >> 6, ch = idx & 63;
                float af[8], gf[8]; unpack8(av[i], af); unpack8(gv[i], gf);
                u32x4 o; o.x = pk2(af[0] * gf[0], af[1] * gf[1]); o.y = pk2(af[2] * gf[2], af[3] * gf[3]); o.z = pk2(af[4] * gf[4], af[5] * gf[5]); o.w = pk2(af[6] * gf[6], af[7] * gf[7]);
                *(u32x4*)(A + row * XS + ch * 16) = o;
            }
#pragma unroll
            for (int ks = 0; ks < 4; ++ks) {
                float qv[8], kv[8]; unpack8(qr[ks], qv); unpack8(kr[ks], kv);
#pragma unroll
                for (int e = 0; e < 4; ++e) {
                    qf[ks][e] = (__bf16)(qv[e] * __expf(qb0[ks][e])); qf[ks][4 + e] = (__bf16)(qv[4 + e] * __expf(qb1[ks][e]));
                    kf0[ks][e] = (__bf16)(kv[e] * __expf(-kb0[ks][e])); kf0[ks][4 + e] = (__bf16)(kv[4 + e] * __expf(-kb1[ks][e]));
                }
            }
        }
        bf16x8 sf[4][2], vf1[2][2]; u32x4 kr1[4]; f32x4 kb10[4], kb11[4], gn[2][4]; u32x2 gg[2][4];
        {
            const size_t jrow1 = (size_t)(st * 64 + 32 + l31);
#pragma unroll
            for (int ks = 0; ks < 4; ++ks) {
                const int dk0 = h * 64 + 16 * ks + 8 * hh;
#pragma unroll
                for (int t = 0; t < 2; ++t) sf[ks][t] = *(const bf16x8*)(ST2 + (size_t)(32 * (2 * dvh + t) + l31) * 64 + 16 * ks + 8 * hh);
                kr1[ks] = *(const u32x4*)(GK + jrow1 * 256 + dk0);
                kb10[ks] = *(const f32x4*)(LAB + jrow1 * 256 + dk0); kb11[ks] = *(const f32x4*)(LAB + jrow1 * 256 + dk0 + 4);
            }
#pragma unroll
            for (int sk = 0; sk < 2; ++sk)
#pragma unroll
                for (int t = 0; t < 2; ++t) vf1[sk][t] = *(const bf16x8*)(GVT + ((((size_t)(s0 >> 4) + 2 + sk) * 4 + 2 * dvh + t) * 64 + lane) * 8);
#pragma unroll
            for (int t = 0; t < 2; ++t)
#pragma unroll
                for (int g = 0; g < 4; ++g) {
                    const int dv = 32 * (2 * dvh + t) + 8 * g + 4 * hh;
                    gn[t][g] = *(const f32x4*)(p.gla_norm_g + h * 128 + dv);
                    gg[t][g] = *(const u32x2*)(GG + trow * 512 + h * 128 + dv);
                }
        }
        __builtin_amdgcn_sched_barrier(0);
        f32x16 o[2];
#pragma unroll
        for (int t = 0; t < 2; ++t)
#pragma unroll
            for (int r = 0; r < 16; ++r) o[t][r] = 0.f;
        {
            f32x16 att;
#pragma unroll
            for (int r = 0; r < 16; ++r) att[r] = 0.f;
#pragma unroll
            for (int ks = 0; ks < 4; ++ks) att = mfma32(kf0[ks], qf[ks], att);
            if (half == 0) {
#pragma unroll
                for (int r = 0; r < 16; ++r) { const int j = (r & 3) + 8 * (r >> 2) + 4 * hh; if (j > l31) att[r] = 0.f; }
            }
#pragma unroll
            for (int sk = 0; sk < 2; ++sk) {
                bf16x8 pf;
#pragma unroll
                for (int e = 0; e < 8; ++e) pf[e] = (__bf16)att[8 * sk + e];
#pragma unroll
                for (int t = 0; t < 2; ++t) o[t] = mfma32(vf0[sk][t], pf, o[t]);
            }
        }
        __builtin_amdgcn_sched_barrier(0);
        if (half == 1) {
            f32x16 att;
#pragma unroll
            for (int r = 0; r < 16; ++r) att[r] = 0.f;
#pragma unroll
            for (int ks = 0; ks < 4; ++ks) {
                float kv[8]; unpack8(kr1[ks], kv);
                bf16x8 kf;
#pragma unroll
                for (int e = 0; e < 4; ++e) { kf[e] = (__bf16)(kv[e] * __expf(-kb10[ks][e])); kf[4 + e] = (__bf16)(kv[4 + e] * __expf(-kb11[ks][e])); }
                att = mfma32(kf, qf[ks], att);
            }
#pragma unroll
            for (int r = 0; r < 16; ++r) { const int j = (r & 3) + 8 * (r >> 2) + 4 * hh; if (j > l31) att[r] = 0.f; }
#pragma unroll
            for (int sk = 0; sk < 2; ++sk) {
                bf16x8 pf;
#pragma unroll
                for (int e = 0; e < 8; ++e) pf[e] = (__bf16)att[8 * sk + e];
#pragma unroll
                for (int t = 0; t < 2; ++t) o[t] = mfma32(vf1[sk][t], pf, o[t]);
            }
        }
#pragma unroll
        for (int ks = 0; ks < 4; ++ks)
#pragma unroll
            for (int t = 0; t < 2; ++t) o[t] = mfma32(sf[ks][t], qf[ks], o[t]);
        float ss = 0.f;
#pragma unroll
        for (int t = 0; t < 2; ++t)
#pragma unroll
            for (int r = 0; r < 16; ++r) ss = fmaf(o[t][r], o[t][r], ss);
        ss += __shfl_xor(ss, 32);
        float* SSX = (float*)(lds + LDS_BASE + 64 * XS);
        if (hh == 0) SSX[w * 32 + l31] = ss;
        __syncthreads();
        ss += SSX[(w ^ 1) * 32 + l31];
        const float inv = rsqrtf(ss * (1.f / 128.f) + NORM_EPS);
#pragma unroll
        for (int t = 0; t < 2; ++t)
#pragma unroll
            for (int g = 0; g < 4; ++g) {
                const int dv = 32 * (2 * dvh + t) + 8 * g + 4 * hh;
                *(u32x2*)(A + l31 * XS + (512 + h * 128 + dv) * 2) =
                    pk4(o[t][4 * g] * inv * gn[t][g][0] * bflo(gg[t][g].x), o[t][4 * g + 1] * inv * gn[t][g][1] * bfhi(gg[t][g].x),
                        o[t][4 * g + 2] * inv * gn[t][g][2] * bflo(gg[t][g].y), o[t][4 * g + 3] * inv * gn[t][g][3] * bfhi(gg[t][g].y));
            }
    }
    __syncthreads();
    p3_outproj(p, it, lds);
}

__device__ __forceinline__ void p3_outproj(const Params& p, int it, unsigned char* lds) {
    int tid = threadIdx.x; asm volatile("" : "+v"(tid));
    const int lane = tid & 63, w = tid >> 6, l31 = lane & 31, hh = lane >> 5;
    const bool is_s = it >= 512;
    const int srow0 = is_s ? (it - 512) * 32 : 0;
    const int st = it >> 1, half = it & 1, b = st >> 5;
    unsigned char* A = lds + LDS_BASE;
    const u32x4* woutf = (const u32x4*)(p.ws + WS_WOUTF);
    const float* mod = (const float*)(p.ws + WS_MOD);
    float s1 = 0.f, s2 = 0.f;
    const size_t row0 = is_s ? (size_t)srow0 : (size_t)st * 64 + 32 * half;
    const float* xb0 = (is_s ? p.x_sample : p.x_prompt) + (row0 + l31) * 1024 + 64 * w + 4 * hh;
    const float* gb0 = mod + (size_t)(is_s ? (8 + srow0 + l31) : b) * 3072 + 2048 + 64 * w + 4 * hh;
    float* yb0 = p.out + (is_s ? OUT_YS : OUT_YP) + (row0 + l31) * 1024 + 64 * w + 4 * hh;
    f32x16 vacc[2][2];
#pragma unroll
    for (int q = 0; q < 2; ++q) {
        f32x16 acc[2];
#pragma unroll
        for (int nt = 0; nt < 2; ++nt)
#pragma unroll
            for (int r = 0; r < 16; ++r) acc[nt][r] = 0.f;
        f32x4 xv[2][4];
        {
            const unsigned char* x0 = A + l31 * XS + hh * 16;
            const u32x4* w0 = woutf + (size_t)(w + 8 * q) * 2 * 64 * 64 + lane;
            const u32x4* w1 = w0 + 64 * 64;
            u32x4 ra[8], rb[8];
#pragma unroll
            for (int u = 0; u < 8; ++u) { ra[u] = w0[u * 64]; rb[u] = w1[u * 64]; }
#pragma unroll
            for (int g = 0; g < 4; ++g) xv[0][g] = *(const f32x4*)(xb0 + 512 * q + 8 * g);
            const float xtouch = xb0[512 * q + 32];
            bf16x8 b0 = *(const bf16x8*)(x0);
#pragma unroll 1
            for (int k0 = 0; k0 < 64; k0 += 8) {
#pragma unroll
                for (int u = 0; u < 8; ++u) {
                    const int ks = k0 + u;
                    const bf16x8 nb0 = *(const bf16x8*)(x0 + (ks + 1) * 32);
                    const bf16x8 a0 = __builtin_bit_cast(bf16x8, ra[u]), a1 = __builtin_bit_cast(bf16x8, rb[u]);
                    ra[u] = w0[(ks + 8) * 64]; rb[u] = w1[(ks + 8) * 64];
                    __builtin_amdgcn_sched_barrier(0);
                    acc[0] = mfma32(a0, b0, acc[0]); acc[1] = mfma32(a1, b0, acc[1]);
                    __builtin_amdgcn_sched_barrier(0);
                    b0 = nb0;
                }
            }
            asm volatile("" :: "v"(xtouch));
        }
        f32x4 gt[2][4];
#pragma unroll
        for (int nt = 0; nt < 2; ++nt)
#pragma unroll
            for (int g = 0; g < 4; ++g) gt[nt][g] = *(const f32x4*)(gb0 + 512 * q + 32 * nt + 8 * g);
#pragma unroll
        for (int g = 0; g < 4; ++g) xv[1][g] = *(const f32x4*)(xb0 + 512 * q + 32 + 8 * g);
        __builtin_amdgcn_sched_barrier(0);
#pragma unroll
        for (int nt = 0; nt < 2; ++nt)
#pragma unroll
            for (int g = 0; g < 4; ++g)
#pragma unroll
                for (int i = 0; i < 4; ++i) {
                    const float v = DN_ALPHA * xv[nt][g][i] + gt[nt][g][i] * acc[nt][4 * g + i];
                    vacc[q][nt][4 * g + i] = v;
                    s1 += v; s2 = fmaf(v, v, s2);
                }
        __builtin_amdgcn_sched_barrier(0);
    }
    float* LNP = (float*)(lds + LDS_BASE + 64 * XS);
    s1 += __shfl_xor(s1, 32); s2 += __shfl_xor(s2, 32);
    __syncthreads();
    if (hh == 0) { LNP[(w * 32 + l31) * 2] = s1; LNP[(w * 32 + l31) * 2 + 1] = s2; }
    __syncthreads();
    float mean, rstd;
    {
        float a = 0.f, bq = 0.f;
#pragma unroll
        for (int ww = 0; ww < 8; ++ww) { a += LNP[(ww * 32 + l31) * 2]; bq += LNP[(ww * 32 + l31) * 2 + 1]; }
        mean = a * (1.f / 1024.f);
        const float var = fmaxf(bq * (1.f / 1024.f) - mean * mean, 0.f);
        rstd = rsqrtf(var + NORM_EPS);
    }
    const float* lgb = p.ln_g + 64 * w + 4 * hh;
    const float* lbb = p.ln_b + 64 * w + 4 * hh;
#pragma unroll
    for (int q = 0; q < 2; ++q) {
        f32x4 lg[2][4], lb[2][4];
#pragma unroll
        for (int nt = 0; nt < 2; ++nt)
#pragma unroll
            for (int g = 0; g < 4; ++g) {
                const int off = 512 * q + 32 * nt + 8 * g;
                lg[nt][g] = *(const f32x4*)(lgb + off); lb[nt][g] = *(const f32x4*)(lbb + off);
            }
        __builtin_amdgcn_sched_barrier(0);
#pragma unroll
        for (int nt = 0; nt < 2; ++nt)
#pragma unroll
            for (int g = 0; g < 4; ++g) {
                const int off = 512 * q + 32 * nt + 8 * g;
                f32x4 y;
#pragma unroll
                for (int i = 0; i < 4; ++i) y[i] = (vacc[q][nt][4 * g + i] - mean) * rstd * lg[nt][g][i] + lb[nt][g][i];
                *(f32x4*)(yb0 + off) = y;
            }
        __builtin_amdgcn_sched_barrier(0);
    }
    __syncthreads();
}


__device__ void p3s_arows(const Params& p, int k, unsigned char* lds) {
    int tid = threadIdx.x; asm volatile("" : "+v"(tid));
    const int lane = tid & 63, w = tid >> 6, l31 = lane & 31, hh = lane >> 5;
    const int r0 = 8 * k, h = w;
    const __bf16* QLR = (const __bf16*)(p.ws + WS_QLR);
    const float* DP = (const float*)(p.ws + WS_DPART);
    const float* lat_s = p.out + OUT_LATS;
    const float* kr_s = p.out + OUT_KRS;
    const __bf16* GM = (const __bf16*)(p.ws + WS_GM);
    const __bf16* GG = (const __bf16*)(p.ws + WS_GG);
    __bf16* AS = (__bf16*)(p.ws + WS_AS);
    unsigned char* OL = lds + LDS_BASE + w * 2304;
#pragma unroll 1
    for (int q0 = 0; q0 < 8; q0 += 4) {
        float qa[4], qb[4], qc[4], la[4], lb2[4], kc[4], mi[4][4], li[4][4];
        f32x2 ln[4], ov[4][4];
#pragma unroll
        for (int u = 0; u < 4; ++u) {
            const int bs = r0 + q0 + u;
            const __bf16* ql = QLR + ((size_t)bs * 8 + h) * 160;
            qa[u] = (float)ql[lane]; qb[u] = (float)ql[64 + lane]; qc[u] = (float)ql[128 + (lane & 31)];
            la[u] = lat_s[(size_t)bs * 128 + lane]; lb2[u] = lat_s[(size_t)bs * 128 + 64 + lane]; kc[u] = kr_s[(size_t)bs * 32 + (lane & 31)];
            ln[u] = *(const f32x2*)(lat_s + (size_t)bs * 128 + 2 * lane);
#pragma unroll
            for (int sp = 0; sp < 4; ++sp) {
                const float* d = DP + ((size_t)(bs * 4 + sp) * 8 + h) * 132;
                mi[u][sp] = d[0]; li[u][sp] = d[1]; ov[u][sp] = *(const f32x2*)(d + 4 + 2 * lane);
            }
        }
        __builtin_amdgcn_sched_barrier(0);
#pragma unroll
        for (int u = 0; u < 4; ++u) {
            float part = qa[u] * la[u] + qb[u] * lb2[u];
            if (lane < 32) part += qc[u] * kc[u];
            const float sn = wave_sum(part);
            float M = sn;
#pragma unroll
            for (int sp = 0; sp < 4; ++sp) M = fmaxf(M, mi[u][sp]);
            const float wn = ex2(sn - M);
            float L = wn, o0 = wn * ln[u][0], o1 = wn * ln[u][1];
#pragma unroll
            for (int sp = 0; sp < 4; ++sp) {
                const float wt = ex2(mi[u][sp] - M);
                L = fmaf(wt, li[u][sp], L); o0 = fmaf(wt, ov[u][sp][0], o0); o1 = fmaf(wt, ov[u][sp][1], o1);
            }
            const float inv = __builtin_amdgcn_rcpf(L);
            *(unsigned*)(OL + (q0 + u) * 288 + 4 * lane) = pk2(o0 * inv, o1 * inv);
        }
    }
    asm volatile("s_waitcnt lgkmcnt(0)" ::: "memory");
    {
        const __bf16* wuvt = (const __bf16*)(p.ws + WS_WUVT);
        f32x16 mo[2];
#pragma unroll
        for (int vt = 0; vt < 2; ++vt)
#pragma unroll
            for (int r = 0; r < 16; ++r) mo[vt][r] = 0.f;
        bf16x8 ob[8], wa[2][8];
        const int tk = (l31 < 8) ? l31 : 7;
#pragma unroll
        for (int ks = 0; ks < 8; ++ks) {
            ob[ks] = *(const bf16x8*)(OL + tk * 288 + (16 * ks + 8 * hh) * 2);
            wa[0][ks] = *(const bf16x8*)(wuvt + ((size_t)h * 64 + l31) * 128 + 16 * ks + 8 * hh);
            wa[1][ks] = *(const bf16x8*)(wuvt + ((size_t)h * 64 + 32 + l31) * 128 + 16 * ks + 8 * hh);
        }
        __builtin_amdgcn_sched_barrier(0);
#pragma unroll
        for (int ks = 0; ks < 8; ++ks)
#pragma unroll
            for (int vt = 0; vt < 2; ++vt) mo[vt] = mfma32(wa[vt][ks], ob[ks], mo[vt]);
        if (l31 < 8) {
#pragma unroll
            for (int vt = 0; vt < 2; ++vt)
#pragma unroll
                for (int g = 0; g < 4; ++g) {
                    const int v = 32 * vt + 8 * g + 4 * hh;
                    const u32x2 gm = *(const u32x2*)(GM + (size_t)(NTOK + r0 + l31) * 512 + h * 64 + v);
                    *(u32x2*)(AS + (size_t)(r0 + l31) * 1024 + h * 64 + v) =
                        pk4(mo[vt][4 * g] * bflo(gm.x), mo[vt][4 * g + 1] * bfhi(gm.x), mo[vt][4 * g + 2] * bflo(gm.y), mo[vt][4 * g + 3] * bfhi(gm.y));
                }
        }
    }
    {
        const float* GLAOS = (const float*)(p.ws + WS_GLAOS);
        f32x2 ov[4], gn[4]; unsigned gg[4];
#pragma unroll
        for (int u = 0; u < 4; ++u) {
            const int pr = w * 4 + u, t = pr >> 2, hg = pr & 3, bs = r0 + t;
            ov[u] = *(const f32x2*)(GLAOS + ((size_t)bs * 4 + hg) * 128 + 2 * lane);
            gn[u] = *(const f32x2*)(p.gla_norm_g + hg * 128 + 2 * lane);
            gg[u] = *(const unsigned*)(GG + (size_t)(NTOK + bs) * 512 + hg * 128 + 2 * lane);
        }
        __builtin_amdgcn_sched_barrier(0);
#pragma unroll
        for (int u = 0; u < 4; ++u) {
            const int pr = w * 4 + u, t = pr >> 2, hg = pr & 3, bs = r0 + t;
            const float ss = wave_sum(ov[u][0] * ov[u][0] + ov[u][1] * ov[u][1]);
            const float inv = rsqrtf(ss * (1.f / 128.f) + NORM_EPS);
            *(unsigned*)(AS + (size_t)bs * 1024 + 512 + hg * 128 + 2 * lane) = pk2(ov[u][0] * inv * gn[u][0] * bflo(gg[u]), ov[u][1] * inv * gn[u][1] * bfhi(gg[u]));
        }
    }
    __syncthreads();
}
__device__ void p3s_cols(const Params& p, int k, unsigned char* lds) {
    int tid = threadIdx.x; asm volatile("" : "+v"(tid));
    const int lane = tid & 63, w = tid >> 6, l31 = lane & 31, hh = lane >> 5;
    const int nt = w >> 1, mt = w & 1;
    unsigned char* A = lds + LDS_BASE;
    const __bf16* AS = (const __bf16*)(p.ws + WS_AS);
    const u32x4* woutf = (const u32x4*)(p.ws + WS_WOUTF);
    const float* mod = (const float*)(p.ws + WS_MOD);
    float* ST = (float*)(lds + LDS_BASE + 64 * XS);
    float* STATS = (float*)(p.ws + WS_STATS);
#pragma unroll 1
    for (int pass = 0; pass < 2; ++pass) {
        {
            u32x4 t[16];
#pragma unroll
            for (int i = 0; i < 16; ++i) { const int idx = i * NTHR + tid, row = idx >> 7, ch = idx & 127; t[i] = *(const u32x4*)(AS + (size_t)(64 * pass + row) * 1024 + 8 * ch); }
            __builtin_amdgcn_sched_barrier(0);
#pragma unroll
            for (int i = 0; i < 16; ++i) { const int idx = i * NTHR + tid, row = idx >> 7, ch = idx & 127; *(u32x4*)(A + row * XS + ch * 16) = t[i]; }
        }
        __syncthreads();
        f32x16 acc;
#pragma unroll
        for (int r = 0; r < 16; ++r) acc[r] = 0.f;
        const int row = 64 * pass + 32 * mt + l31;
        const int ncol = 128 * k + 32 * nt + 4 * hh;
        f32x4 xv[4], gt[4];
#pragma unroll
        for (int g = 0; g < 4; ++g) { xv[g] = *(const f32x4*)(p.x_sample + (size_t)row * 1024 + ncol + 8 * g); gt[g] = *(const f32x4*)(mod + (size_t)(8 + row) * 3072 + 2048 + ncol + 8 * g); }
        {
            const unsigned char* x0 = A + (32 * mt + l31) * XS + hh * 16;
            const u32x4* w0 = woutf + (size_t)(4 * k + nt) * 64 * 64 + lane;
            u32x4 ra[8];
#pragma unroll
            for (int u = 0; u < 8; ++u) ra[u] = w0[u * 64];
#pragma unroll 1
            for (int k0 = 0; k0 < 64; k0 += 8) {
#pragma unroll
                for (int u = 0; u < 8; ++u) {
                    const int ks = k0 + u;
                    const bf16x8 b0 = *(const bf16x8*)(x0 + ks * 32);
                    const bf16x8 a0 = __builtin_bit_cast(bf16x8, ra[u]);
                    ra[u] = w0[(ks + 8) * 64];
                    __builtin_amdgcn_sched_barrier(0);
                    acc = mfma32(a0, b0, acc);
                    __builtin_amdgcn_sched_barrier(0);
                }
            }
        }
        float s1 = 0.f, s2 = 0.f;
        float* yb = p.out + OUT_YS + (size_t)row * 1024 + ncol;
#pragma unroll
        for (int g = 0; g < 4; ++g) {
            f32x4 v;
#pragma unroll
            for (int i = 0; i < 4; ++i) { v[i] = DN_ALPHA * xv[g][i] + gt[g][i] * acc[4 * g + i]; s1 += v[i]; s2 = fmaf(v[i], v[i], s2); }
            *(f32x4*)(yb + 8 * g) = v;
        }
        s1 += __shfl_xor(s1, 32); s2 += __shfl_xor(s2, 32);
        if (hh == 0) { ST[(w * 32 + l31) * 2] = s1; ST[(w * 32 + l31) * 2 + 1] = s2; }
        __syncthreads();
        if (tid < 64) {
            const int m2 = tid >> 5, tk = tid & 31;
            float a = 0.f, bq = 0.f;
#pragma unroll
            for (int n2 = 0; n2 < 4; ++n2) { a += ST[((2 * n2 + m2) * 32 + tk) * 2]; bq += ST[((2 * n2 + m2) * 32 + tk) * 2 + 1]; }
            STATS[((size_t)k * NDEC + 64 * pass + tid) * 2] = a; STATS[((size_t)k * NDEC + 64 * pass + tid) * 2 + 1] = bq;
        }
        __syncthreads();
    }
}
__device__ void p3s_ln(const Params& p, int k, unsigned char* lds) {
    int tid = threadIdx.x; asm volatile("" : "+v"(tid));
    const int row = 32 * k + (tid >> 4), c0 = (tid & 15) * 64;
    const float* STATS = (const float*)(p.ws + WS_STATS);
    float a = 0.f, bq = 0.f;
#pragma unroll
    for (int j = 0; j < 8; ++j) { a += STATS[((size_t)j * NDEC + row) * 2]; bq += STATS[((size_t)j * NDEC + row) * 2 + 1]; }
    const float mean = a * (1.f / 1024.f);
    const float rstd = rsqrtf(fmaxf(bq * (1.f / 1024.f) - mean * mean, 0.f) + NORM_EPS);
    float* y = p.out + OUT_YS + (size_t)row * 1024 + c0;
    f32x4 v[16];
#pragma unroll
    for (int i = 0; i < 16; ++i) v[i] = *(const f32x4*)(y + 4 * i);
    __builtin_amdgcn_sched_barrier(0);
#pragma unroll
    for (int i = 0; i < 16; ++i) {
        const f32x4 lg = *(const f32x4*)(p.ln_g + c0 + 4 * i), lb = *(const f32x4*)(p.ln_b + c0 + 4 * i);
        f32x4 o;
#pragma unroll
        for (int e = 0; e < 4; ++e) o[e] = (v[i][e] - mean) * rstd * lg[e] + lb[e];
        *(f32x4*)(y + 4 * i) = o;
    }
}

__device__ __forceinline__ int q_next(unsigned* cnt, unsigned char* lds) {
    volatile LAS unsigned* slot = (volatile LAS unsigned*)(lds + 16);
    __syncthreads();
    if (threadIdx.x == 0) *slot = __hip_atomic_fetch_add(cnt, 1u, __ATOMIC_RELAXED, __HIP_MEMORY_SCOPE_AGENT);
    __syncthreads();
    return (int)*slot;
}
__device__ __forceinline__ void signal_done(unsigned* cnt) {
    asm volatile("s_waitcnt vmcnt(0)" ::: "memory");
    __syncthreads();
    if (threadIdx.x == 0) {
        __builtin_amdgcn_fence(__ATOMIC_RELEASE, "agent");
        asm volatile("s_waitcnt vmcnt(0)" ::: "memory");
        (void)__hip_atomic_fetch_add(cnt, 1u, __ATOMIC_RELAXED, __HIP_MEMORY_SCOPE_AGENT);
    }
}
__device__ __forceinline__ void wait_count(unsigned* bar, unsigned* cnt, unsigned want) {
    if (threadIdx.x == 0) {
        XB_SPIN(xb_ld(cnt) < want, bar);
        __builtin_amdgcn_fence(__ATOMIC_ACQUIRE, "agent");
        asm volatile("s_waitcnt vmcnt(0)" ::: "memory");
    }
    __syncthreads();
}

__global__ void __launch_bounds__(NTHR) fwd_mega(Params p, int ph_lo, int ph_hi, int use_bar) {
    extern __shared__ __attribute__((aligned(16))) unsigned char lds[];
    const int tid = threadIdx.x;
    if (use_bar) {
        if (tid == 0) { *(u32x4*)lds = (u32x4){0u, 0u, 0u, 0u}; }
        __syncthreads();
        (void)xcd_barrier_post((unsigned*)(p.ws + WS_CTL), (volatile LAS unsigned*)lds);
    }
    const int G = gridDim.x, bid = blockIdx.x;
    unsigned* ctl = (unsigned*)(p.ws + WS_CTL);
    for (int ph = ph_lo; ph < ph_hi; ++ph) {
        for (int rep = 0; rep < ((ph == REP_PH) ? 2 : 1); ++rep) {
        if (ph == 0) {
            for (int item = bid; item < 96; item += G) p0_mod_item(p, item, lds);
            p0_convert(p);
        } else if (ph == 1 || ph == 2) {
            bool sample_ok = false;
            int local = 0;
            for (;;) {
                int kind, a0, a1;
                if (ph == 1) { a0 = bid + local * G; ++local; if (a0 >= 256) break; kind = 0; a1 = 0; }
                else {
                    const int i = q_next(ctl + CW_Q2 + 16 * rep, lds);
                    if (i >= 1194) break;
                    if (i < 2) { kind = 0; a0 = 256 + i; a1 = 1; }
                    else if (i < 10) { kind = 0; a0 = 256 + ((i - 2) >> 2); a1 = 2 + ((i - 2) & 3); }
                    else if (i < 42) { kind = 1; a0 = i - 10; a1 = 0; }
                    else if (i < 234) { kind = 2; a0 = (i - 42) & 63; a1 = 7 - ((i - 42) >> 6); }
                    else if (i < 362) { kind = 3; a0 = i - 234; a1 = 0; }
                    else { const int g = (i - 362) / 13, r = (i - 362) - 13 * g;
                        const int na = (r > 2) + (r > 4) + (r > 7) + (r > 9);
                        if (r == 2 || r == 4 || r == 7 || r == 9 || r == 12) { const int ai = 5 * g + na; kind = 2; a0 = ai & 63; a1 = 4 - (ai >> 6); }
                        else { const int d = 8 * g + (r - na); kind = 4; a0 = d >> 2; a1 = d & 3; } }
                }
                if (kind >= 3 && !sample_ok) { wait_count(ctl, ctl + CW_SAMPLE, 10u * (rep + 1)); sample_ok = true; }
                if (kind == 0) { p1_stripe(p, a0, a1, lds); if (ph == 2) signal_done(ctl + CW_SAMPLE); }
                else if (kind == 1) p2_scan(p, a0);
                else if (kind == 2) p2_attn(p, a0, a1, lds);
                else if (kind == 3) p2_glarec(p, a0, lds);
                else p2_decode(p, a0, a1, lds);
            }
        } else {
            for (;;) {
                const int qi = q_next(ctl + CW_Q3 + 16 * rep, lds);
                if (qi >= 540) break;
                if (qi < 16) { p3s_arows(p, qi, lds); signal_done(ctl + CW_AS); }
                else if (qi < 272) p3_stripe(p, qi - 16, lds);
                else if (qi < 280) { wait_count(ctl, ctl + CW_AS, 16u * (rep + 1)); p3s_cols(p, qi - 272, lds); signal_done(ctl + CW_COL); }
                else if (qi < 536) p3_stripe(p, qi - 280 + 256, lds);
                else { wait_count(ctl, ctl + CW_COL, 8u * (rep + 1)); p3s_ln(p, qi - 536, lds); }
            }
        }
        }
        if (use_bar && ph + 1 < ph_hi) {
            XcdBarrier xb; xb.bar = (unsigned*)(p.ws + WS_CTL); xb.x = xb_xcc_id(); xb.st = (volatile LAS unsigned*)lds;
            xcd_barrier(xb);
        }
    }
}


extern "C" void kernel_launch(void* const* d_in, const int* in_sizes, int n_in, void* d_out, int out_size, void* d_ws, size_t ws_size, hipStream_t stream) {
    static int grid = 0;
    if (grid == 0) {
        if (n_in != 22 || (size_t)out_size != OUT_END || ws_size < WS_END) { fprintf(stderr, "kernel_launch: unexpected shapes (n_in %d out %d ws %zu)\n", n_in, out_size, ws_size); grid = -1; return; }
        int dev = 0, cus = 0, per_cu = 0;
        if (hipGetDevice(&dev) != hipSuccess || hipDeviceGetAttribute(&cus, hipDeviceAttributeMultiprocessorCount, dev) != hipSuccess) { grid = -1; return; }
        if (hipFuncSetAttribute((const void*)fwd_mega, hipFuncAttributeMaxDynamicSharedMemorySize, LDS_BYTES) != hipSuccess) { fprintf(stderr, "kernel_launch: hipFuncSetAttribute failed\n"); grid = -1; return; }
        if (hipOccupancyMaxActiveBlocksPerMultiprocessor(&per_cu, (const void*)fwd_mega, NTHR, LDS_BYTES) != hipSuccess || per_cu < 1) { fprintf(stderr, "kernel_launch: occupancy query says %d\n", per_cu); grid = -1; return; }
        (void)hipGetLastError();
        grid = cus;
    }
    if (grid < 0) return;
    Params p{};
    p.x_prompt = (const float*)d_in[0]; p.x_sample = (const float*)d_in[1]; p.cache_lat = (const float*)d_in[2]; p.cache_kr = (const float*)d_in[3];
    p.state_gla = (const float*)d_in[4]; p.page_table = (const int*)d_in[5]; p.c_prompt = (const float*)d_in[6]; p.c_sample = (const float*)d_in[7];
    p.w_ada = (const float*)d_in[8]; p.b_ada = (const float*)d_in[9]; p.w_in = (const float*)d_in[10]; p.q_norm_g = (const float*)d_in[11];
    p.w_uq = (const float*)d_in[12]; p.kv_norm_g = (const float*)d_in[13]; p.w_uk = (const float*)d_in[14]; p.w_uv = (const float*)d_in[15];
    p.w_gate_up = (const float*)d_in[16]; p.b_gate = (const float*)d_in[17]; p.gla_norm_g = (const float*)d_in[18]; p.w_out = (const float*)d_in[19];
    p.ln_g = (const float*)d_in[20]; p.ln_b = (const float*)d_in[21];
    p.out = (float*)d_out; p.ws = (unsigned char*)d_ws;
    if (hipMemsetAsync((char*)d_ws + WS_CTL, 0, CTL_BYTES, stream) != hipSuccess) { fprintf(stderr, "kernel_launch: memset failed\n"); return; }
#if N_LAUNCHES == 1
    hipLaunchKernelGGL(fwd_mega, dim3(grid), dim3(NTHR), LDS_BYTES, stream, p, 0, 4, 1);
#else
    for (int ph = 0; ph < 4; ++ph) hipLaunchKernelGGL(fwd_mega, dim3(grid), dim3(NTHR), LDS_BYTES, stream, p, ph, ph + 1, 0);
#endif
    const hipError_t le = hipPeekAtLastError();
    if (le != hipSuccess) fprintf(stderr, "kernel_launch: launch failed: %s\n", hipGetErrorName(le));
}
```

```cpp
#include <hip/hip_runtime.h>
#include <cstdint>
#include <cstdio>

typedef __bf16 bf16x8 __attribute__((ext_vector_type(8)));
typedef __bf16 bf16x4 __attribute__((ext_vector_type(4)));
typedef __bf16 bf16x2 __attribute__((ext_vector_type(2)));
typedef float f32x16 __attribute__((ext_vector_type(16)));
typedef float f32x4 __attribute__((ext_vector_type(4)));
typedef float f32x2 __attribute__((ext_vector_type(2)));
typedef unsigned u32x4 __attribute__((ext_vector_type(4)));
typedef unsigned u32x2 __attribute__((ext_vector_type(2)));

#define NTHR 512
#define N_LAUNCHES 1
#define REP_PH (-1)
#define LDS_BYTES 143360
#define LDS_BASE 256

constexpr int DM = 1024, SEQ = 2048, NB = 8, NTOK = 16384, NDEC = 128, RT = NTOK + NDEC;
constexpr int NPAGES = 64;
constexpr float NORM_EPS = 1e-6f;
constexpr float LOG2E = 1.4426950408889634f;
constexpr float QSCALE = 0.10206207261596577f * 1.4426950408889634f;
constexpr float DN_ALPHA = 1.189207115002721f;

constexpr size_t OUT_YP = 0;
constexpr size_t OUT_YS = OUT_YP + (size_t)NTOK * 1024;
constexpr size_t OUT_LATP = OUT_YS + (size_t)NDEC * 1024;
constexpr size_t OUT_KRP = OUT_LATP + (size_t)NTOK * 128;
constexpr size_t OUT_STP = OUT_KRP + (size_t)NTOK * 32;
constexpr size_t OUT_LATS = OUT_STP + (size_t)NB * 4 * 64 * 128;
constexpr size_t OUT_KRS = OUT_LATS + (size_t)NDEC * 128;
constexpr size_t OUT_STS = OUT_KRS + (size_t)NDEC * 32;
constexpr size_t OUT_END = OUT_STS + (size_t)NDEC * 4 * 64 * 128;

constexpr size_t al256(size_t x) { return (x + 255) & ~(size_t)255; }
constexpr size_t WS_CTL = 0;
constexpr size_t CTL_BYTES = 16384;
constexpr size_t WS_MOD = WS_CTL + CTL_BYTES;
constexpr size_t WS_ROPE = WS_MOD + al256((size_t)136 * 3072 * 4);
constexpr size_t WS_WINF = WS_ROPE + al256((size_t)2049 * 32 * 4);
constexpr size_t WS_WUQF = WS_WINF + (size_t)78 * 64 * 1024;
constexpr size_t WS_WKVF = WS_WUQF + (size_t)24 * 16 * 1024;
constexpr size_t WS_WOUTF = WS_WKVF + (size_t)32 * 8 * 1024;
constexpr size_t WS_WUKB = WS_WOUTF + (size_t)32 * 64 * 1024;
constexpr size_t WS_WUVT = WS_WUKB + (size_t)65536 * 2;
constexpr size_t WS_GM = WS_WUVT + (size_t)65536 * 2;
constexpr size_t WS_GQ = WS_GM + al256((size_t)RT * 512 * 2);
constexpr size_t WS_GK = WS_GQ + al256((size_t)RT * 256 * 2);
constexpr size_t WS_GV = WS_GK + al256((size_t)RT * 256 * 2);
constexpr size_t WS_GG = WS_GV + al256((size_t)RT * 512 * 2);
constexpr size_t WS_LAB = WS_GG + al256((size_t)RT * 512 * 2);
constexpr size_t WS_BT = WS_LAB + al256((size_t)RT * 256 * 4);
constexpr size_t WS_GKT = WS_BT + (size_t)NB * 4 * 64 * 2048 * 4;
constexpr size_t WS_GVT = WS_GKT + (size_t)NB * 4 * 64 * 2048 * 2;
constexpr size_t WS_Q = WS_GVT + (size_t)NB * 4 * 128 * 2048 * 2;
constexpr size_t WS_KN = WS_Q + (size_t)NB * 8 * 2048 * 96 * 2;
constexpr size_t WS_KR = WS_KN + (size_t)NB * 8 * 2048 * 64 * 2;
constexpr size_t WS_VT = WS_KR + (size_t)NB * 2048 * 32 * 2;
constexpr size_t WS_AO = WS_VT + (size_t)NB * 8 * 64 * 2048 * 2;
constexpr size_t WS_ST2 = WS_AO + (size_t)NTOK * 512 * 2;
constexpr size_t WS_BL = WS_ST2 + (size_t)NB * 4 * 32 * 128 * 64 * 2;
constexpr size_t WS_QLR = WS_BL + (size_t)NB * 4 * 32 * 64 * 4;
constexpr size_t WS_DPART = WS_QLR + al256((size_t)NDEC * 8 * 160 * 2);
constexpr size_t WS_GLAOS = WS_DPART + al256((size_t)NDEC * 4 * 8 * 132 * 4);
constexpr size_t WS_OLAT = WS_GLAOS + al256((size_t)NDEC * 4 * 128 * 4);
constexpr size_t WS_AS = WS_OLAT + al256((size_t)NDEC * 8 * 128 * 2);
constexpr size_t WS_STATS = WS_AS + (size_t)NDEC * 1024 * 2;
constexpr size_t WS_END = WS_STATS + (size_t)8 * NDEC * 2 * 4;

struct Params {
    const float* x_prompt; const float* x_sample; const float* cache_lat; const float* cache_kr; const float* state_gla;
    const int* page_table; const float* c_prompt; const float* c_sample;
    const float* w_ada; const float* b_ada; const float* w_in; const float* q_norm_g; const float* w_uq; const float* kv_norm_g;
    const float* w_uk; const float* w_uv; const float* w_gate_up; const float* b_gate; const float* gla_norm_g;
    const float* w_out; const float* ln_g; const float* ln_b;
    float* out; unsigned char* ws;
};

__device__ __forceinline__ f32x16 mfma32(bf16x8 a, bf16x8 b, f32x16 c) { return __builtin_amdgcn_mfma_f32_32x32x16_bf16(a, b, c, 0, 0, 0); }
__device__ __forceinline__ unsigned pk2(float lo, float hi) { bf16x2 v = {(__bf16)lo, (__bf16)hi}; return __builtin_bit_cast(unsigned, v); }
__device__ __forceinline__ u32x2 pk4(float a, float b, float c, float d) { u32x2 r; r.x = pk2(a, b); r.y = pk2(c, d); return r; }
__device__ __forceinline__ float bflo(unsigned u) { return __builtin_bit_cast(float, u << 16); }
__device__ __forceinline__ float bfhi(unsigned u) { return __builtin_bit_cast(float, u & 0xffff0000u); }
__device__ __forceinline__ float siluf(float x) { return x * __builtin_amdgcn_rcpf(1.f + __expf(-x)); }
__device__ __forceinline__ float ex2(float x) { return __builtin_amdgcn_exp2f(x); }
__device__ __forceinline__ float wave_sum(float v) {
#pragma unroll
    for (int o = 1; o < 64; o <<= 1) v += __shfl_xor(v, o);
    return v;
}
__device__ __forceinline__ bf16x8 cvt8(f32x4 a, f32x4 b) {
    bf16x8 r; r[0] = (__bf16)a[0]; r[1] = (__bf16)a[1]; r[2] = (__bf16)a[2]; r[3] = (__bf16)a[3]; r[4] = (__bf16)b[0]; r[5] = (__bf16)b[1]; r[6] = (__bf16)b[2]; r[7] = (__bf16)b[3]; return r;
}
__device__ __forceinline__ void unpack8(u32x4 u, float (&f)[8]) {
    f[0] = bflo(u.x); f[1] = bfhi(u.x); f[2] = bflo(u.y); f[3] = bfhi(u.y); f[4] = bflo(u.z); f[5] = bfhi(u.z); f[6] = bflo(u.w); f[7] = bfhi(u.w);
}
__device__ __forceinline__ int permpos(int s) { return (s & ~12) | ((s & 4) << 1) | ((s & 8) >> 1); }

#define XB_TMO      128
#define XB_XCNT(j)  (256  + 64 * (j))
#define XB_XSUB(j)  (1280 + 64 * (j))
#define XB_XGEN(j)  (2304 + 64 * (j))
#define XB_TOP      3328
#define XB_TOPGEN   3392
#define XCD_BAR_WORDS 3456
#define CW_Q2 3520
#define CW_Q3 3584
#define CW_SAMPLE 3648
#define CW_AS 3712
#define CW_COL 3776
#define XB_SPIN_CAP (1u << 22)
#define LAS __attribute__((address_space(3)))
__device__ __forceinline__ unsigned xb_ld(unsigned* p)              { return __hip_atomic_load(p, __ATOMIC_RELAXED, __HIP_MEMORY_SCOPE_AGENT); }
__device__ __forceinline__ unsigned xb_add(unsigned* p, unsigned v) { return __hip_atomic_fetch_add(p, v, __ATOMIC_RELAXED, __HIP_MEMORY_SCOPE_AGENT); }
__device__ __forceinline__ unsigned xb_xcc_id() { return (unsigned)__builtin_amdgcn_s_getreg((3 << 11) | 20) & 0xFu; }
#define XB_SPIN(cond, bar) do { unsigned _sp = 0; while (cond) { __builtin_amdgcn_s_sleep(1); \
    if ((++_sp & 255u) == 0u) { if (xb_ld(&(bar)[XB_TMO])) break; if (_sp > XB_SPIN_CAP) { atomicAdd(&(bar)[XB_TMO], 1u); break; } } } } while (0)
struct XcdBarrier { unsigned* bar; unsigned x; volatile LAS unsigned* st; };
__device__ __forceinline__ XcdBarrier xcd_barrier_post(unsigned* bar, volatile LAS unsigned* st) {
    XcdBarrier b; b.bar = bar; b.x = xb_xcc_id(); b.st = st;
    if (threadIdx.x == 0) (void)xb_add(&bar[XB_XCNT(b.x)], 1u);
    return b;
}
__device__ __forceinline__ void xcd_barrier_complete(unsigned* bar, unsigned x, unsigned& nloc, unsigned& nx) {
    const unsigned G = gridDim.x * gridDim.y * gridDim.z;
    unsigned sum, cnt, mine, sp = 0u;
    for (;;) {
        sum = 0u; cnt = 0u; mine = 0u;
#pragma unroll
        for (unsigned j = 0; j < 16; ++j) { const unsigned c = xb_ld(&bar[XB_XCNT(j)]); sum += c; cnt += (c > 0u) ? 1u : 0u; mine = (j == x) ? c : mine; }
        if (sum == G) break;
        __builtin_amdgcn_s_sleep(1);
        if ((++sp & 255u) == 0u) { if (xb_ld(&bar[XB_TMO])) break; if (sp > XB_SPIN_CAP) { atomicAdd(&bar[XB_TMO], 1u); break; } }
    }
    nloc = mine > 0u ? mine : 1u; nx = cnt > 0u ? cnt : 1u;
}
__device__ __forceinline__ void xcd_barrier(const XcdBarrier& b) {
    asm volatile("s_waitcnt vmcnt(0)" ::: "memory");
    __syncthreads();
    if (threadIdx.x == 0) {
        unsigned* bar = b.bar;
        __builtin_amdgcn_s_waitcnt(0);
        unsigned nloc = b.st[0], nx = b.st[1];
        if (nloc == 0u) { xcd_barrier_complete(bar, b.x, nloc, nx); b.st[0] = nloc; b.st[1] = nx; }
        const unsigned old = xb_add(&bar[XB_XSUB(b.x)], 1u);
        const unsigned gen = old / nloc;
        if (old + 1u == (gen + 1u) * nloc) {
            __builtin_amdgcn_fence(__ATOMIC_RELEASE, "agent");
            asm volatile("s_waitcnt vmcnt(0)" ::: "memory");
            const unsigned og = xb_add(&bar[XB_TOP], 1u);
            const unsigned tg = og / nx;
            if (og + 1u == (tg + 1u) * nx) xb_add(&bar[XB_TOPGEN], 1u);
            else XB_SPIN(xb_ld(&bar[XB_TOPGEN]) == tg, bar);
            __builtin_amdgcn_fence(__ATOMIC_ACQUIRE, "agent");
            xb_add(&bar[XB_XGEN(b.x)], 1u);
            asm volatile("s_waitcnt vmcnt(0)" ::: "memory");
        } else {
            XB_SPIN(xb_ld(&bar[XB_XGEN(b.x)]) == gen, bar);
            __builtin_amdgcn_fence(__ATOMIC_ACQUIRE, "agent");
            asm volatile("s_waitcnt vmcnt(0)" ::: "memory");
        }
    }
    __syncthreads();
}

template <int KS, bool SW>
__device__ __forceinline__ void gemm_2x2(const u32x4* __restrict__ wf, const unsigned char* xl, int xstride, int lane, f32x16 (&acc)[2][2]) {
    constexpr int PF = 8;
    static_assert(KS % PF == 0, "KS must be a multiple of the prefetch depth");
    const int l31 = lane & 31, hh = lane >> 5;
    const unsigned char* x0 = xl + l31 * xstride + hh * 16;
    const unsigned char* x1 = x0 + 32 * xstride;
    const u32x4* w0 = wf + lane;
    const u32x4* w1 = wf + KS * 64 + lane;
    u32x4 ra[PF], rb[PF];
#pragma unroll
    for (int u = 0; u < PF; ++u) { ra[u] = w0[u * 64]; rb[u] = w1[u * 64]; }
#pragma unroll 1
    for (int k0 = 0; k0 < KS; k0 += PF) {
#pragma unroll
        for (int u = 0; u < PF; ++u) {
            const int ks = k0 + u;
            const bf16x8 b0 = *(const bf16x8*)(x0 + ks * 32);
            const bf16x8 b1 = *(const bf16x8*)(x1 + ks * 32);
            const bf16x8 a0 = __builtin_bit_cast(bf16x8, ra[u]);
            const bf16x8 a1 = __builtin_bit_cast(bf16x8, rb[u]);
            if (KS > PF) { ra[u] = w0[(ks + PF) * 64]; rb[u] = w1[(ks + PF) * 64]; }
            __builtin_amdgcn_sched_barrier(0);
            if (SW) {
                acc[0][0] = mfma32(a0, b0, acc[0][0]); acc[0][1] = mfma32(a0, b1, acc[0][1]);
                acc[1][0] = mfma32(a1, b0, acc[1][0]); acc[1][1] = mfma32(a1, b1, acc[1][1]);
            } else {
                acc[0][0] = mfma32(b0, a0, acc[0][0]); acc[0][1] = mfma32(b1, a0, acc[0][1]);
                acc[1][0] = mfma32(b0, a1, acc[1][0]); acc[1][1] = mfma32(b1, a1, acc[1][1]);
            }
            __builtin_amdgcn_sched_barrier(0);
        }
    }
}
constexpr int GPF = 8;
template <int KS, bool SW>
__device__ __forceinline__ void gemm_2x2_stream(const u32x4* __restrict__ wf, const u32x4* __restrict__ wfn, bool fill, const unsigned char* xl, int xstride, int lane,
                                                f32x16 (&acc)[2][2], u32x4 (&ra)[GPF], u32x4 (&rb)[GPF]) {
    static_assert(KS % GPF == 0 && KS >= 2 * GPF, "KS must be a multiple of (and larger than) the prefetch depth");
    const int l31 = lane & 31, hh = lane >> 5;
    const unsigned char* x0 = xl + l31 * xstride + hh * 16;
    const unsigned char* x1 = x0 + 32 * xstride;
    const u32x4* w0 = wf + lane;
    const u32x4* w1 = wf + KS * 64 + lane;
    if (fill) {
#pragma unroll
        for (int u = 0; u < GPF; ++u) { ra[u] = w0[u * 64]; rb[u] = w1[u * 64]; }
    }
    bf16x8 b0 = *(const bf16x8*)(x0), b1 = *(const bf16x8*)(x1);
#pragma unroll 1
    for (int k0 = 0; k0 < KS; k0 += GPF) {
        const bool last = (k0 + GPF >= KS);
        const u32x4* n0 = last ? (wfn + lane) : (w0 + (k0 + GPF) * 64);
        const u32x4* n1 = last ? (wfn + KS * 64 + lane) : (w1 + (k0 + GPF) * 64);
#pragma unroll
        for (int u = 0; u < GPF; ++u) {
            const int ks = k0 + u;
            const bf16x8 nb0 = *(const bf16x8*)(x0 + (ks + 1) * 32);
            const bf16x8 nb1 = *(const bf16x8*)(x1 + (ks + 1) * 32);
            const bf16x8 a0 = __builtin_bit_cast(bf16x8, ra[u]);
            const bf16x8 a1 = __builtin_bit_cast(bf16x8, rb[u]);
            ra[u] = n0[u * 64]; rb[u] = n1[u * 64];
            __builtin_amdgcn_sched_barrier(0);
            if (SW) {
                acc[0][0] = mfma32(a0, b0, acc[0][0]); acc[0][1] = mfma32(a0, b1, acc[0][1]);
                acc[1][0] = mfma32(a1, b0, acc[1][0]); acc[1][1] = mfma32(a1, b1, acc[1][1]);
            } else {
                acc[0][0] = mfma32(b0, a0, acc[0][0]); acc[0][1] = mfma32(b1, a0, acc[0][1]);
                acc[1][0] = mfma32(b0, a1, acc[1][0]); acc[1][1] = mfma32(b1, a1, acc[1][1]);
            }
            __builtin_amdgcn_sched_barrier(0);
            b0 = nb0; b1 = nb1;
        }
    }
}
__device__ __forceinline__ void zero_acc(f32x16 (&acc)[2][2]) {
#pragma unroll
    for (int a = 0; a < 2; ++a)
#pragma unroll
        for (int b = 0; b < 2; ++b)
#pragma unroll
            for (int r = 0; r < 16; ++r) acc[a][b][r] = 0.f;
}
template <int MODE>
__device__ __forceinline__ void store_nat(const f32x16 (&acc)[2][2], __bf16* dst, int ld, int col0, int lane) {
    const int l31 = lane & 31, hh = lane >> 5;
#pragma unroll
    for (int nt = 0; nt < 2; ++nt)
#pragma unroll
        for (int mt = 0; mt < 2; ++mt)
#pragma unroll
            for (int g = 0; g < 4; ++g) {
                float v[4];
#pragma unroll
                for (int i = 0; i < 4; ++i) {
                    float t = acc[nt][mt][4 * g + i];
                    if (MODE == 1) t = siluf(t);
                    if (MODE == 2) t *= 0.125f;
                    if (MODE == 3) t *= QSCALE;
                    v[i] = t;
                }
                *(u32x2*)(dst + (size_t)(32 * mt + l31) * ld + col0 + 32 * nt + 8 * g + 4 * hh) = pk4(v[0], v[1], v[2], v[3]);
            }
}
__device__ __forceinline__ void store_tr(const f32x16 (&acc)[2][2], __bf16* dst, int group, int NT, int rowtile0, int s0, int lane) {
#pragma unroll
    for (int nt = 0; nt < 2; ++nt)
#pragma unroll
        for (int mt = 0; mt < 2; ++mt)
#pragma unroll
            for (int g = 0; g < 4; ++g) {
                const int k16 = (s0 >> 4) + 2 * mt + (g >> 1);
                *(u32x2*)(dst + ((((size_t)group * 128 + k16) * NT + rowtile0 + nt) * 64 + lane) * 8 + 4 * (g & 1)) =
                    pk4(acc[nt][mt][4 * g], acc[nt][mt][4 * g + 1], acc[nt][mt][4 * g + 2], acc[nt][mt][4 * g + 3]);
            }
}

__device__ __forceinline__ int win_col(int np) {
    if (np < 384) return np;
    if (np < 896) return 416 + (np - 384);
    if (np < 1152) return 928 + (np - 896);
    if (np < 1408) return 1184 + (np - 1152);
    if (np < 1920) return 1440 + (np - 1408);
    if (np < 2432) return 1968 + (np - 1920);
    if (np < 2464) return 384 + (np - 2432);
    if (np < 2480) return 1952 + (np - 2464);
    return -1;
}
__device__ void p0_mod_item(const Params& p, int item, unsigned char* lds) {
    int tid = threadIdx.x; asm volatile("" : "+v"(tid));
    const int lane = tid & 63, w = tid >> 6, l31 = lane & 31, hh = lane >> 5;
    const int n0 = item * 32;
    float* mod = (float*)(p.ws + WS_MOD);
    f32x16 acc[5];
#pragma unroll
    for (int m = 0; m < 5; ++m)
#pragma unroll
        for (int r = 0; r < 16; ++r) acc[m][r] = 0.f;
    float aN[8]; f32x4 c0N[5], c1N[5];
    const float* cp[5];
#pragma unroll
    for (int m = 0; m < 5; ++m) { const int row = min(32 * m + l31, 135); cp[m] = (row < 8) ? (p.c_prompt + (size_t)row * 1024) : (p.c_sample + (size_t)(row - 8) * 1024); }
#define MOD_LOAD(k8_) do { const int k0_ = 16 * (8 * w + (k8_)) + 8 * hh; \
        _Pragma("unroll") for (int j = 0; j < 8; ++j) aN[j] = p.w_ada[(size_t)(k0_ + j) * 3072 + n0 + l31]; \
        _Pragma("unroll") for (int m = 0; m < 5; ++m) { c0N[m] = *(const f32x4*)(cp[m] + k0_); c1N[m] = *(const f32x4*)(cp[m] + k0_ + 4); } } while (0)
    MOD_LOAD(0);
#pragma unroll 1
    for (int k8 = 0; k8 < 8; ++k8) {
        float aC[8]; f32x4 c0C[5], c1C[5];
#pragma unroll
        for (int j = 0; j < 8; ++j) aC[j] = aN[j];
#pragma unroll
        for (int m = 0; m < 5; ++m) { c0C[m] = c0N[m]; c1C[m] = c1N[m]; }
        MOD_LOAD(k8 < 7 ? k8 + 1 : 7);
        __builtin_amdgcn_sched_barrier(0);
        bf16x8 a;
#pragma unroll
        for (int j = 0; j < 8; ++j) a[j] = (__bf16)aC[j];
#pragma unroll
        for (int m = 0; m < 5; ++m) {
            bf16x8 bq;
            const bool live = (32 * m + l31) < 136;
#pragma unroll
            for (int j = 0; j < 4; ++j) { bq[j] = (__bf16)(live ? siluf(c0C[m][j]) : 0.f); bq[4 + j] = (__bf16)(live ? siluf(c1C[m][j]) : 0.f); }
            acc[m] = mfma32(a, bq, acc[m]);
        }
        __builtin_amdgcn_sched_barrier(0);
    }
#undef MOD_LOAD
    float* red = (float*)(lds + LDS_BASE);
#pragma unroll
    for (int m = 0; m < 5; ++m) {
#pragma unroll
        for (int r = 0; r < 16; ++r) red[(w * 16 + r) * 64 + lane] = acc[m][r];
        __syncthreads();
#pragma unroll
        for (int q = 0; q < 2; ++q) {
            const int o = tid + 512 * q, r = o >> 6, ln = o & 63;
            float s = 0.f;
#pragma unroll
            for (int ww = 0; ww < 8; ++ww) s += red[(ww * 16 + r) * 64 + ln];
            const int n = n0 + (r & 3) + 8 * (r >> 2) + 4 * (ln >> 5), row = 32 * m + (ln & 31);
            if (row < 136) mod[(size_t)row * 3072 + n] = s + p.b_ada[n];
        }
        __syncthreads();
    }
}
__device__ void p0_convert(const Params& p) {
    int tid0 = threadIdx.x; asm volatile("" : "+v"(tid0));
    const int nmod = (gridDim.x > 128) ? 96 : 0;
    if ((int)blockIdx.x < nmod) return;
    const int gt = ((int)blockIdx.x - nmod) * NTHR + tid0, GT = ((int)gridDim.x - nmod) * NTHR;
    u32x4* winf = (u32x4*)(p.ws + WS_WINF);
    for (int idx = gt; idx < 78 * 64 * 64; idx += GT) {
        const int lane = idx & 63, fk = idx >> 6, ks = fk & 63, nt = fk >> 6;
        const int col = win_col(nt * 32 + (lane & 31)), k0 = ks * 16 + 8 * (lane >> 5);
        float v[8];
#pragma unroll
        for (int j = 0; j < 8; ++j) v[j] = (col >= 0) ? p.w_in[(size_t)(k0 + j) * 2480 + col] : 0.f;
        u32x4 o; o.x = pk2(v[0], v[1]); o.y = pk2(v[2], v[3]); o.z = pk2(v[4], v[5]); o.w = pk2(v[6], v[7]);
        winf[idx] = o;
    }
    u32x4* wuqf = (u32x4*)(p.ws + WS_WUQF);
    for (int idx = gt; idx < 24 * 16 * 64; idx += GT) {
        const int lane = idx & 63, fk = idx >> 6, ks = fk & 15, nt = fk >> 4;
        const int n = nt * 32 + (lane & 31), k0 = ks * 16 + 8 * (lane >> 5);
        float v[8];
#pragma unroll
        for (int j = 0; j < 8; ++j) v[j] = p.w_uq[(size_t)(k0 + j) * 768 + n];
        u32x4 o; o.x = pk2(v[0], v[1]); o.y = pk2(v[2], v[3]); o.z = pk2(v[4], v[5]); o.w = pk2(v[6], v[7]);
        wuqf[idx] = o;
    }
    u32x4* wkvf = (u32x4*)(p.ws + WS_WKVF);
    for (int idx = gt; idx < 32 * 8 * 64; idx += GT) {
        const int lane = idx & 63, fk = idx >> 6, ks = fk & 7, nt = fk >> 3;
        const int n = nt * 32 + (lane & 31), k0 = ks * 16 + 8 * (lane >> 5);
        float v[8];
#pragma unroll
        for (int j = 0; j < 8; ++j) v[j] = (n < 512) ? p.w_uk[(size_t)(k0 + j) * 512 + n] : p.w_uv[(size_t)(k0 + j) * 512 + (n - 512)];
        u32x4 o; o.x = pk2(v[0], v[1]); o.y = pk2(v[2], v[3]); o.z = pk2(v[4], v[5]); o.w = pk2(v[6], v[7]);
        wkvf[idx] = o;
    }
    u32x4* woutf = (u32x4*)(p.ws + WS_WOUTF);
    for (int idx = gt; idx < 32 * 64 * 64; idx += GT) {
        const int lane = idx & 63, fk = idx >> 6, ks = fk & 63, nt = fk >> 6;
        const int n = nt * 32 + (lane & 31), k0 = ks * 16 + 8 * (lane >> 5);
        float v[8];
#pragma unroll
        for (int j = 0; j < 8; ++j) v[j] = p.w_out[(size_t)(k0 + j) * 1024 + n];
        u32x4 o; o.x = pk2(v[0], v[1]); o.y = pk2(v[2], v[3]); o.z = pk2(v[4], v[5]); o.w = pk2(v[6], v[7]);
        woutf[idx] = o;
    }
    __bf16* wukb = (__bf16*)(p.ws + WS_WUKB);
    __bf16* wuvt = (__bf16*)(p.ws + WS_WUVT);
    for (int idx = gt; idx < 65536; idx += GT) {
        wukb[idx] = (__bf16)p.w_uk[idx];
        const int r = idx & 127, v = (idx >> 7) & 63, h = idx >> 13;
        wuvt[idx] = (__bf16)p.w_uv[(size_t)r * 512 + h * 64 + v];
    }
    float* rope = (float*)(p.ws + WS_ROPE);
    for (int idx = gt; idx < 2049 * 16; idx += GT) {
        const int pi = idx >> 4, i = idx & 15;
        const float pos = (pi == 2048) ? 8192.f : (float)pi;
        const float inv = __builtin_amdgcn_exp2f(-(float)(2 * i) * (13.287712379549449f / 32.f));
        const double rev = (double)(pos * inv) * 0.15915494309189535;
        const float fr = (float)(rev - floor(rev));
        const float s = __builtin_amdgcn_sinf(fr), c = __builtin_amdgcn_cosf(fr);
        rope[pi * 32 + i] = c; rope[pi * 32 + 16 + i] = s;
    }
}

constexpr int XS = 2064;
constexpr int ZS = 1808;

__device__ __forceinline__ void p1_post(const Params& p, int it, unsigned char* lds);
__device__ void p1_stripe(const Params& p, int it, int mode, unsigned char* lds) {
    int tid = threadIdx.x; asm volatile("" : "+v"(tid));
    const int lane = tid & 63, w = tid >> 6, l31 = lane & 31, hh = lane >> 5;
    const bool is_s = it >= 256;
    const int srow0 = is_s ? (it - 256) * 64 : 0;
    const int tok0 = is_s ? NTOK + srow0 : it * 64;
    const int b = it >> 5, s0 = (it & 31) * 64;
    unsigned char* A = lds + LDS_BASE;
    const float* mod = (const float*)(p.ws + WS_MOD);
    const float* rope = (const float*)(p.ws + WS_ROPE);
    {
        const int c4 = tid & 255, rb = tid >> 8;
        if (!is_s) {
            const f32x4 sh = *(const f32x4*)(mod + (size_t)b * 3072 + 4 * c4);
            const f32x4 sc = *(const f32x4*)(mod + (size_t)b * 3072 + 1024 + 4 * c4);
            const float* xr = p.x_prompt + (size_t)(it * 64 + rb) * 1024 + 4 * c4;
            {
                f32x4 x[32];
#pragma unroll
                for (int u = 0; u < 32; ++u) x[u] = *(const f32x4*)(xr + (size_t)u * 2048);
                __builtin_amdgcn_sched_barrier(0);
#pragma unroll
                for (int u = 0; u < 32; ++u)
                    *(u32x2*)(A + (2 * u + rb) * XS + c4 * 8) = pk4(x[u][0] * (1.f + sc[0]) + sh[0], x[u][1] * (1.f + sc[1]) + sh[1], x[u][2] * (1.f + sc[2]) + sh[2], x[u][3] * (1.f + sc[3]) + sh[3]);
            }
        } else {
#pragma unroll 1
            for (int i0 = 0; i0 < 32; i0 += 4) {
                f32x4 x[4], sh[4], sc[4];
#pragma unroll
                for (int u = 0; u < 4; ++u) {
                    const int row = 2 * (i0 + u) + rb;
                    x[u] = *(const f32x4*)(p.x_sample + (size_t)(srow0 + row) * 1024 + 4 * c4);
                    sh[u] = *(const f32x4*)(mod + (size_t)(8 + srow0 + row) * 3072 + 4 * c4);
                    sc[u] = *(const f32x4*)(mod + (size_t)(8 + srow0 + row) * 3072 + 1024 + 4 * c4);
                }
                __builtin_amdgcn_sched_barrier(0);
#pragma unroll
                for (int u = 0; u < 4; ++u)
                    *(u32x2*)(A + (2 * (i0 + u) + rb) * XS + c4 * 8) = pk4(x[u][0] * (1.f + sc[u][0]) + sh[u][0], x[u][1] * (1.f + sc[u][1]) + sh[u][1], x[u][2] * (1.f + sc[u][2]) + sh[u][2], x[u][3] * (1.f + sc[u][3]) + sh[u][3]);
            }
        }
    }
    __syncthreads();
    const u32x4* winf = (const u32x4*)(p.ws + WS_WINF);
    __bf16* GM = (__bf16*)(p.ws + WS_GM); __bf16* GQ = (__bf16*)(p.ws + WS_GQ); __bf16* GK = (__bf16*)(p.ws + WS_GK);
    __bf16* GV = (__bf16*)(p.ws + WS_GV); __bf16* GG = (__bf16*)(p.ws + WS_GG);
    __bf16* GKT = (__bf16*)(p.ws + WS_GKT); __bf16* GVT = (__bf16*)(p.ws + WS_GVT);
    f32x16 acc[2][2];
    u32x4 ringa[GPF], ringb[GPF];
    const int sst = (w < 6) ? w : 38;
    bool fill = true;
#pragma unroll 1
    for (int i = 0; i < 4; ++i) {
        if (mode == 1 || (mode >= 2 && i != mode - 2)) continue;
        const int st = 6 + w + 8 * i;
        const int stn = (mode == 0) ? ((i < 3) ? st + 8 : ((w < 7) ? sst : st)) : st;
        zero_acc(acc);
        const bool tr = (!is_s) && (st >= 22 && st < 30);
        if (tr) gemm_2x2_stream<64, false>(winf + (size_t)st * 2 * 64 * 64, winf + (size_t)stn * 2 * 64 * 64, fill, A, XS, lane, acc, ringa, ringb);
        else    gemm_2x2_stream<64, true >(winf + (size_t)st * 2 * 64 * 64, winf + (size_t)stn * 2 * 64 * 64, fill, A, XS, lane, acc, ringa, ringb);
        fill = (mode != 0);
        int lane2 = lane; asm volatile("" : "+v"(lane2));
        if (st < 14) store_nat<1>(acc, GM + (size_t)tok0 * 512, 512, (st - 6) * 64, lane2);
        else if (st < 18) store_nat<2>(acc, GQ + (size_t)tok0 * 256, 256, (st - 14) * 64, lane2);
        else if (st < 22) {
            store_nat<0>(acc, GK + (size_t)tok0 * 256, 256, (st - 18) * 64, lane2);
            if (!is_s) {
                const int l31b = lane2 & 31, hhb = lane2 >> 5;
                __bf16* gb = GKT + ((((size_t)(b * 4 + (st - 18)) * 128 + (s0 >> 4) + (l31b >> 4)) * 2) * 64 + 32 * ((l31b >> 2) & 1) + 4 * hhb) * 8 + 4 * ((l31b >> 3) & 1) + (l31b & 3);
#pragma unroll
                for (int mt = 0; mt < 2; ++mt)
#pragma unroll
                    for (int nt = 0; nt < 2; ++nt)
#pragma unroll
                        for (int r = 0; r < 16; ++r)
                            gb[(size_t)mt * 2 * 2 * 512 + nt * 512 + ((r & 3) + 8 * (r >> 2)) * 8] = (__bf16)acc[nt][mt][r];
            }
        } else if (st < 30) {
            if (tr) store_tr(acc, GVT, b * 4 + ((st - 22) >> 1), 4, ((st - 22) & 1) * 2, s0, lane2);
            else store_nat<0>(acc, GV + (size_t)tok0 * 512, 512, (st - 22) * 64, lane2);
        } else store_nat<1>(acc, GG + (size_t)tok0 * 512, 512, (st - 30) * 64, lane2);
    }
    if (mode >= 2) { __syncthreads(); return; }
    if (w < 7) { zero_acc(acc); gemm_2x2_stream<64, true>(winf + (size_t)sst * 2 * 64 * 64, winf + (size_t)sst * 2 * 64 * 64, fill, A, XS, lane, acc, ringa, ringb); }
    __syncthreads();
    unsigned char* Z = A;
    if (w < 7) {
        const int cb = (w < 4) ? 64 * w : (w < 6 ? 256 + 64 * (w - 4) : 384);
#pragma unroll
        for (int nt = 0; nt < 2; ++nt)
#pragma unroll
            for (int mt = 0; mt < 2; ++mt)
#pragma unroll
                for (int g = 0; g < 4; ++g) {
                    f32x4 v = {acc[nt][mt][4 * g], acc[nt][mt][4 * g + 1], acc[nt][mt][4 * g + 2], acc[nt][mt][4 * g + 3]};
                    *(f32x4*)(Z + (32 * mt + l31) * ZS + (cb + 32 * nt + 8 * g + 4 * hh) * 4) = v;
                }
    }
    __syncthreads();
    p1_post(p, it, lds);
}

__device__ __forceinline__ void p1_post(const Params& p, int it, unsigned char* lds) {
    int tid = threadIdx.x; asm volatile("" : "+v"(tid));
    const int lane = tid & 63, w = tid >> 6, l31 = lane & 31, hh = lane >> 5;
    const bool is_s = it >= 256;
    const int srow0 = is_s ? (it - 256) * 64 : 0;
    const int tok0 = is_s ? NTOK + srow0 : it * 64;
    const int b = it >> 5, s0 = (it & 31) * 64;
    unsigned char* Z = lds + LDS_BASE;
    const float* rope = (const float*)(p.ws + WS_ROPE);
    f32x16 acc[2][2];
    float* latout = p.out + (is_s ? OUT_LATS + (size_t)srow0 * 128 : OUT_LATP + (size_t)it * 64 * 128);
    for (int rr = 0; rr < 8; ++rr) {
        const int row = 8 * w + rr;
        unsigned char* zr = Z + row * ZS;
        const f32x4 v = *(const f32x4*)(zr + 16 * lane);
        const float ss = wave_sum(v[0] * v[0] + v[1] * v[1] + v[2] * v[2] + v[3] * v[3]);
        const float inv = rsqrtf(ss * (1.f / 256.f) + NORM_EPS);
        const f32x4 g = *(const f32x4*)(p.q_norm_g + 4 * lane);
        const f32x2 c = *(const f32x2*)(zr + 1024 + 8 * lane);
        const float ss2 = wave_sum(c[0] * c[0] + c[1] * c[1]);
        const float inv2 = rsqrtf(ss2 * (1.f / 128.f) + NORM_EPS);
        const f32x2 g2 = *(const f32x2*)(p.kv_norm_g + 2 * lane);
        const float y0 = c[0] * inv2 * g2[0], y1 = c[1] * inv2 * g2[1];
        *(u32x2*)(zr + 8 * lane) = pk4(v[0] * inv * g[0], v[1] * inv * g[1], v[2] * inv * g[2], v[3] * inv * g[3]);
        *(unsigned*)(zr + 1024 + 4 * lane) = pk2(y0, y1);
        f32x2 yo = {y0, y1};
        *(f32x2*)(latout + (size_t)row * 128 + 2 * lane) = yo;
    }
    {
        float* krout = p.out + (is_s ? OUT_KRS + (size_t)srow0 * 32 : OUT_KRP + (size_t)it * 64 * 32);
        __bf16* KR = (__bf16*)(p.ws + WS_KR);
#pragma unroll
        for (int q = 0; q < 2; ++q) {
            const int idx = tid + NTHR * q, row = idx >> 4, i = idx & 15;
            const float* zr = (const float*)(Z + row * ZS);
            const float x1 = zr[384 + i], x2 = zr[400 + i];
            const int pi = is_s ? 2048 : s0 + row;
            const float cs = rope[pi * 32 + i], sn = rope[pi * 32 + 16 + i];
            const float o1 = x1 * cs - x2 * sn, o2 = x2 * cs + x1 * sn;
            krout[row * 32 + i] = o1; krout[row * 32 + 16 + i] = o2;
            if (!is_s) { KR[((size_t)b * 2048 + s0 + row) * 32 + i] = (__bf16)o1; KR[((size_t)b * 2048 + s0 + row) * 32 + 16 + i] = (__bf16)o2; }
        }
    }
    {
        const int n = 32 * w + l31, h = w >> 1, dk = 32 * (w & 1) + l31;
        bf16x8 wb;
#pragma unroll
        for (int e = 0; e < 8; ++e) wb[e] = (__bf16)p.w_gate_up[(8 * hh + e) * 256 + n];
        const float bg = p.b_gate[n];
        f32x16 la[2];
#pragma unroll
        for (int mt = 0; mt < 2; ++mt) {
            const float* zr = (const float*)(Z + (32 * mt + l31) * ZS);
            const bf16x8 ga = cvt8(*(const f32x4*)(zr + 416 + 8 * hh), *(const f32x4*)(zr + 420 + 8 * hh));
#pragma unroll
            for (int r = 0; r < 16; ++r) la[mt][r] = 0.f;
            la[mt] = mfma32(ga, wb, la[mt]);
#pragma unroll
            for (int r = 0; r < 16; ++r) { const float a = la[mt][r] + bg; la[mt][r] = (fminf(a, 0.f) - __logf(1.f + __expf(-fabsf(a)))) * (1.f / 16.f); }
        }
        if (!is_s) {
            float carry = 0.f;
#pragma unroll
            for (int mt = 0; mt < 2; ++mt) {
                float bs[4], ps[4];
#pragma unroll
                for (int g = 0; g < 4; ++g) { bs[g] = (la[mt][4 * g] + la[mt][4 * g + 1]) + (la[mt][4 * g + 2] + la[mt][4 * g + 3]); ps[g] = __shfl_xor(bs[g], 32); }
#pragma unroll
                for (int g = 0; g < 4; ++g) {
                    const float b0s = hh ? ps[g] : bs[g], b1s = hh ? bs[g] : ps[g];
                    float run = carry + (hh ? b0s : 0.f);
#pragma unroll
                    for (int i = 0; i < 4; ++i) { run += la[mt][4 * g + i]; la[mt][4 * g + i] = run; }
                    carry += b0s + b1s;
                }
            }
        }
        float* LAB = (float*)(p.ws + WS_LAB) + (size_t)tok0 * 256 + n;
#pragma unroll
        for (int mt = 0; mt < 2; ++mt)
#pragma unroll
            for (int r = 0; r < 16; ++r) LAB[(size_t)(32 * mt + (r & 3) + 8 * (r >> 2) + 4 * hh) * 256] = la[mt][r];
        if (!is_s) {
            float* BT = (float*)(p.ws + WS_BT);
#pragma unroll
            for (int mt = 0; mt < 2; ++mt)
#pragma unroll
                for (int g = 0; g < 4; ++g) {
                    const int k16 = (s0 >> 4) + 2 * mt + (g >> 1);
                    f32x4 v = {la[mt][4 * g], la[mt][4 * g + 1], la[mt][4 * g + 2], la[mt][4 * g + 3]};
                    *(f32x4*)(BT + ((((size_t)(b * 4 + h) * 128 + k16) * 2 + (w & 1)) * 64 + lane) * 8 + 4 * (g & 1)) = v;
                }
            if (hh) ((float*)(p.ws + WS_BL))[((size_t)(b * 4 + h) * 32 + (s0 >> 6)) * 64 + dk] = la[1][15];
        }
    }
    __syncthreads();
    {
        const u32x4* wuqf = (const u32x4*)(p.ws + WS_WUQF);
        const int h = w;
        const unsigned char* x0 = Z + l31 * ZS + hh * 16;
        const unsigned char* x1 = x0 + 32 * ZS;
        const int qoff = (h < 4) ? 512 + 128 * h : 1280 + 128 * (h - 4);
        __bf16* QLR = (__bf16*)(p.ws + WS_QLR);
        __bf16* Q = (__bf16*)(p.ws + WS_Q) + ((size_t)(b * 8 + h) * 2048 + s0) * 96;
#pragma unroll 1
        for (int j = 0; j < 3; ++j) {
            f32x16 q[2];
#pragma unroll
            for (int m = 0; m < 2; ++m)
#pragma unroll
                for (int r = 0; r < 16; ++r) q[m][r] = 0.f;
            const u32x4* wq = wuqf + (size_t)(3 * h + j) * 16 * 64 + lane;
            u32x4 rq[16];
#pragma unroll
            for (int ks = 0; ks < 16; ++ks) rq[ks] = wq[ks * 64];
            __builtin_amdgcn_sched_barrier(0);
#pragma unroll
            for (int ks = 0; ks < 16; ++ks) {
                const bf16x8 a = __builtin_bit_cast(bf16x8, rq[ks]);
                const bf16x8 b0 = *(const bf16x8*)(x0 + ks * 32), b1 = *(const bf16x8*)(x1 + ks * 32);
                q[0] = mfma32(a, b0, q[0]); q[1] = mfma32(a, b1, q[1]);
            }
            if (j == 2) {
#pragma unroll
                for (int m = 0; m < 2; ++m) {
                    const int pi = is_s ? 2048 : s0 + 32 * m + l31;
#pragma unroll
                    for (int g = 0; g < 2; ++g) {
                        const f32x4 cs = *(const f32x4*)(rope + pi * 32 + 8 * g + 4 * hh);
                        const f32x4 sn = *(const f32x4*)(rope + pi * 32 + 16 + 8 * g + 4 * hh);
#pragma unroll
                        for (int i = 0; i < 4; ++i) {
                            const float x1v = q[m][4 * g + i], x2v = q[m][4 * g + 8 + i];
                            q[m][4 * g + i] = x1v * cs[i] - x2v * sn[i];
                            q[m][4 * g + 8 + i] = x2v * cs[i] + x1v * sn[i];
                        }
                    }
                }
            }
#pragma unroll
            for (int m = 0; m < 2; ++m)
#pragma unroll
                for (int g = 0; g < 4; ++g) {
                    const int tok = 32 * m + l31;
                    if (!is_s) {
                        *(u32x2*)(Q + (size_t)tok * 96 + 32 * j + 8 * g + 4 * hh) = pk4(q[m][4 * g] * QSCALE, q[m][4 * g + 1] * QSCALE, q[m][4 * g + 2] * QSCALE, q[m][4 * g + 3] * QSCALE);
                    } else if (j == 2) {
                        *(u32x2*)(QLR + ((size_t)(srow0 + tok) * 8 + h) * 160 + 128 + 8 * g + 4 * hh) = pk4(q[m][4 * g] * QSCALE, q[m][4 * g + 1] * QSCALE, q[m][4 * g + 2] * QSCALE, q[m][4 * g + 3] * QSCALE);
                    } else {
                        *(u32x2*)(Z + tok * ZS + qoff + (32 * j + 8 * g + 4 * hh) * 2) = pk4(q[m][4 * g], q[m][4 * g + 1], q[m][4 * g + 2], q[m][4 * g + 3]);
                    }
                }
        }
        if (is_s) {
            asm volatile("s_waitcnt lgkmcnt(0)" ::: "memory");
            const __bf16* wukb = (const __bf16*)(p.ws + WS_WUKB);
#pragma unroll 1
            for (int rt = 0; rt < 4; ++rt) {
                f32x16 ql[2];
#pragma unroll
                for (int m = 0; m < 2; ++m)
#pragma unroll
                    for (int r = 0; r < 16; ++r) ql[m][r] = 0.f;
#pragma unroll
                for (int ks = 0; ks < 4; ++ks) {
                    const bf16x8 b0 = *(const bf16x8*)(Z + l31 * ZS + qoff + (16 * ks + 8 * hh) * 2);
                    const bf16x8 b1 = *(const bf16x8*)(Z + (32 + l31) * ZS + qoff + (16 * ks + 8 * hh) * 2);
                    const bf16x8 a = *(const bf16x8*)(wukb + ((size_t)(32 * rt + l31) * 8 + h) * 64 + 16 * ks + 8 * hh);
                    ql[0] = mfma32(a, b0, ql[0]); ql[1] = mfma32(a, b1, ql[1]);
                }
#pragma unroll
                for (int m = 0; m < 2; ++m)
#pragma unroll
                    for (int g = 0; g < 4; ++g)
                        *(u32x2*)(QLR + ((size_t)(srow0 + 32 * m + l31) * 8 + h) * 160 + 32 * rt + 8 * g + 4 * hh) =
                            pk4(ql[m][4 * g] * QSCALE, ql[m][4 * g + 1] * QSCALE, ql[m][4 * g + 2] * QSCALE, ql[m][4 * g + 3] * QSCALE);
            }
        }
    }
    if (!is_s) {
        const u32x4* wkvf = (const u32x4*)(p.ws + WS_WKVF);
        __bf16* KN = (__bf16*)(p.ws + WS_KN);
        __bf16* VT = (__bf16*)(p.ws + WS_VT);
#pragma unroll 1
        for (int pp = 0; pp < 2; ++pp) {
            const int nt0 = 4 * w + 2 * pp;
            zero_acc(acc);
            if (w < 4) {
                gemm_2x2<8, true>(wkvf + (size_t)nt0 * 8 * 64, Z + 1024, ZS, lane, acc);
                const int hd = nt0 >> 1;
                store_nat<0>(acc, KN + ((size_t)(b * 8 + hd) * 2048 + s0) * 64, 64, 0, lane);
            } else {
                gemm_2x2<8, false>(wkvf + (size_t)nt0 * 8 * 64, Z + 1024, ZS, lane, acc);
                const int hd = (nt0 - 16) >> 1;
                store_tr(acc, VT, b * 8 + hd, 2, 0, s0, lane);
            }
        }
    }
    __syncthreads();
}

constexpr int KST = 208, VST = 144;
constexpr int KBUF = 64 * KST, VBUF = 8192;

__device__ void p2_attn(const Params& p, int bh, int qb, unsigned char* lds) {
    int tid = threadIdx.x; asm volatile("" : "+v"(tid));
    const int lane = tid & 63, w = tid >> 6, l31 = lane & 31, hh = lane >> 5;
    const int b = bh >> 3, h = bh & 7;
    const __bf16* Q = (const __bf16*)(p.ws + WS_Q) + (size_t)bh * 2048 * 96;
    const __bf16* KN = (const __bf16*)(p.ws + WS_KN) + (size_t)bh * 2048 * 64;
    const __bf16* KR = (const __bf16*)(p.ws + WS_KR) + (size_t)b * 2048 * 32;
    const __bf16* VT = (const __bf16*)(p.ws + WS_VT) + (size_t)bh * 64 * 2048;
    unsigned char* Kb = lds + LDS_BASE;
    unsigned char* Vb = Kb + 2 * KBUF;
    const int qrow0 = qb * 256 + 32 * w, qi = qrow0 + l31;
    bf16x8 qf[6];
#pragma unroll
    for (int ks = 0; ks < 6; ++ks) qf[ks] = *(const bf16x8*)(Q + (size_t)qi * 96 + 16 * ks + 8 * hh);
    f32x16 o[2];
#pragma unroll
    for (int d = 0; d < 2; ++d)
#pragma unroll
        for (int r = 0; r < 16; ++r) o[d][r] = 0.f;
    float m = -1e30f, l = 0.f;
    const int nkt = (qb + 1) * 4;
    const int key_k = tid >> 3, ch_k = tid & 7, key_r = tid >> 2, ch_r = tid & 3;
    u32x4 kA, rA = {0u, 0u, 0u, 0u}, vA, kB, rB = {0u, 0u, 0u, 0u}, vB;
#define ATT_LOAD(kx, rx, vx, jt_) do { const int jc_ = ((jt_) < nkt) ? (jt_) : (nkt - 1); const int k0_ = 64 * jc_; \
        kx = *(const u32x4*)(KN + (size_t)(k0_ + key_k) * 64 + 8 * ch_k); \
        if (tid < 256) rx = *(const u32x4*)(KR + (size_t)(k0_ + key_r) * 32 + 8 * ch_r); \
        vx = *(const u32x4*)(VT + (size_t)jc_ * 4096 + (size_t)tid * 8); } while (0)
#define ATT_STORE(kx, rx, vx, buf_) do { unsigned char* kn_ = Kb + (buf_) * KBUF; unsigned char* vn_ = Vb + (buf_) * VBUF; \
        *(u32x4*)(kn_ + key_k * KST + ch_k * 16) = kx; \
        if (tid < 256) *(u32x4*)(kn_ + key_r * KST + 128 + ch_r * 16) = rx; \
        *(u32x4*)(vn_ + tid * 16) = vx; } while (0)
#define ATT_COMPUTE(j_, cur_) do { \
        const unsigned char* kb = Kb + (cur_) * KBUF; \
        const unsigned char* vb = Vb + (cur_) * VBUF; \
        _Pragma("unroll") for (int sub = 0; sub < 2; ++sub) { \
            const int key_lo = 64 * (j_) + 32 * sub; \
            if (key_lo <= qrow0 + 31) { \
                f32x16 s; \
                _Pragma("unroll") for (int r = 0; r < 16; ++r) s[r] = 0.f; \
                _Pragma("unroll") for (int ks = 0; ks < 6; ++ks) { \
                    const bf16x8 kf = *(const bf16x8*)(kb + (32 * sub + l31) * KST + (16 * ks + 8 * hh) * 2); \
                    s = mfma32(kf, qf[ks], s); } \
                if (key_lo + 31 > qrow0) { \
                    _Pragma("unroll") for (int r = 0; r < 16; ++r) { const int key = key_lo + (r & 3) + 8 * (r >> 2) + 4 * hh; if (key > qi) s[r] = -1e30f; } } \
                float mx = s[0]; \
                _Pragma("unroll") for (int r = 1; r < 16; ++r) mx = fmaxf(mx, s[r]); \
                mx = fmaxf(mx, __shfl_xor(mx, 32)); \
                const float mn = fmaxf(m, mx), alpha = ex2(m - mn); \
                m = mn; \
                float ps = 0.f; \
                _Pragma("unroll") for (int r = 0; r < 16; ++r) { s[r] = ex2(s[r] - mn); ps += s[r]; } \
                l = l * alpha + ps; \
                _Pragma("unroll") for (int d = 0; d < 2; ++d) _Pragma("unroll") for (int r = 0; r < 16; ++r) o[d][r] *= alpha; \
                _Pragma("unroll") for (int sk = 0; sk < 2; ++sk) { \
                    bf16x8 pf; \
                    _Pragma("unroll") for (int e = 0; e < 8; ++e) pf[e] = (__bf16)s[8 * sk + e]; \
                    _Pragma("unroll") for (int d = 0; d < 2; ++d) { \
                        const bf16x8 vf = *(const bf16x8*)(vb + ((2 * sub + sk) * 2 + d) * 1024 + lane * 16); \
                        o[d] = mfma32(vf, pf, o[d]); } } } } } while (0)
    ATT_LOAD(kA, rA, vA, 0);
    ATT_LOAD(kB, rB, vB, 1);
    ATT_STORE(kA, rA, vA, 0);
    ATT_LOAD(kA, rA, vA, 2);
    __syncthreads();
    for (int j = 0; j < nkt; j += 2) {
        ATT_COMPUTE(j, 0);
        ATT_STORE(kB, rB, vB, 1);
        ATT_LOAD(kB, rB, vB, j + 3);
        __syncthreads();
        ATT_COMPUTE(j + 1, 1);
        ATT_STORE(kA, rA, vA, 0);
        ATT_LOAD(kA, rA, vA, j + 4);
        __syncthreads();
    }
#undef ATT_LOAD
#undef ATT_STORE
#undef ATT_COMPUTE
    const float lt = l + __shfl_xor(l, 32);
    const float inv = 1.f / lt;
    __bf16* AO = (__bf16*)(p.ws + WS_AO) + ((size_t)b * 2048 + qi) * 512 + h * 64;
#pragma unroll
    for (int d = 0; d < 2; ++d)
#pragma unroll
        for (int g = 0; g < 4; ++g)
            *(u32x2*)(AO + 32 * d + 8 * g + 4 * hh) = pk4(o[d][4 * g] * inv, o[d][4 * g + 1] * inv, o[d][4 * g + 2] * inv, o[d][4 * g + 3] * inv);
}

constexpr int DVS = 80;
constexpr int DW_BYTES = 8192 + 32 * DVS + 16 * DVS;
typedef short s16x4 __attribute__((ext_vector_type(4)));
__device__ __forceinline__ f32x4 mfma16(bf16x8 a, bf16x8 b, f32x4 c) { return __builtin_amdgcn_mfma_f32_16x16x32_bf16(a, b, c, 0, 0, 0); }
__device__ __forceinline__ s16x4 lds_tr16(const unsigned char* q) { return __builtin_amdgcn_ds_read_tr16_b64_v4i16((LAS s16x4*)q); }
__device__ void p2_decode(const Params& p, int bs, int split, unsigned char* lds) {
    int tid = threadIdx.x; asm volatile("" : "+v"(tid));
    const int lane = tid & 63, w = tid >> 6, l15 = lane & 15, q4 = lane >> 4;
    unsigned char* IMG = lds + LDS_BASE + w * DW_BYTES;
    unsigned char* KRI = IMG + 8192;
    unsigned char* WP = KRI + 32 * DVS;
    const __bf16* QLR = (const __bf16*)(p.ws + WS_QLR);
    const int pg0 = split * 16 + 2 * w;
    const int phys0 = p.page_table[bs * NPAGES + pg0], phys1 = p.page_table[bs * NPAGES + pg0 + 1];
    f32x4 raw[20];
#define DEC_ISSUE(tt_) do { const int phys_ = ((tt_) >> 2) ? phys1 : phys0; \
        const float* lp_ = p.cache_lat + ((size_t)phys_ * 128 + ((tt_) & 3) * 32) * 128 + 4 * lane; \
        const float* kp_ = p.cache_kr + ((size_t)phys_ * 128 + ((tt_) & 3) * 32) * 32 + 4 * lane; \
        _Pragma("unroll") for (int i = 0; i < 16; ++i) raw[i] = __builtin_nontemporal_load((const f32x4*)(lp_ + 256 * i)); \
        _Pragma("unroll") for (int i = 0; i < 4; ++i) raw[16 + i] = __builtin_nontemporal_load((const f32x4*)(kp_ + 256 * i)); } while (0)
    DEC_ISSUE(0);
    bf16x8 qf[5];
#pragma unroll
    for (int ks = 0; ks < 5; ++ks) {
        u32x4 v = *(const u32x4*)(QLR + ((size_t)bs * 8 + (l15 & 7)) * 160 + 32 * ks + 8 * q4);
        if (l15 >= 8) v = (u32x4){0u, 0u, 0u, 0u};
        qf[ks] = __builtin_bit_cast(bf16x8, v);
    }
    const int hi = lane >> 5;
    const int W0 = 256 * hi + 16 * (((lane & 31) >> 1) ^ (hi << 2)) + 8 * (lane & 1);
    const int KW0 = (lane >> 3) * DVS + 8 * (lane & 7);
    const int RB0 = 256 * l15 + 16 * (q4 ^ (l15 >> 2)) + 64 * (l15 & 3);
    const int TQ = l15 >> 2, TP = lane & 3;
    const int T00 = 256 * (8 * q4 + TQ) + 16 * ((TP >> 1) ^ ((TQ << 2) | ((2 * q4) & 3))) + 8 * (TP & 1);
    const int T01 = 256 * (8 * q4 + 4 + TQ) + 16 * ((TP >> 1) ^ ((TQ << 2) | ((2 * q4 + 1) & 3))) + 8 * (TP & 1);
    f32x4 o[8];
#pragma unroll
    for (int t = 0; t < 8; ++t) o[t] = (f32x4){0.f, 0.f, 0.f, 0.f};
    float m = -1e30f, l = 0.f;
#pragma unroll 1
    for (int tt = 0; tt < 8; ++tt) {
#pragma unroll
        for (int i = 0; i < 16; ++i) {
            const int ci = (((2 * i) & 3) << 2) | ((i >> 1) & 3);
            *(u32x2*)(IMG + 512 * i + (W0 ^ (ci << 4))) = pk4(raw[i][0], raw[i][1], raw[i][2], raw[i][3]);
        }
#pragma unroll
        for (int i = 0; i < 4; ++i) *(u32x2*)(KRI + 8 * i * DVS + KW0) = pk4(raw[16 + i][0], raw[16 + i][1], raw[16 + i][2], raw[16 + i][3]);
        asm volatile("" ::: "memory");
        DEC_ISSUE(tt < 7 ? tt + 1 : 7);
        f32x4 s[2];
#pragma unroll
        for (int j = 0; j < 2; ++j) {
            s[j] = (f32x4){0.f, 0.f, 0.f, 0.f};
#pragma unroll
            for (int ks = 0; ks < 4; ++ks) {
                const bf16x8 kf = *(const bf16x8*)(IMG + 4096 * j + (RB0 ^ (ks << 6)));
                s[j] = mfma16(kf, qf[ks], s[j]);
            }
            const bf16x8 kf = *(const bf16x8*)(KRI + (16 * j + l15) * DVS + 16 * q4);
            s[j] = mfma16(kf, qf[4], s[j]);
        }
        float mx = fmaxf(fmaxf(fmaxf(s[0][0], s[0][1]), fmaxf(s[0][2], s[0][3])), fmaxf(fmaxf(s[1][0], s[1][1]), fmaxf(s[1][2], s[1][3])));
        mx = fmaxf(mx, __shfl_xor(mx, 16)); mx = fmaxf(mx, __shfl_xor(mx, 32));
        const float mn = fmaxf(m, mx), alpha = ex2(m - mn);
        m = mn;
        float ps = 0.f;
#pragma unroll
        for (int j = 0; j < 2; ++j)
#pragma unroll
            for (int r = 0; r < 4; ++r) { s[j][r] = ex2(s[j][r] - mn); ps += s[j][r]; }
        l = l * alpha + ps;
#pragma unroll
        for (int t = 0; t < 8; ++t) o[t] *= alpha;
#pragma unroll
        for (int j = 0; j < 2; ++j) *(u32x2*)(WP + l15 * DVS + (16 * j + 4 * q4) * 2) = pk4(s[j][0], s[j][1], s[j][2], s[j][3]);
        {
            const bf16x8 pf = *(const bf16x8*)(WP + l15 * DVS + 8 * q4 * 2);
#pragma unroll
            for (int t = 0; t < 8; ++t) {
                const s16x4 v0 = lds_tr16(IMG + (T00 ^ (t << 5))), v1 = lds_tr16(IMG + (T01 ^ (t << 5)));
                typedef short s16x8 __attribute__((ext_vector_type(8)));
                const s16x8 vv = {v0[0], v0[1], v0[2], v0[3], v1[0], v1[1], v1[2], v1[3]};
                o[t] = mfma16(__builtin_bit_cast(bf16x8, vv), pf, o[t]);
            }
        }
    }
#undef DEC_ISSUE
    float lt = l + __shfl_xor(l, 16); lt += __shfl_xor(lt, 32);
    __syncthreads();
    float* MG = (float*)(lds + LDS_BASE);
    if (l15 < 8) {
        float* rec = MG + (w * 8 + l15) * 132;
        if (q4 == 0) { rec[0] = m; rec[1] = lt; }
#pragma unroll
        for (int t = 0; t < 8; ++t) *(f32x4*)(rec + 4 + 16 * t + 4 * q4) = o[t];
    }
    __syncthreads();
    {
        const int hd = tid >> 6, r2 = 2 * (tid & 63);
        float M = -1e30f;
#pragma unroll
        for (int ww = 0; ww < 8; ++ww) M = fmaxf(M, MG[(ww * 8 + hd) * 132]);
        float L = 0.f, o0 = 0.f, o1 = 0.f;
#pragma unroll
        for (int ww = 0; ww < 8; ++ww) {
            const float* rec = MG + (ww * 8 + hd) * 132;
            const float wt = ex2(rec[0] - M);
            L = fmaf(wt, rec[1], L); o0 = fmaf(wt, rec[4 + r2], o0); o1 = fmaf(wt, rec[5 + r2], o1);
        }
        float* dp = (float*)(p.ws + WS_DPART) + ((size_t)(bs * 4 + split) * 8 + hd) * 132;
        if ((tid & 63) == 0) { dp[0] = M; dp[1] = L; }
        f32x2 ov = {o0, o1};
        *(f32x2*)(dp + 4 + r2) = ov;
    }
    __syncthreads();
}

__device__ void p2_scan(const Params& p, int bh) {
    int tid = threadIdx.x; asm volatile("" : "+v"(tid));
    const int lane = tid & 63, w = tid >> 6, l31 = lane & 31, hh = lane >> 5;
    const int dkt = w & 1, dvt = w >> 1;
    const float* BT = (const float*)(p.ws + WS_BT) + (size_t)bh * 64 * 2048;
    const __bf16* GKT = (const __bf16*)(p.ws + WS_GKT) + (size_t)bh * 64 * 2048;
    const __bf16* GVT = (const __bf16*)(p.ws + WS_GVT) + (size_t)bh * 128 * 2048;
    const float* BL = (const float*)(p.ws + WS_BL) + (size_t)bh * 32 * 64;
    __bf16* ST2 = (__bf16*)(p.ws + WS_ST2) + (size_t)bh * 32 * 128 * 64;
    const int dkA = 32 * dkt + l31, dvB = 32 * dvt + l31;
    f32x16 S;
#pragma unroll
    for (int r = 0; r < 16; ++r) S[r] = 0.f;
    float decN[16], blN; u32x4 kN[4]; f32x4 b0N[4], b1N[4]; bf16x8 vN[4];
#define SCAN_LOAD(c_) do { \
        _Pragma("unroll") for (int r = 0; r < 16; ++r) decN[r] = BL[(c_) * 64 + 32 * dkt + (r & 3) + 8 * (r >> 2) + 4 * hh]; \
        blN = BL[(c_) * 64 + dkA]; \
        _Pragma("unroll") for (int ks = 0; ks < 4; ++ks) { const size_t k16 = (size_t)(c_) * 4 + ks; \
            kN[ks] = *(const u32x4*)(GKT + ((k16 * 2 + dkt) * 64 + lane) * 8); \
            b0N[ks] = *(const f32x4*)(BT + ((k16 * 2 + dkt) * 64 + lane) * 8); b1N[ks] = *(const f32x4*)(BT + ((k16 * 2 + dkt) * 64 + lane) * 8 + 4); \
            vN[ks] = *(const bf16x8*)(GVT + ((k16 * 4 + dvt) * 64 + lane) * 8); } \
    } while (0)
    SCAN_LOAD(0);
#pragma unroll 1
    for (int c = 0; c < 32; ++c) {
        float dec[16]; u32x4 kC[4]; f32x4 b0C[4], b1C[4]; bf16x8 vC[4];
        const float blast = blN;
#pragma unroll
        for (int r = 0; r < 16; ++r) dec[r] = decN[r];
#pragma unroll
        for (int ks = 0; ks < 4; ++ks) { kC[ks] = kN[ks]; b0C[ks] = b0N[ks]; b1C[ks] = b1N[ks]; vC[ks] = vN[ks]; }
        SCAN_LOAD(c + 1);
        __builtin_amdgcn_sched_barrier(0);
#pragma unroll
        for (int g = 0; g < 4; ++g)
            *(u32x2*)(ST2 + ((size_t)c * 128 + dvB) * 64 + 32 * dkt + 8 * g + 4 * hh) = pk4(S[4 * g], S[4 * g + 1], S[4 * g + 2], S[4 * g + 3]);
#pragma unroll
        for (int r = 0; r < 16; ++r) S[r] *= __expf(dec[r]);
#pragma unroll
        for (int ks = 0; ks < 4; ++ks) {
            float kv[8]; unpack8(kC[ks], kv);
            bf16x8 ka;
#pragma unroll
            for (int e = 0; e < 4; ++e) { ka[e] = (__bf16)(kv[e] * __expf(blast - b0C[ks][e])); ka[4 + e] = (__bf16)(kv[4 + e] * __expf(blast - b1C[ks][e])); }
            S = mfma32(ka, vC[ks], S);
        }
        __builtin_amdgcn_sched_barrier(0);
    }
#undef SCAN_LOAD
    float* stp = p.out + OUT_STP + (size_t)bh * 64 * 128;
#pragma unroll
    for (int r = 0; r < 16; ++r) {
        const int dkr = 32 * dkt + (r & 3) + 8 * (r >> 2) + 4 * hh;
        stp[(size_t)dkr * 128 + dvB] = S[r];
    }
}

__device__ void p2_glarec(const Params& p, int bs, unsigned char* lds) {
    int tid = threadIdx.x; asm volatile("" : "+v"(tid));
    float* sq = (float*)(lds + LDS_BASE); float* sk = sq + 256; float* se = sk + 256;
    const __bf16* GQ = (const __bf16*)(p.ws + WS_GQ) + (size_t)(NTOK + bs) * 256;
    const __bf16* GK = (const __bf16*)(p.ws + WS_GK) + (size_t)(NTOK + bs) * 256;
    const float* LAB = (const float*)(p.ws + WS_LAB) + (size_t)(NTOK + bs) * 256;
    if (tid < 256) { sq[tid] = (float)GQ[tid]; sk[tid] = (float)GK[tid]; se[tid] = __expf(LAB[tid]); }
    __syncthreads();
    const int h = tid >> 7, dv = tid & 127;
    const float v = (float)((const __bf16*)(p.ws + WS_GV))[(size_t)(NTOK + bs) * 512 + h * 128 + dv];
    const float* s0 = p.state_gla + ((size_t)(bs * 4 + h) * 64) * 128 + dv;
    float* s1 = p.out + OUT_STS + ((size_t)(bs * 4 + h) * 64) * 128 + dv;
    float o = 0.f;
#pragma unroll 8
    for (int dk = 0; dk < 64; ++dk) {
        const float ns = se[h * 64 + dk] * s0[(size_t)dk * 128] + sk[h * 64 + dk] * v;
        s1[(size_t)dk * 128] = ns;
        o = fmaf(sq[h * 64 + dk], ns, o);
    }
    ((float*)(p.ws + WS_GLAOS))[(size_t)(bs * 4 + h) * 128 + dv] = o;
    __syncthreads();
}

__device__ __forceinline__ void p3_outproj(const Params& p, int it, unsigned char* lds);
__device__ void p3_stripe(const Params& p, int it, unsigned char* lds) {
    int tid = threadIdx.x; asm volatile("" : "+v"(tid));
    const int lane = tid & 63, w = tid >> 6, l31 = lane & 31, hh = lane >> 5;
    const bool is_s = it >= 512;
    const int srow0 = is_s ? (it - 512) * 32 : 0;
    const int st = it >> 1, half = it & 1;
    const int tok0 = is_s ? NTOK + srow0 : st * 64 + 32 * half;
    const int b = st >> 5, c = st & 31, s0 = c * 64;
    unsigned char* A = lds + LDS_BASE;
    const __bf16* GM = (const __bf16*)(p.ws + WS_GM);
    const __bf16* GG = (const __bf16*)(p.ws + WS_GG);
    if (!is_s) {
        const __bf16* AO = (const __bf16*)(p.ws + WS_AO);
        const int h = w >> 1, dvh = w & 1, bh = b * 4 + h;
        const int ti = 32 * half + l31;
        const size_t trow = (size_t)(st * 64 + ti);
        const __bf16* GQ = (const __bf16*)(p.ws + WS_GQ);
        const __bf16* GK = (const __bf16*)(p.ws + WS_GK);
        const float* LAB = (const float*)(p.ws + WS_LAB);
        const __bf16* GVT = (const __bf16*)(p.ws + WS_GVT) + (size_t)bh * 128 * 2048;
        const __bf16* ST2 = (const __bf16*)(p.ws + WS_ST2) + ((size_t)bh * 32 + c) * 128 * 64;
        bf16x8 qf[4], kf0[4], vf0[2][2];
        {
            u32x4 av[4], gv[4];
            u32x4 qr[4], kr[4]; f32x4 qb0[4], qb1[4], kb0[4], kb1[4];
            const size_t jrow = (size_t)(st * 64 + l31);
#pragma unroll
            for (int i = 0; i < 4; ++i) {
                const int idx = i * NTHR + tid, row = idx >> 6, ch = idx & 63;
                av[i] = *(const u32x4*)(AO + (size_t)(tok0 + row) * 512 + 8 * ch);
                gv[i] = *(const u32x4*)(GM + (size_t)(tok0 + row) * 512 + 8 * ch);
            }
#pragma unroll
            for (int ks = 0; ks < 4; ++ks) {
                const int dk0 = h * 64 + 16 * ks + 8 * hh;
                qr[ks] = *(const u32x4*)(GQ + trow * 256 + dk0);
                qb0[ks] = *(const f32x4*)(LAB + trow * 256 + dk0); qb1[ks] = *(const f32x4*)(LAB + trow * 256 + dk0 + 4);
                kr[ks] = *(const u32x4*)(GK + jrow * 256 + dk0);
                kb0[ks] = *(const f32x4*)(LAB + jrow * 256 + dk0); kb1[ks] = *(const f32x4*)(LAB + jrow * 256 + dk0 + 4);
            }
#pragma unroll
            for (int sk = 0; sk < 2; ++sk)
#pragma unroll
                for (int t = 0; t < 2; ++t) vf0[sk][t] = *(const bf16x8*)(GVT + ((((size_t)(s0 >> 4) + sk) * 4 + 2 * dvh + t) * 64 + lane) * 8);
            __builtin_amdgcn_sched_barrier(0);
#pragma unroll
            for (int i = 0; i < 4; ++i) {
                const int idx = i * NTHR + tid, row = idx >> 6, ch = idx & 63;
                float af[8], gf[8]; unpack8(av[i], af); unpack8(gv[i], gf);
                u32x4 o; o.x = pk2(af[0] * gf[0], af[1] * gf[1]); o.y = pk2(af[2] * gf[2], af[3] * gf[3]); o.z = pk2(af[4] * gf[4], af[5] * gf[5]); o.w = pk2(af[6] * gf[6], af[7] * gf[7]);
                *(u32x4*)(A + row * XS + ch * 16) = o;
            }
#pragma unroll
            for (int ks = 0; ks < 4; ++ks) {
                float qv[8], kv[8]; unpack8(qr[ks], qv); unpack8(kr[ks], kv);
#pragma unroll
                for (int e = 0; e < 4; ++e) {
                    qf[ks][e] = (__bf16)(qv[e] * __expf(qb0[ks][e])); qf[ks][4 + e] = (__bf16)(qv[4 + e] * __expf(qb1[ks][e]));
                    kf0[ks][e] = (__bf16)(kv[e] * __expf(-kb0[ks][e])); kf0[ks][4 + e] = (__bf16)(kv[4 + e] * __expf(-kb1[ks][e]));
                }
            }
        }
        bf16x8 sf[4][2], vf1[2][2]; u32x4 kr1[4]; f32x4 kb10[4], kb11[4], gn[2][4]; u32x2 gg[2][4];
        {
            const size_t jrow1 = (size_t)(st * 64 + 32 + l31);
#pragma unroll
            for (int ks = 0; ks < 4; ++ks) {
                const int dk0 = h * 64 + 16 * ks + 8 * hh;
#pragma unroll
                for (int t = 0; t < 2; ++t) sf[ks][t] = *(const bf16x8*)(ST2 + (size_t)(32 * (2 * dvh + t) + l31) * 64 + 16 * ks + 8 * hh);
                kr1[ks] = *(const u32x4*)(GK + jrow1 * 256 + dk0);
                kb10[ks] = *(const f32x4*)(LAB + jrow1 * 256 + dk0); kb11[ks] = *(const f32x4*)(LAB + jrow1 * 256 + dk0 + 4);
            }
#pragma unroll
            for (int sk = 0; sk < 2; ++sk)
#pragma unroll
                for (int t = 0; t < 2; ++t) vf1[sk][t] = *(const bf16x8*)(GVT + ((((size_t)(s0 >> 4) + 2 + sk) * 4 + 2 * dvh + t) * 64 + lane) * 8);
#pragma unroll
            for (int t = 0; t < 2; ++t)
#pragma unroll
                for (int g = 0; g < 4; ++g) {
                    const int dv = 32 * (2 * dvh + t) + 8 * g + 4 * hh;
                    gn[t][g] = *(const f32x4*)(p.gla_norm_g + h * 128 + dv);
                    gg[t][g] = *(const u32x2*)(GG + trow * 512 + h * 128 + dv);
                }
        }
        __builtin_amdgcn_sched_barrier(0);
        f32x16 o[2];
#pragma unroll
        for (int t = 0; t < 2; ++t)
#pragma unroll
            for (int r = 0; r < 16; ++r) o[t][r] = 0.f;
        {
            f32x16 att;
#pragma unroll
            for (int r = 0; r < 16; ++r) att[r] = 0.f;
#pragma unroll
            for (int ks = 0; ks < 4; ++ks) att = mfma32(kf0[ks], qf[ks], att);
            if (half == 0) {
#pragma unroll
                for (int r = 0; r < 16; ++r) { const int j = (r & 3) + 8 * (r >> 2) + 4 * hh; if (j > l31) att[r] = 0.f; }
            }
#pragma unroll
            for (int sk = 0; sk < 2; ++sk) {
                bf16x8 pf;
#pragma unroll
                for (int e = 0; e < 8; ++e) pf[e] = (__bf16)att[8 * sk + e];
#pragma unroll
                for (int t = 0; t < 2; ++t) o[t] = mfma32(vf0[sk][t], pf, o[t]);
            }
        }
        __builtin_amdgcn_sched_barrier(0);
        if (half == 1) {
            f32x16 att;
#pragma unroll
            for (int r = 0; r < 16; ++r) att[r] = 0.f;
#pragma unroll
            for (int ks = 0; ks < 4; ++ks) {
                float kv[8]; unpack8(kr1[ks], kv);
                bf16x8 kf;
#pragma unroll
                for (int e = 0; e < 4; ++e) { kf[e] = (__bf16)(kv[e] * __expf(-kb10[ks][e])); kf[4 + e] = (__bf16)(kv[4 + e] * __expf(-kb11[ks][e])); }
                att = mfma32(kf, qf[ks], att);
            }
#pragma unroll
            for (int r = 0; r < 16; ++r) { const int j = (r & 3) + 8 * (r >> 2) + 4 * hh; if (j > l31) att[r] = 0.f; }
#pragma unroll
            for (int sk = 0; sk < 2; ++sk) {
                bf16x8 pf;
#pragma unroll
                for (int e = 0; e < 8; ++e) pf[e] = (__bf16)att[8 * sk + e];
#pragma unroll
                for (int t = 0; t < 2; ++t) o[t] = mfma32(vf1[sk][t], pf, o[t]);
            }
        }
#pragma unroll
        for (int ks = 0; ks < 4; ++ks)
#pragma unroll
            for (int t = 0; t < 2; ++t) o[t] = mfma32(sf[ks][t], qf[ks], o[t]);
        float ss = 0.f;
#pragma unroll
        for (int t = 0; t < 2; ++t)
#pragma unroll
            for (int r = 0; r < 16; ++r) ss = fmaf(o[t][r], o[t][r], ss);
        ss += __shfl_xor(ss, 32);
        float* SSX = (float*)(lds + LDS_BASE + 64 * XS);
        if (hh == 0) SSX[w * 32 + l31] = ss;
        __syncthreads();
        ss += SSX[(w ^ 1) * 32 + l31];
        const float inv = rsqrtf(ss * (1.f / 128.f) + NORM_EPS);
#pragma unroll
        for (int t = 0; t < 2; ++t)
#pragma unroll
            for (int g = 0; g < 4; ++g) {
                const int dv = 32 * (2 * dvh + t) + 8 * g + 4 * hh;
                *(u32x2*)(A + l31 * XS + (512 + h * 128 + dv) * 2) =
                    pk4(o[t][4 * g] * inv * gn[t][g][0] * bflo(gg[t][g].x), o[t][4 * g + 1] * inv * gn[t][g][1] * bfhi(gg[t][g].x),
                        o[t][4 * g + 2] * inv * gn[t][g][2] * bflo(gg[t][g].y), o[t][4 * g + 3] * inv * gn[t][g][3] * bfhi(gg[t][g].y));
            }
    }
    __syncthreads();
    p3_outproj(p, it, lds);
}

__device__ __forceinline__ void p3_outproj(const Params& p, int it, unsigned char* lds) {
    int tid = threadIdx.x; asm volatile("" : "+v"(tid));
    const int lane = tid & 63, w = tid >> 6, l31 = lane & 31, hh = lane >> 5;
    const bool is_s = it >= 512;
    const int srow0 = is_s ? (it - 512) * 32 : 0;
    const int st = it >> 1, half = it & 1, b = st >> 5;
    unsigned char* A = lds + LDS_BASE;
    const u32x4* woutf = (const u32x4*)(p.ws + WS_WOUTF);
    const float* mod = (const float*)(p.ws + WS_MOD);
    float s1 = 0.f, s2 = 0.f;
    const size_t row0 = is_s ? (size_t)srow0 : (size_t)st * 64 + 32 * half;
    const float* xb0 = (is_s ? p.x_sample : p.x_prompt) + (row0 + l31) * 1024 + 64 * w + 4 * hh;
    const float* gb0 = mod + (size_t)(is_s ? (8 + srow0 + l31) : b) * 3072 + 2048 + 64 * w + 4 * hh;
    float* yb0 = p.out + (is_s ? OUT_YS : OUT_YP) + (row0 + l31) * 1024 + 64 * w + 4 * hh;
    f32x16 vacc[2][2];
#pragma unroll
    for (int q = 0; q < 2; ++q) {
        f32x16 acc[2];
#pragma unroll
        for (int nt = 0; nt < 2; ++nt)
#pragma unroll
            for (int r = 0; r < 16; ++r) acc[nt][r] = 0.f;
        f32x4 xv[2][4];
        {
            const unsigned char* x0 = A + l31 * XS + hh * 16;
            const u32x4* w0 = woutf + (size_t)(w + 8 * q) * 2 * 64 * 64 + lane;
            const u32x4* w1 = w0 + 64 * 64;
            u32x4 ra[8], rb[8];
#pragma unroll
            for (int u = 0; u < 8; ++u) { ra[u] = w0[u * 64]; rb[u] = w1[u * 64]; }
#pragma unroll
            for (int g = 0; g < 4; ++g) xv[0][g] = *(const f32x4*)(xb0 + 512 * q + 8 * g);
            const float xtouch = xb0[512 * q + 32];
            bf16x8 b0 = *(const bf16x8*)(x0);
#pragma unroll 1
            for (int k0 = 0; k0 < 64; k0 += 8) {
#pragma unroll
                for (int u = 0; u < 8; ++u) {
                    const int ks = k0 + u;
                    const bf16x8 nb0 = *(const bf16x8*)(x0 + (ks + 1) * 32);
                    const bf16x8 a0 = __builtin_bit_cast(bf16x8, ra[u]), a1 = __builtin_bit_cast(bf16x8, rb[u]);
                    ra[u] = w0[(ks + 8) * 64]; rb[u] = w1[(ks + 8) * 64];
                    __builtin_amdgcn_sched_barrier(0);
                    acc[0] = mfma32(a0, b0, acc[0]); acc[1] = mfma32(a1, b0, acc[1]);
                    __builtin_amdgcn_sched_barrier(0);
                    b0 = nb0;
                }
            }
            asm volatile("" :: "v"(xtouch));
        }
        f32x4 gt[2][4];
#pragma unroll
        for (int nt = 0; nt < 2; ++nt)
#pragma unroll
            for (int g = 0; g < 4; ++g) gt[nt][g] = *(const f32x4*)(gb0 + 512 * q + 32 * nt + 8 * g);
#pragma unroll
        for (int g = 0; g < 4; ++g) xv[1][g] = *(const f32x4*)(xb0 + 512 * q + 32 + 8 * g);
        __builtin_amdgcn_sched_barrier(0);
#pragma unroll
        for (int nt = 0; nt < 2; ++nt)
#pragma unroll
            for (int g = 0; g < 4; ++g)
#pragma unroll
                for (int i = 0; i < 4; ++i) {
                    const float v = DN_ALPHA * xv[nt][g][i] + gt[nt][g][i] * acc[nt][4 * g + i];
                    vacc[q][nt][4 * g + i] = v;
                    s1 += v; s2 = fmaf(v, v, s2);
                }
        __builtin_amdgcn_sched_barrier(0);
    }
    float* LNP = (float*)(lds + LDS_BASE + 64 * XS);
    s1 += __shfl_xor(s1, 32); s2 += __shfl_xor(s2, 32);
    __syncthreads();
    if (hh == 0) { LNP[(w * 32 + l31) * 2] = s1; LNP[(w * 32 + l31) * 2 + 1] = s2; }
    __syncthreads();
    float mean, rstd;
    {
        float a = 0.f, bq = 0.f;
#pragma unroll
        for (int ww = 0; ww < 8; ++ww) { a += LNP[(ww * 32 + l31) * 2]; bq += LNP[(ww * 32 + l31) * 2 + 1]; }
        mean = a * (1.f / 1024.f);
        const float var = fmaxf(bq * (1.f / 1024.f) - mean * mean, 0.f);
        rstd = rsqrtf(var + NORM_EPS);
    }
    const float* lgb = p.ln_g + 64 * w + 4 * hh;
    const float* lbb = p.ln_b + 64 * w + 4 * hh;
#pragma unroll
    for (int q = 0; q < 2; ++q) {
        f32x4 lg[2][4], lb[2][4];
#pragma unroll
        for (int nt = 0; nt < 2; ++nt)
#pragma unroll
            for (int g = 0; g < 4; ++g) {
                const int off = 512 * q + 32 * nt + 8 * g;
                lg[nt][g] = *(const f32x4*)(lgb + off); lb[nt][g] = *(const f32x4*)(lbb + off);
            }
        __builtin_amdgcn_sched_barrier(0);
#pragma unroll
        for (int nt = 0; nt < 2; ++nt)
#pragma unroll
            for (int g = 0; g < 4; ++g) {
                const int off = 512 * q + 32 * nt + 8 * g;
                f32x4 y;
#pragma unroll
                for (int i = 0; i < 4; ++i) y[i] = (vacc[q][nt][4 * g + i] - mean) * rstd * lg[nt][g][i] + lb[nt][g][i];
                *(f32x4*)(yb0 + off) = y;
            }
        __builtin_amdgcn_sched_barrier(0);
    }
    __syncthreads();
}


__device__ void p3s_arows(const Params& p, int k, unsigned char* lds) {
    int tid = threadIdx.x; asm volatile("" : "+v"(tid));
    const int lane = tid & 63, w = tid >> 6, l31 = lane & 31, hh = lane >> 5;
    const int r0 = 8 * k, h = w;
    const __bf16* QLR = (const __bf16*)(p.ws + WS_QLR);
    const float* DP = (const float*)(p.ws + WS_DPART);
    const float* lat_s = p.out + OUT_LATS;
    const float* kr_s = p.out + OUT_KRS;
    const __bf16* GM = (const __bf16*)(p.ws + WS_GM);
    const __bf16* GG = (const __bf16*)(p.ws + WS_GG);
    __bf16* AS = (__bf16*)(p.ws + WS_AS);
    unsigned char* OL = lds + LDS_BASE + w * 2304;
#pragma unroll 1
    for (int q0 = 0; q0 < 8; q0 += 4) {
        float qa[4], qb[4], qc[4], la[4], lb2[4], kc[4], mi[4][4], li[4][4];
        f32x2 ln[4], ov[4][4];
#pragma unroll
        for (int u = 0; u < 4; ++u) {
            const int bs = r0 + q0 + u;
            const __bf16* ql = QLR + ((size_t)bs * 8 + h) * 160;
            qa[u] = (float)ql[lane]; qb[u] = (float)ql[64 + lane]; qc[u] = (float)ql[128 + (lane & 31)];
            la[u] = lat_s[(size_t)bs * 128 + lane]; lb2[u] = lat_s[(size_t)bs * 128 + 64 + lane]; kc[u] = kr_s[(size_t)bs * 32 + (lane & 31)];
            ln[u] = *(const f32x2*)(lat_s + (size_t)bs * 128 + 2 * lane);
#pragma unroll
            for (int sp = 0; sp < 4; ++sp) {
                const float* d = DP + ((size_t)(bs * 4 + sp) * 8 + h) * 132;
                mi[u][sp] = d[0]; li[u][sp] = d[1]; ov[u][sp] = *(const f32x2*)(d + 4 + 2 * lane);
            }
        }
        __builtin_amdgcn_sched_barrier(0);
#pragma unroll
        for (int u = 0; u < 4; ++u) {
            float part = qa[u] * la[u] + qb[u] * lb2[u];
            if (lane < 32) part += qc[u] * kc[u];
            const float sn = wave_sum(part);
            float M = sn;
#pragma unroll
            for (int sp = 0; sp < 4; ++sp) M = fmaxf(M, mi[u][sp]);
            const float wn = ex2(sn - M);
            float L = wn, o0 = wn * ln[u][0], o1 = wn * ln[u][1];
#pragma unroll
            for (int sp = 0; sp < 4; ++sp) {
                const float wt = ex2(mi[u][sp] - M);
                L = fmaf(wt, li[u][sp], L); o0 = fmaf(wt, ov[u][sp][0], o0); o1 = fmaf(wt, ov[u][sp][1], o1);
            }
            const float inv = __builtin_amdgcn_rcpf(L);
            *(unsigned*)(OL + (q0 + u) * 288 + 4 * lane) = pk2(o0 * inv, o1 * inv);
        }
    }
    asm volatile("s_waitcnt lgkmcnt(0)" ::: "memory");
    {
        const __bf16* wuvt = (const __bf16*)(p.ws + WS_WUVT);
        f32x16 mo[2];
#pragma unroll
        for (int vt = 0; vt < 2; ++vt)
#pragma unroll
            for (int r = 0; r < 16; ++r) mo[vt][r] = 0.f;
        bf16x8 ob[8], wa[2][8];
        const int tk = (l31 < 8) ? l31 : 7;
#pragma unroll
        for (int ks = 0; ks < 8; ++ks) {
            ob[ks] = *(const bf16x8*)(OL + tk * 288 + (16 * ks + 8 * hh) * 2);
            wa[0][ks] = *(const bf16x8*)(wuvt + ((size_t)h * 64 + l31) * 128 + 16 * ks + 8 * hh);
            wa[1][ks] = *(const bf16x8*)(wuvt + ((size_t)h * 64 + 32 + l31) * 128 + 16 * ks + 8 * hh);
        }
        __builtin_amdgcn_sched_barrier(0);
#pragma unroll
        for (int ks = 0; ks < 8; ++ks)
#pragma unroll
            for (int vt = 0; vt < 2; ++vt) mo[vt] = mfma32(wa[vt][ks], ob[ks], mo[vt]);
        if (l31 < 8) {
#pragma unroll
            for (int vt = 0; vt < 2; ++vt)
#pragma unroll
                for (int g = 0; g < 4; ++g) {
                    const int v = 32 * vt + 8 * g + 4 * hh;
                    const u32x2 gm = *(const u32x2*)(GM + (size_t)(NTOK + r0 + l31) * 512 + h * 64 + v);
                    *(u32x2*)(AS + (size_t)(r0 + l31) * 1024 + h * 64 + v) =
                        pk4(mo[vt][4 * g] * bflo(gm.x), mo[vt][4 * g + 1] * bfhi(gm.x), mo[vt][4 * g + 2] * bflo(gm.y), mo[vt][4 * g + 3] * bfhi(gm.y));
                }
        }
    }
    {
        const float* GLAOS = (const float*)(p.ws + WS_GLAOS);
        f32x2 ov[4], gn[4]; unsigned gg[4];
#pragma unroll
        for (int u = 0; u < 4; ++u) {
            const int pr = w * 4 + u, t = pr >> 2, hg = pr & 3, bs = r0 + t;
            ov[u] = *(const f32x2*)(GLAOS + ((size_t)bs * 4 + hg) * 128 + 2 * lane);
            gn[u] = *(const f32x2*)(p.gla_norm_g + hg * 128 + 2 * lane);
            gg[u] = *(const unsigned*)(GG + (size_t)(NTOK + bs) * 512 + hg * 128 + 2 * lane);
        }
        __builtin_amdgcn_sched_barrier(0);
#pragma unroll
        for (int u = 0; u < 4; ++u) {
            const int pr = w * 4 + u, t = pr >> 2, hg = pr & 3, bs = r0 + t;
            const float ss = wave_sum(ov[u][0] * ov[u][0] + ov[u][1] * ov[u][1]);
            const float inv = rsqrtf(ss * (1.f / 128.f) + NORM_EPS);
            *(unsigned*)(AS + (size_t)bs * 1024 + 512 + hg * 128 + 2 * lane) = pk2(ov[u][0] * inv * gn[u][0] * bflo(gg[u]), ov[u][1] * inv * gn[u][1] * bfhi(gg[u]));
        }
    }
    __syncthreads();
}
__device__ void p3s_cols(const Params& p, int k, unsigned char* lds) {
    int tid = threadIdx.x; asm volatile("" : "+v"(tid));
    const int lane = tid & 63, w = tid >> 6, l31 = lane & 31, hh = lane >> 5;
    const int nt = w >> 1, mt = w & 1;
    unsigned char* A = lds + LDS_BASE;
    const __bf16* AS = (const __bf16*)(p.ws + WS_AS);
    const u32x4* woutf = (const u32x4*)(p.ws + WS_WOUTF);
    const float* mod = (const float*)(p.ws + WS_MOD);
    float* ST = (float*)(lds + LDS_BASE + 64 * XS);
    float* STATS = (float*)(p.ws + WS_STATS);
#pragma unroll 1
    for (int pass = 0; pass < 2; ++pass) {
        {
            u32x4 t[16];
#pragma unroll
            for (int i = 0; i < 16; ++i) { const int idx = i * NTHR + tid, row = idx >> 7, ch = idx & 127; t[i] = *(const u32x4*)(AS + (size_t)(64 * pass + row) * 1024 + 8 * ch); }
            __builtin_amdgcn_sched_barrier(0);
#pragma unroll
            for (int i = 0; i < 16; ++i) { const int idx = i * NTHR + tid, row = idx >> 7, ch = idx & 127; *(u32x4*)(A + row * XS + ch * 16) = t[i]; }
        }
        __syncthreads();
        f32x16 acc;
#pragma unroll
        for (int r = 0; r < 16; ++r) acc[r] = 0.f;
        const int row = 64 * pass + 32 * mt + l31;
        const int ncol = 128 * k + 32 * nt + 4 * hh;
        f32x4 xv[4], gt[4];
#pragma unroll
        for (int g = 0; g < 4; ++g) { xv[g] = *(const f32x4*)(p.x_sample + (size_t)row * 1024 + ncol + 8 * g); gt[g] = *(const f32x4*)(mod + (size_t)(8 + row) * 3072 + 2048 + ncol + 8 * g); }
        {
            const unsigned char* x0 = A + (32 * mt + l31) * XS + hh * 16;
            const u32x4* w0 = woutf + (size_t)(4 * k + nt) * 64 * 64 + lane;
            u32x4 ra[8];
#pragma unroll
            for (int u = 0; u < 8; ++u) ra[u] = w0[u * 64];
#pragma unroll 1
            for (int k0 = 0; k0 < 64; k0 += 8) {
#pragma unroll
                for (int u = 0; u < 8; ++u) {
                    const int ks = k0 + u;
                    const bf16x8 b0 = *(const bf16x8*)(x0 + ks * 32);
                    const bf16x8 a0 = __builtin_bit_cast(bf16x8, ra[u]);
                    ra[u] = w0[(ks + 8) * 64];
                    __builtin_amdgcn_sched_barrier(0);
                    acc = mfma32(a0, b0, acc);
                    __builtin_amdgcn_sched_barrier(0);
                }
            }
        }
        float s1 = 0.f, s2 = 0.f;
        float* yb = p.out + OUT_YS + (size_t)row * 1024 + ncol;
#pragma unroll
        for (int g = 0; g < 4; ++g) {
            f32x4 v;
#pragma unroll
            for (int i = 0; i < 4; ++i) { v[i] = DN_ALPHA * xv[g][i] + gt[g][i] * acc[4 * g + i]; s1 += v[i]; s2 = fmaf(v[i], v[i], s2); }
            *(f32x4*)(yb + 8 * g) = v;
        }
        s1 += __shfl_xor(s1, 32); s2 += __shfl_xor(s2, 32);
        if (hh == 0) { ST[(w * 32 + l31) * 2] = s1; ST[(w * 32 + l31) * 2 + 1] = s2; }
        __syncthreads();
        if (tid < 64) {
            const int m2 = tid >> 5, tk = tid & 31;
            float a = 0.f, bq = 0.f;
#pragma unroll
            for (int n2 = 0; n2 < 4; ++n2) { a += ST[((2 * n2 + m2) * 32 + tk) * 2]; bq += ST[((2 * n2 + m2) * 32 + tk) * 2 + 1]; }
            STATS[((size_t)k * NDEC + 64 * pass + tid) * 2] = a; STATS[((size_t)k * NDEC + 64 * pass + tid) * 2 + 1] = bq;
        }
        __syncthreads();
    }
}
__device__ void p3s_ln(const Params& p, int k, unsigned char* lds) {
    int tid = threadIdx.x; asm volatile("" : "+v"(tid));
    const int row = 32 * k + (tid >> 4), c0 = (tid & 15) * 64;
    const float* STATS = (const float*)(p.ws + WS_STATS);
    float a = 0.f, bq = 0.f;
#pragma unroll
    for (int j = 0; j < 8; ++j) { a += STATS[((size_t)j * NDEC + row) * 2]; bq += STATS[((size_t)j * NDEC + row) * 2 + 1]; }
    const float mean = a * (1.f / 1024.f);
    const float rstd = rsqrtf(fmaxf(bq * (1.f / 1024.f) - mean * mean, 0.f) + NORM_EPS);
    float* y = p.out + OUT_YS + (size_t)row * 1024 + c0;
    f32x4 v[16];
#pragma unroll
    for (int i = 0; i < 16; ++i) v[i] = *(const f32x4*)(y + 4 * i);
    __builtin_amdgcn_sched_barrier(0);
#pragma unroll
    for (int i = 0; i < 16; ++i) {
        const f32x4 lg = *(const f32x4*)(p.ln_g + c0 + 4 * i), lb = *(const f32x4*)(p.ln_b + c0 + 4 * i);
        f32x4 o;
#pragma unroll
        for (int e = 0; e < 4; ++e) o[e] = (v[i][e] - mean) * rstd * lg[e] + lb[e];
        *(f32x4*)(y + 4 * i) = o;
    }
}

__device__ __forceinline__ int q_next(unsigned* cnt, unsigned char* lds) {
    volatile LAS unsigned* slot = (volatile LAS unsigned*)(lds + 16);
    __syncthreads();
    if (threadIdx.x == 0) *slot = __hip_atomic_fetch_add(cnt, 1u, __ATOMIC_RELAXED, __HIP_MEMORY_SCOPE_AGENT);
    __syncthreads();
    return (int)*slot;
}
__device__ __forceinline__ void signal_done(unsigned* cnt) {
    asm volatile("s_waitcnt vmcnt(0)" ::: "memory");
    __syncthreads();
    if (threadIdx.x == 0) {
        __builtin_amdgcn_fence(__ATOMIC_RELEASE, "agent");
        asm volatile("s_waitcnt vmcnt(0)" ::: "memory");
        (void)__hip_atomic_fetch_add(cnt, 1u, __ATOMIC_RELAXED, __HIP_MEMORY_SCOPE_AGENT);
    }
}
__device__ __forceinline__ void wait_count(unsigned* bar, unsigned* cnt, unsigned want) {
    if (threadIdx.x == 0) {
        XB_SPIN(xb_ld(cnt) < want, bar);
        __builtin_amdgcn_fence(__ATOMIC_ACQUIRE, "agent");
        asm volatile("s_waitcnt vmcnt(0)" ::: "memory");
    }
    __syncthreads();
}

__global__ void __launch_bounds__(NTHR) fwd_mega(Params p, int ph_lo, int ph_hi, int use_bar) {
    extern __shared__ __attribute__((aligned(16))) unsigned char lds[];
    const int tid = threadIdx.x;
    if (use_bar) {
        if (tid == 0) { *(u32x4*)lds = (u32x4){0u, 0u, 0u, 0u}; }
        __syncthreads();
        (void)xcd_barrier_post((unsigned*)(p.ws + WS_CTL), (volatile LAS unsigned*)lds);
    }
    const int G = gridDim.x, bid = blockIdx.x;
    unsigned* ctl = (unsigned*)(p.ws + WS_CTL);
    for (int ph = ph_lo; ph < ph_hi; ++ph) {
        for (int rep = 0; rep < ((ph == REP_PH) ? 2 : 1); ++rep) {
        if (ph == 0) {
            for (int item = bid; item < 96; item += G) p0_mod_item(p, item, lds);
            p0_convert(p);
        } else if (ph == 1 || ph == 2) {
            bool sample_ok = false;
            int local = 0;
            for (;;) {
                int kind, a0, a1;
                if (ph == 1) { a0 = bid + local * G; ++local; if (a0 >= 256) break; kind = 0; a1 = 0; }
                else {
                    const int i = q_next(ctl + CW_Q2 + 16 * rep, lds);
                    if (i >= 1194) break;
                    if (i < 2) { kind = 0; a0 = 256 + i; a1 = 1; }
                    else if (i < 10) { kind = 0; a0 = 256 + ((i - 2) >> 2); a1 = 2 + ((i - 2) & 3); }
                    else if (i < 42) { kind = 1; a0 = i - 10; a1 = 0; }
                    else if (i < 234) { kind = 2; a0 = (i - 42) & 63; a1 = 7 - ((i - 42) >> 6); }
                    else if (i < 362) { kind = 3; a0 = i - 234; a1 = 0; }
                    else { const int g = (i - 362) / 13, r = (i - 362) - 13 * g;
                        const int na = (r > 2) + (r > 4) + (r > 7) + (r > 9);
                        if (r == 2 || r == 4 || r == 7 || r == 9 || r == 12) { const int ai = 5 * g + na; kind = 2; a0 = ai & 63; a1 = 4 - (ai >> 6); }
                        else { const int d = 8 * g + (r - na); kind = 4; a0 = d >> 2; a1 = d & 3; } }
                }
                if (kind >= 3 && !sample_ok) { wait_count(ctl, ctl + CW_SAMPLE, 10u * (rep + 1)); sample_ok = true; }
                if (kind == 0) { p1_stripe(p, a0, a1, lds); if (ph == 2) signal_done(ctl + CW_SAMPLE); }
                else if (kind == 1) p2_scan(p, a0);
                else if (kind == 2) p2_attn(p, a0, a1, lds);
                else if (kind == 3) p2_glarec(p, a0, lds);
                else p2_decode(p, a0, a1, lds);
            }
        } else {
            for (;;) {
                const int qi = q_next(ctl + CW_Q3 + 16 * rep, lds);
                if (qi >= 540) break;
                if (qi < 16) { p3s_arows(p, qi, lds); signal_done(ctl + CW_AS); }
                else if (qi < 272) p3_stripe(p, qi - 16, lds);
                else if (qi < 280) { wait_count(ctl, ctl + CW_AS, 16u * (rep + 1)); p3s_cols(p, qi - 272, lds); signal_done(ctl + CW_COL); }
                else if (qi < 536) p3_stripe(p, qi - 280 + 256, lds);
                else { wait_count(ctl, ctl + CW_COL, 8u * (rep + 1)); p3s_ln(p, qi - 536, lds); }
            }
        }
        }
        if (use_bar && ph + 1 < ph_hi) {
            XcdBarrier xb; xb.bar = (unsigned*)(p.ws + WS_CTL); xb.x = xb_xcc_id(); xb.st = (volatile LAS unsigned*)lds;
            xcd_barrier(xb);
        }
    }
}


extern "C" void kernel_launch(void* const* d_in, const int* in_sizes, int n_in, void* d_out, int out_size, void* d_ws, size_t ws_size, hipStream_t stream) {
    static int grid = 0;
    if (grid == 0) {
        if (n_in != 22 || (size_t)out_size != OUT_END || ws_size < WS_END) { fprintf(stderr, "kernel_launch: unexpected shapes (n_in %d out %d ws %zu)\n", n_in, out_size, ws_size); grid = -1; return; }
        int dev = 0, cus = 0, per_cu = 0;
        if (hipGetDevice(&dev) != hipSuccess || hipDeviceGetAttribute(&cus, hipDeviceAttributeMultiprocessorCount, dev) != hipSuccess) { grid = -1; return; }
        if (hipFuncSetAttribute((const void*)fwd_mega, hipFuncAttributeMaxDynamicSharedMemorySize, LDS_BYTES) != hipSuccess) { fprintf(stderr, "kernel_launch: hipFuncSetAttribute failed\n"); grid = -1; return; }
        if (hipOccupancyMaxActiveBlocksPerMultiprocessor(&per_cu, (const void*)fwd_mega, NTHR, LDS_BYTES) != hipSuccess || per_cu < 1) { fprintf(stderr, "kernel_launch: occupancy query says %d\n", per_cu); grid = -1; return; }
        (void)hipGetLastError();
        grid = cus;
    }
    if (grid < 0) return;
    Params p{};
    p.x_prompt = (const float*)d_in[0]; p.x_sample = (const float*)d_in[1]; p.cache_lat = (const float*)d_in[2]; p.cache_kr = (const float*)d_in[3];
    p.state_gla = (const float*)d_in[4]; p.page_table = (const int*)d_in[5]; p.c_prompt = (const float*)d_in[6]; p.c_sample = (const float*)d_in[7];
    p.w_ada = (const float*)d_in[8]; p.b_ada = (const float*)d_in[9]; p.w_in = (const float*)d_in[10]; p.q_norm_g = (const float*)d_in[11];
    p.w_uq = (const float*)d_in[12]; p.kv_norm_g = (const float*)d_in[13]; p.w_uk = (const float*)d_in[14]; p.w_uv = (const float*)d_in[15];
    p.w_gate_up = (const float*)d_in[16]; p.b_gate = (const float*)d_in[17]; p.gla_norm_g = (const float*)d_in[18]; p.w_out = (const float*)d_in[19];
    p.ln_g = (const float*)d_in[20]; p.ln_b = (const float*)d_in[21];
    p.out = (float*)d_out; p.ws = (unsigned char*)d_ws;
    if (hipMemsetAsync((char*)d_ws + WS_CTL, 0, CTL_BYTES, stream) != hipSuccess) { fprintf(stderr, "kernel_launch: memset failed\n"); return; }
#if N_LAUNCHES == 1
    hipLaunchKernelGGL(fwd_mega, dim3(grid), dim3(NTHR), LDS_BYTES, stream, p, 0, 4, 1);
#else
    for (int ph = 0; ph < 4; ++ph) hipLaunchKernelGGL(fwd_mega, dim3(grid), dim3(NTHR), LDS_BYTES, stream, p, ph, ph + 1, 0);
#endif
    const hipError_t le = hipPeekAtLastError();
    if (le != hipSuccess) fprintf(stderr, "kernel_launch: launch failed: %s\n", hipGetErrorName(le));
}
```

```cpp
#include <hip/hip_runtime.h>
#include <cstdint>
#include <cstdio>

typedef __bf16 bf16x8 __attribute__((ext_vector_type(8)));
typedef __bf16 bf16x4 __attribute__((ext_vector_type(4)));
typedef __bf16 bf16x2 __attribute__((ext_vector_type(2)));
typedef float f32x16 __attribute__((ext_vector_type(16)));
typedef float f32x4 __attribute__((ext_vector_type(4)));
typedef float f32x2 __attribute__((ext_vector_type(2)));
typedef unsigned u32x4 __attribute__((ext_vector_type(4)));
typedef unsigned u32x2 __attribute__((ext_vector_type(2)));

#define NTHR 512
#define N_LAUNCHES 1
#define REP_PH (-1)
#ifndef ND_CU8
#define ND_CU8 12
#endif
#define LDS_BYTES 143360
#define LDS_BASE 256

constexpr int DM = 1024, SEQ = 2048, NB = 8, NTOK = 16384, NDEC = 128, RT = NTOK + NDEC;
constexpr int NPAGES = 64;
constexpr float NORM_EPS = 1e-6f;
constexpr float LOG2E = 1.4426950408889634f;
constexpr float QSCALE = 0.10206207261596577f * 1.4426950408889634f;
constexpr float DN_ALPHA = 1.189207115002721f;

constexpr size_t OUT_YP = 0;
constexpr size_t OUT_YS = OUT_YP + (size_t)NTOK * 1024;
constexpr size_t OUT_LATP = OUT_YS + (size_t)NDEC * 1024;
constexpr size_t OUT_KRP = OUT_LATP + (size_t)NTOK * 128;
constexpr size_t OUT_STP = OUT_KRP + (size_t)NTOK * 32;
constexpr size_t OUT_LATS = OUT_STP + (size_t)NB * 4 * 64 * 128;
constexpr size_t OUT_KRS = OUT_LATS + (size_t)NDEC * 128;
constexpr size_t OUT_STS = OUT_KRS + (size_t)NDEC * 32;
constexpr size_t OUT_END = OUT_STS + (size_t)NDEC * 4 * 64 * 128;

constexpr size_t al256(size_t x) { return (x + 255) & ~(size_t)255; }
constexpr size_t WS_CTL = 0;
constexpr size_t CTL_BYTES = 16384;
constexpr size_t WS_MOD = WS_CTL + CTL_BYTES;
constexpr size_t WS_ROPE = WS_MOD + al256((size_t)136 * 3072 * 4);
constexpr size_t WS_WINF = WS_ROPE + al256((size_t)2049 * 32 * 4);
constexpr size_t WS_WUQF = WS_WINF + (size_t)78 * 64 * 1024;
constexpr size_t WS_WKVF = WS_WUQF + (size_t)24 * 16 * 1024;
constexpr size_t WS_WOUTF = WS_WKVF + (size_t)32 * 8 * 1024;
constexpr size_t WS_WUKB = WS_WOUTF + (size_t)32 * 64 * 1024;
constexpr size_t WS_WUVT = WS_WUKB + (size_t)65536 * 2;
constexpr size_t WS_GM = WS_WUVT + (size_t)65536 * 2;
constexpr size_t WS_GQ = WS_GM + al256((size_t)RT * 512 * 2);
constexpr size_t WS_GK = WS_GQ + al256((size_t)RT * 256 * 2);
constexpr size_t WS_GV = WS_GK + al256((size_t)RT * 256 * 2);
constexpr size_t WS_GG = WS_GV + al256((size_t)RT * 512 * 2);
constexpr size_t WS_LAB = WS_GG + al256((size_t)RT * 512 * 2);
constexpr size_t WS_BT = WS_LAB + al256((size_t)RT * 256 * 4);
constexpr size_t WS_GKT = WS_BT + (size_t)NB * 4 * 64 * 2048 * 4;
constexpr size_t WS_GVT = WS_GKT + (size_t)NB * 4 * 64 * 2048 * 2;
constexpr size_t WS_Q = WS_GVT + (size_t)NB * 4 * 128 * 2048 * 2;
constexpr size_t WS_KN = WS_Q + (size_t)NB * 8 * 2048 * 96 * 2;
constexpr size_t WS_KR = WS_KN + (size_t)NB * 8 * 2048 * 64 * 2;
constexpr size_t WS_VT = WS_KR + (size_t)NB * 2048 * 32 * 2;
constexpr size_t WS_AO = WS_VT + (size_t)NB * 8 * 64 * 2048 * 2;
constexpr size_t WS_ST2 = WS_AO + (size_t)NTOK * 512 * 2;
constexpr size_t WS_BL = WS_ST2 + (size_t)NB * 4 * 32 * 128 * 64 * 2;
constexpr size_t WS_QLR = WS_BL + (size_t)NB * 4 * 32 * 64 * 4;
constexpr size_t WS_DPART = WS_QLR + al256((size_t)NDEC * 8 * 160 * 2);
constexpr size_t WS_GLAOS = WS_DPART + al256((size_t)NDEC * 4 * 8 * 132 * 4);
constexpr size_t WS_OLAT = WS_GLAOS + al256((size_t)NDEC * 4 * 128 * 4);
constexpr size_t WS_AS = WS_OLAT + al256((size_t)NDEC * 8 * 128 * 2);
constexpr size_t WS_STATS = WS_AS + (size_t)NDEC * 1024 * 2;
constexpr size_t WS_END = WS_STATS + (size_t)8 * NDEC * 2 * 4;

struct Params {
    const float* x_prompt; const float* x_sample; const float* cache_lat; const float* cache_kr; const float* state_gla;
    const int* page_table; const float* c_prompt; const float* c_sample;
    const float* w_ada; const float* b_ada; const float* w_in; const float* q_norm_g; const float* w_uq; const float* kv_norm_g;
    const float* w_uk; const float* w_uv; const float* w_gate_up; const float* b_gate; const float* gla_norm_g;
    const float* w_out; const float* ln_g; const float* ln_b;
    float* out; unsigned char* ws;
};

__device__ __forceinline__ f32x16 mfma32(bf16x8 a, bf16x8 b, f32x16 c) { return __builtin_amdgcn_mfma_f32_32x32x16_bf16(a, b, c, 0, 0, 0); }
__device__ __forceinline__ unsigned pk2(float lo, float hi) { bf16x2 v = {(__bf16)lo, (__bf16)hi}; return __builtin_bit_cast(unsigned, v); }
__device__ __forceinline__ u32x2 pk4(float a, float b, float c, float d) { u32x2 r; r.x = pk2(a, b); r.y = pk2(c, d); return r; }
__device__ __forceinline__ float bflo(unsigned u) { return __builtin_bit_cast(float, u << 16); }
__device__ __forceinline__ float bfhi(unsigned u) { return __builtin_bit_cast(float, u & 0xffff0000u); }
__device__ __forceinline__ float siluf(float x) { return x * __builtin_amdgcn_rcpf(1.f + __expf(-x)); }
__device__ __forceinline__ float ex2(float x) { return __builtin_amdgcn_exp2f(x); }
__device__ __forceinline__ float wave_sum(float v) {
#pragma unroll
    for (int o = 1; o < 64; o <<= 1) v += __shfl_xor(v, o);
    return v;
}
__device__ __forceinline__ bf16x8 cvt8(f32x4 a, f32x4 b) {
    bf16x8 r; r[0] = (__bf16)a[0]; r[1] = (__bf16)a[1]; r[2] = (__bf16)a[2]; r[3] = (__bf16)a[3]; r[4] = (__bf16)b[0]; r[5] = (__bf16)b[1]; r[6] = (__bf16)b[2]; r[7] = (__bf16)b[3]; return r;
}
__device__ __forceinline__ void unpack8(u32x4 u, float (&f)[8]) {
    f[0] = bflo(u.x); f[1] = bfhi(u.x); f[2] = bflo(u.y); f[3] = bfhi(u.y); f[4] = bflo(u.z); f[5] = bfhi(u.z); f[6] = bflo(u.w); f[7] = bfhi(u.w);
}
__device__ __forceinline__ int permpos(int s) { return (s & ~12) | ((s & 4) << 1) | ((s & 8) >> 1); }

#define XB_TMO      128
#define XB_XCNT(j)  (256  + 64 * (j))
#define XB_XSUB(j)  (1280 + 64 * (j))
#define XB_XGEN(j)  (2304 + 64 * (j))
#define XB_TOP      3328
#define XB_TOPGEN   3392
#define XCD_BAR_WORDS 3456
#define CW_Q2 3520
#define CW_Q3 3584
#define CW_SAMPLE 3648
#define CW_AS 3712
#define CW_COL 3776
#define CW_B0 3840
#define CW_B17 3904
#define XB_SPIN_CAP (1u << 22)
#define LAS __attribute__((address_space(3)))
__device__ __forceinline__ unsigned xb_ld(unsigned* p)              { return __hip_atomic_load(p, __ATOMIC_RELAXED, __HIP_MEMORY_SCOPE_AGENT); }
__device__ __forceinline__ unsigned xb_add(unsigned* p, unsigned v) { return __hip_atomic_fetch_add(p, v, __ATOMIC_RELAXED, __HIP_MEMORY_SCOPE_AGENT); }
__device__ __forceinline__ unsigned xb_xcc_id() { return (unsigned)__builtin_amdgcn_s_getreg((3 << 11) | 20) & 0xFu; }
#define XB_SPIN(cond, bar) do { unsigned _sp = 0; while (cond) { __builtin_amdgcn_s_sleep(1); \
    if ((++_sp & 255u) == 0u) { if (xb_ld(&(bar)[XB_TMO])) break; if (_sp > XB_SPIN_CAP) { atomicAdd(&(bar)[XB_TMO], 1u); break; } } } } while (0)
struct XcdBarrier { unsigned* bar; unsigned x; volatile LAS unsigned* st; };
__device__ __forceinline__ XcdBarrier xcd_barrier_post(unsigned* bar, volatile LAS unsigned* st) {
    XcdBarrier b; b.bar = bar; b.x = xb_xcc_id(); b.st = st;
    if (threadIdx.x == 0) (void)xb_add(&bar[XB_XCNT(b.x)], 1u);
    return b;
}
__device__ __forceinline__ void xcd_barrier_complete(unsigned* bar, unsigned x, unsigned& nloc, unsigned& nx) {
    const unsigned G = gridDim.x * gridDim.y * gridDim.z;
    unsigned sum, cnt, mine, sp = 0u;
    for (;;) {
        sum = 0u; cnt = 0u; mine = 0u;
#pragma unroll
        for (unsigned j = 0; j < 16; ++j) { const unsigned c = xb_ld(&bar[XB_XCNT(j)]); sum += c; cnt += (c > 0u) ? 1u : 0u; mine = (j == x) ? c : mine; }
        if (sum == G) break;
        __builtin_amdgcn_s_sleep(1);
        if ((++sp & 255u) == 0u) { if (xb_ld(&bar[XB_TMO])) break; if (sp > XB_SPIN_CAP) { atomicAdd(&bar[XB_TMO], 1u); break; } }
    }
    nloc = mine > 0u ? mine : 1u; nx = cnt > 0u ? cnt : 1u;
}
__device__ __forceinline__ void xcd_barrier(const XcdBarrier& b) {
    asm volatile("s_waitcnt vmcnt(0)" ::: "memory");
    __syncthreads();
    if (threadIdx.x == 0) {
        unsigned* bar = b.bar;
        __builtin_amdgcn_s_waitcnt(0);
        unsigned nloc = b.st[0], nx = b.st[1];
        if (nloc == 0u) { xcd_barrier_complete(bar, b.x, nloc, nx); b.st[0] = nloc; b.st[1] = nx; }
        const unsigned old = xb_add(&bar[XB_XSUB(b.x)], 1u);
        const unsigned gen = old / nloc;
        if (old + 1u == (gen + 1u) * nloc) {
            __builtin_amdgcn_fence(__ATOMIC_RELEASE, "agent");
            asm volatile("s_waitcnt vmcnt(0)" ::: "memory");
            const unsigned og = xb_add(&bar[XB_TOP], 1u);
            const unsigned tg = og / nx;
            if (og + 1u == (tg + 1u) * nx) xb_add(&bar[XB_TOPGEN], 1u);
            else XB_SPIN(xb_ld(&bar[XB_TOPGEN]) == tg, bar);
            __builtin_amdgcn_fence(__ATOMIC_ACQUIRE, "agent");
            xb_add(&bar[XB_XGEN(b.x)], 1u);
            asm volatile("s_waitcnt vmcnt(0)" ::: "memory");
        } else {
            XB_SPIN(xb_ld(&bar[XB_XGEN(b.x)]) == gen, bar);
            __builtin_amdgcn_fence(__ATOMIC_ACQUIRE, "agent");
            asm volatile("s_waitcnt vmcnt(0)" ::: "memory");
        }
    }
    __syncthreads();
}

template <int KS, bool SW>
__device__ __forceinline__ void gemm_2x2(const u32x4* __restrict__ wf, const unsigned char* xl, int xstride, int lane, f32x16 (&acc)[2][2]) {
    constexpr int PF = 8;
    static_assert(KS % PF == 0, "KS must be a multiple of the prefetch depth");
    const int l31 = lane & 31, hh = lane >> 5;
    const unsigned char* x0 = xl + l31 * xstride + hh * 16;
    const unsigned char* x1 = x0 + 32 * xstride;
    const u32x4* w0 = wf + lane;
    const u32x4* w1 = wf + KS * 64 + lane;
    u32x4 ra[PF], rb[PF];
#pragma unroll
    for (int u = 0; u < PF; ++u) { ra[u] = w0[u * 64]; rb[u] = w1[u * 64]; }
#pragma unroll 1
    for (int k0 = 0; k0 < KS; k0 += PF) {
#pragma unroll
        for (int u = 0; u < PF; ++u) {
            const int ks = k0 + u;
            const bf16x8 b0 = *(const bf16x8*)(x0 + ks * 32);
            const bf16x8 b1 = *(const bf16x8*)(x1 + ks * 32);
            const bf16x8 a0 = __builtin_bit_cast(bf16x8, ra[u]);
            const bf16x8 a1 = __builtin_bit_cast(bf16x8, rb[u]);
            if (KS > PF) { ra[u] = w0[(ks + PF) * 64]; rb[u] = w1[(ks + PF) * 64]; }
            __builtin_amdgcn_sched_barrier(0);
            if (SW) {
                acc[0][0] = mfma32(a0, b0, acc[0][0]); acc[0][1] = mfma32(a0, b1, acc[0][1]);
                acc[1][0] = mfma32(a1, b0, acc[1][0]); acc[1][1] = mfma32(a1, b1, acc[1][1]);
            } else {
                acc[0][0] = mfma32(b0, a0, acc[0][0]); acc[0][1] = mfma32(b1, a0, acc[0][1]);
                acc[1][0] = mfma32(b0, a1, acc[1][0]); acc[1][1] = mfma32(b1, a1, acc[1][1]);
            }
            __builtin_amdgcn_sched_barrier(0);
        }
    }
}
constexpr int GPF = 8;
template <int KS, bool SW>
__device__ __forceinline__ void gemm_2x2_stream(const u32x4* __restrict__ wf, const u32x4* __restrict__ wfn, bool fill, const unsigned char* xl, int xstride, int lane,
                                                f32x16 (&acc)[2][2], u32x4 (&ra)[GPF], u32x4 (&rb)[GPF]) {
    static_assert(KS % GPF == 0 && KS >= 2 * GPF, "KS must be a multiple of (and larger than) the prefetch depth");
    const int l31 = lane & 31, hh = lane >> 5;
    const unsigned char* x0 = xl + l31 * xstride + hh * 16;
    const unsigned char* x1 = x0 + 32 * xstride;
    const u32x4* w0 = wf + lane;
    const u32x4* w1 = wf + KS * 64 + lane;
    if (fill) {
#pragma unroll
        for (int u = 0; u < GPF; ++u) { ra[u] = w0[u * 64]; rb[u] = w1[u * 64]; }
    }
    bf16x8 b0 = *(const bf16x8*)(x0), b1 = *(const bf16x8*)(x1);
#pragma unroll 1
    for (int k0 = 0; k0 < KS; k0 += GPF) {
        const bool last = (k0 + GPF >= KS);
        const u32x4* n0 = last ? (wfn + lane) : (w0 + (k0 + GPF) * 64);
        const u32x4* n1 = last ? (wfn + KS * 64 + lane) : (w1 + (k0 + GPF) * 64);
#pragma unroll
        for (int u = 0; u < GPF; ++u) {
            const int ks = k0 + u;
            const bf16x8 nb0 = *(const bf16x8*)(x0 + (ks + 1) * 32);
            const bf16x8 nb1 = *(const bf16x8*)(x1 + (ks + 1) * 32);
            const bf16x8 a0 = __builtin_bit_cast(bf16x8, ra[u]);
            const bf16x8 a1 = __builtin_bit_cast(bf16x8, rb[u]);
            ra[u] = n0[u * 64]; rb[u] = n1[u * 64];
            __builtin_amdgcn_sched_barrier(0);
            if (SW) {
                acc[0][0] = mfma32(a0, b0, acc[0][0]); acc[0][1] = mfma32(a0, b1, acc[0][1]);
                acc[1][0] = mfma32(a1, b0, acc[1][0]); acc[1][1] = mfma32(a1, b1, acc[1][1]);
            } else {
                acc[0][0] = mfma32(b0, a0, acc[0][0]); acc[0][1] = mfma32(b1, a0, acc[0][1]);
                acc[1][0] = mfma32(b0, a1, acc[1][0]); acc[1][1] = mfma32(b1, a1, acc[1][1]);
            }
            __builtin_amdgcn_sched_barrier(0);
            b0 = nb0; b1 = nb1;
        }
    }
}
__device__ __forceinline__ void zero_acc(f32x16 (&acc)[2][2]) {
#pragma unroll
    for (int a = 0; a < 2; ++a)
#pragma unroll
        for (int b = 0; b < 2; ++b)
#pragma unroll
            for (int r = 0; r < 16; ++r) acc[a][b][r] = 0.f;
}
template <int MODE>
__device__ __forceinline__ void store_nat(const f32x16 (&acc)[2][2], __bf16* dst, int ld, int col0, int lane) {
    const int l31 = lane & 31, hh = lane >> 5;
#pragma unroll
    for (int nt = 0; nt < 2; ++nt)
#pragma unroll
        for (int mt = 0; mt < 2; ++mt)
#pragma unroll
            for (int g = 0; g < 4; ++g) {
                float v[4];
#pragma unroll
                for (int i = 0; i < 4; ++i) {
                    float t = acc[nt][mt][4 * g + i];
                    if (MODE == 1) t = siluf(t);
                    if (MODE == 2) t *= 0.125f;
                    if (MODE == 3) t *= QSCALE;
                    v[i] = t;
                }
                *(u32x2*)(dst + (size_t)(32 * mt + l31) * ld + col0 + 32 * nt + 8 * g + 4 * hh) = pk4(v[0], v[1], v[2], v[3]);
            }
}
__device__ __forceinline__ void store_tr(const f32x16 (&acc)[2][2], __bf16* dst, int group, int NT, int rowtile0, int s0, int lane) {
#pragma unroll
    for (int nt = 0; nt < 2; ++nt)
#pragma unroll
        for (int mt = 0; mt < 2; ++mt)
#pragma unroll
            for (int g = 0; g < 4; ++g) {
                const int k16 = (s0 >> 4) + 2 * mt + (g >> 1);
                *(u32x2*)(dst + ((((size_t)group * 128 + k16) * NT + rowtile0 + nt) * 64 + lane) * 8 + 4 * (g & 1)) =
                    pk4(acc[nt][mt][4 * g], acc[nt][mt][4 * g + 1], acc[nt][mt][4 * g + 2], acc[nt][mt][4 * g + 3]);
            }
}

__device__ __forceinline__ int win_col(int np) {
    if (np < 384) return np;
    if (np < 896) return 416 + (np - 384);
    if (np < 1152) return 928 + (np - 896);
    if (np < 1408) return 1184 + (np - 1152);
    if (np < 1920) return 1440 + (np - 1408);
    if (np < 2432) return 1968 + (np - 1920);
    if (np < 2464) return 384 + (np - 2432);
    if (np < 2480) return 1952 + (np - 2464);
    return -1;
}
__device__ void p0_mod_item(const Params& p, int item, unsigned char* lds) {
    int tid = threadIdx.x; asm volatile("" : "+v"(tid));
    const int lane = tid & 63, w = tid >> 6, l31 = lane & 31, hh = lane >> 5;
    const int n0 = item * 32;
    float* mod = (float*)(p.ws + WS_MOD);
    f32x16 acc[5];
#pragma unroll
    for (int m = 0; m < 5; ++m)
#pragma unroll
        for (int r = 0; r < 16; ++r) acc[m][r] = 0.f;
    float aN[8]; f32x4 c0N[5], c1N[5];
    const float* cp[5];
#pragma unroll
    for (int m = 0; m < 5; ++m) { const int row = min(32 * m + l31, 135); cp[m] = (row < 8) ? (p.c_prompt + (size_t)row * 1024) : (p.c_sample + (size_t)(row - 8) * 1024); }
#define MOD_LOAD(k8_) do { const int k0_ = 16 * (8 * w + (k8_)) + 8 * hh; \
        _Pragma("unroll") for (int j = 0; j < 8; ++j) aN[j] = p.w_ada[(size_t)(k0_ + j) * 3072 + n0 + l31]; \
        _Pragma("unroll") for (int m = 0; m < 5; ++m) { c0N[m] = *(const f32x4*)(cp[m] + k0_); c1N[m] = *(const f32x4*)(cp[m] + k0_ + 4); } } while (0)
    MOD_LOAD(0);
#pragma unroll 1
    for (int k8 = 0; k8 < 8; ++k8) {
        float aC[8]; f32x4 c0C[5], c1C[5];
#pragma unroll
        for (int j = 0; j < 8; ++j) aC[j] = aN[j];
#pragma unroll
        for (int m = 0; m < 5; ++m) { c0C[m] = c0N[m]; c1C[m] = c1N[m]; }
        MOD_LOAD(k8 < 7 ? k8 + 1 : 7);
        __builtin_amdgcn_sched_barrier(0);
        bf16x8 a;
#pragma unroll
        for (int j = 0; j < 8; ++j) a[j] = (__bf16)aC[j];
#pragma unroll
        for (int m = 0; m < 5; ++m) {
            bf16x8 bq;
            const bool live = (32 * m + l31) < 136;
#pragma unroll
            for (int j = 0; j < 4; ++j) { bq[j] = (__bf16)(live ? siluf(c0C[m][j]) : 0.f); bq[4 + j] = (__bf16)(live ? siluf(c1C[m][j]) : 0.f); }
            acc[m] = mfma32(a, bq, acc[m]);
        }
        __builtin_amdgcn_sched_barrier(0);
    }
#undef MOD_LOAD
    float* red = (float*)(lds + LDS_BASE);
#pragma unroll
    for (int m = 0; m < 5; ++m) {
#pragma unroll
        for (int r = 0; r < 16; ++r) red[(w * 16 + r) * 64 + lane] = acc[m][r];
        __syncthreads();
#pragma unroll
        for (int q = 0; q < 2; ++q) {
            const int o = tid + 512 * q, r = o >> 6, ln = o & 63;
            float s = 0.f;
#pragma unroll
            for (int ww = 0; ww < 8; ++ww) s += red[(ww * 16 + r) * 64 + ln];
            const int n = n0 + (r & 3) + 8 * (r >> 2) + 4 * (ln >> 5), row = 32 * m + (ln & 31);
            if (row < 136) mod[(size_t)row * 3072 + n] = s + p.b_ada[n];
        }
        __syncthreads();
    }
}
__device__ void p0_convert(const Params& p) {
    int tid0 = threadIdx.x; asm volatile("" : "+v"(tid0));
    const int nmod = (gridDim.x > 128) ? 96 : 0;
    if ((int)blockIdx.x < nmod) return;
    const int gt = ((int)blockIdx.x - nmod) * NTHR + tid0, GT = ((int)gridDim.x - nmod) * NTHR;
    u32x4* winf = (u32x4*)(p.ws + WS_WINF);
    for (int idx = gt; idx < 78 * 64 * 64; idx += GT) {
        const int lane = idx & 63, fk = idx >> 6, ks = fk & 63, nt = fk >> 6;
        const int col = win_col(nt * 32 + (lane & 31)), k0 = ks * 16 + 8 * (lane >> 5);
        float v[8];
#pragma unroll
        for (int j = 0; j < 8; ++j) v[j] = (col >= 0) ? p.w_in[(size_t)(k0 + j) * 2480 + col] : 0.f;
        u32x4 o; o.x = pk2(v[0], v[1]); o.y = pk2(v[2], v[3]); o.z = pk2(v[4], v[5]); o.w = pk2(v[6], v[7]);
        winf[idx] = o;
    }
    u32x4* wuqf = (u32x4*)(p.ws + WS_WUQF);
    for (int idx = gt; idx < 24 * 16 * 64; idx += GT) {
        const int lane = idx & 63, fk = idx >> 6, ks = fk & 15, nt = fk >> 4;
        const int n = nt * 32 + (lane & 31), k0 = ks * 16 + 8 * (lane >> 5);
        float v[8];
#pragma unroll
        for (int j = 0; j < 8; ++j) v[j] = p.w_uq[(size_t)(k0 + j) * 768 + n];
        u32x4 o; o.x = pk2(v[0], v[1]); o.y = pk2(v[2], v[3]); o.z = pk2(v[4], v[5]); o.w = pk2(v[6], v[7]);
        wuqf[idx] = o;
    }
    u32x4* wkvf = (u32x4*)(p.ws + WS_WKVF);
    for (int idx = gt; idx < 32 * 8 * 64; idx += GT) {
        const int lane = idx & 63, fk = idx >> 6, ks = fk & 7, nt = fk >> 3;
        const int n = nt * 32 + (lane & 31), k0 = ks * 16 + 8 * (lane >> 5);
        float v[8];
#pragma unroll
        for (int j = 0; j < 8; ++j) v[j] = (n < 512) ? p.w_uk[(size_t)(k0 + j) * 512 + n] : p.w_uv[(size_t)(k0 + j) * 512 + (n - 512)];
        u32x4 o; o.x = pk2(v[0], v[1]); o.y = pk2(v[2], v[3]); o.z = pk2(v[4], v[5]); o.w = pk2(v[6], v[7]);
        wkvf[idx] = o;
    }
    u32x4* woutf = (u32x4*)(p.ws + WS_WOUTF);
    for (int idx = gt; idx < 32 * 64 * 64; idx += GT) {
        const int lane = idx & 63, fk = idx >> 6, ks = fk & 63, nt = fk >> 6;
        const int n = nt * 32 + (lane & 31), k0 = ks * 16 + 8 * (lane >> 5);
        float v[8];
#pragma unroll
        for (int j = 0; j < 8; ++j) v[j] = p.w_out[(size_t)(k0 + j) * 1024 + n];
        u32x4 o; o.x = pk2(v[0], v[1]); o.y = pk2(v[2], v[3]); o.z = pk2(v[4], v[5]); o.w = pk2(v[6], v[7]);
        woutf[idx] = o;
    }
    __bf16* wukb = (__bf16*)(p.ws + WS_WUKB);
    __bf16* wuvt = (__bf16*)(p.ws + WS_WUVT);
    for (int idx = gt; idx < 65536; idx += GT) {
        wukb[idx] = (__bf16)p.w_uk[idx];
        const int r = idx & 127, v = (idx >> 7) & 63, h = idx >> 13;
        wuvt[idx] = (__bf16)p.w_uv[(size_t)r * 512 + h * 64 + v];
    }
    float* rope = (float*)(p.ws + WS_ROPE);
    for (int idx = gt; idx < 2049 * 16; idx += GT) {
        const int pi = idx >> 4, i = idx & 15;
        const float pos = (pi == 2048) ? 8192.f : (float)pi;
        const float inv = __builtin_amdgcn_exp2f(-(float)(2 * i) * (13.287712379549449f / 32.f));
        const double rev = (double)(pos * inv) * 0.15915494309189535;
        const float fr = (float)(rev - floor(rev));
        const float s = __builtin_amdgcn_sinf(fr), c = __builtin_amdgcn_cosf(fr);
        rope[pi * 32 + i] = c; rope[pi * 32 + 16 + i] = s;
    }
}

constexpr int XS = 2064;
constexpr int ZS = 1808;

__device__ __forceinline__ void p1_post(const Params& p, int it, unsigned char* lds);
__device__ void p1_stripe(const Params& p, int it, int mode, unsigned char* lds) {
    int tid = threadIdx.x; asm volatile("" : "+v"(tid));
    const int lane = tid & 63, w = tid >> 6, l31 = lane & 31, hh = lane >> 5;
    const bool is_s = it >= 256;
    const int srow0 = is_s ? (it - 256) * 64 : 0;
    const int tok0 = is_s ? NTOK + srow0 : it * 64;
    const int b = it >> 5, s0 = (it & 31) * 64;
    unsigned char* A = lds + LDS_BASE;
    const float* mod = (const float*)(p.ws + WS_MOD);
    const float* rope = (const float*)(p.ws + WS_ROPE);
    {
        const int c4 = tid & 255, rb = tid >> 8;
        if (!is_s) {
            const f32x4 sh = *(const f32x4*)(mod + (size_t)b * 3072 + 4 * c4);
            const f32x4 sc = *(const f32x4*)(mod + (size_t)b * 3072 + 1024 + 4 * c4);
            const float* xr = p.x_prompt + (size_t)(it * 64 + rb) * 1024 + 4 * c4;
            {
                f32x4 x[32];
#pragma unroll
                for (int u = 0; u < 32; ++u) x[u] = *(const f32x4*)(xr + (size_t)u * 2048);
                __builtin_amdgcn_sched_barrier(0);
#pragma unroll
                for (int u = 0; u < 32; ++u)
                    *(u32x2*)(A + (2 * u + rb) * XS + c4 * 8) = pk4(x[u][0] * (1.f + sc[0]) + sh[0], x[u][1] * (1.f + sc[1]) + sh[1], x[u][2] * (1.f + sc[2]) + sh[2], x[u][3] * (1.f + sc[3]) + sh[3]);
            }
        } else {
#pragma unroll 1
            for (int i0 = 0; i0 < 32; i0 += 4) {
                f32x4 x[4], sh[4], sc[4];
#pragma unroll
                for (int u = 0; u < 4; ++u) {
                    const int row = 2 * (i0 + u) + rb;
                    x[u] = *(const f32x4*)(p.x_sample + (size_t)(srow0 + row) * 1024 + 4 * c4);
                    sh[u] = *(const f32x4*)(mod + (size_t)(8 + srow0 + row) * 3072 + 4 * c4);
                    sc[u] = *(const f32x4*)(mod + (size_t)(8 + srow0 + row) * 3072 + 1024 + 4 * c4);
                }
                __builtin_amdgcn_sched_barrier(0);
#pragma unroll
                for (int u = 0; u < 4; ++u)
                    *(u32x2*)(A + (2 * (i0 + u) + rb) * XS + c4 * 8) = pk4(x[u][0] * (1.f + sc[u][0]) + sh[u][0], x[u][1] * (1.f + sc[u][1]) + sh[u][1], x[u][2] * (1.f + sc[u][2]) + sh[u][2], x[u][3] * (1.f + sc[u][3]) + sh[u][3]);
            }
        }
    }
    __syncthreads();
    const u32x4* winf = (const u32x4*)(p.ws + WS_WINF);
    __bf16* GM = (__bf16*)(p.ws + WS_GM); __bf16* GQ = (__bf16*)(p.ws + WS_GQ); __bf16* GK = (__bf16*)(p.ws + WS_GK);
    __bf16* GV = (__bf16*)(p.ws + WS_GV); __bf16* GG = (__bf16*)(p.ws + WS_GG);
    __bf16* GKT = (__bf16*)(p.ws + WS_GKT); __bf16* GVT = (__bf16*)(p.ws + WS_GVT);
    f32x16 acc[2][2];
    u32x4 ringa[GPF], ringb[GPF];
    const int sst = (w < 6) ? w : 38;
    bool fill = true;
#pragma unroll 1
    for (int i = 0; i < 4; ++i) {
        if (mode == 1 || (mode >= 2 && i != mode - 2)) continue;
        const int st = 6 + w + 8 * i;
        const int stn = (mode == 0) ? ((i < 3) ? st + 8 : ((w < 7) ? sst : st)) : st;
        zero_acc(acc);
        const bool tr = (!is_s) && (st >= 22 && st < 30);
        if (tr) gemm_2x2_stream<64, false>(winf + (size_t)st * 2 * 64 * 64, winf + (size_t)stn * 2 * 64 * 64, fill, A, XS, lane, acc, ringa, ringb);
        else    gemm_2x2_stream<64, true >(winf + (size_t)st * 2 * 64 * 64, winf + (size_t)stn * 2 * 64 * 64, fill, A, XS, lane, acc, ringa, ringb);
        fill = (mode != 0);
        int lane2 = lane; asm volatile("" : "+v"(lane2));
        if (st < 14) store_nat<1>(acc, GM + (size_t)tok0 * 512, 512, (st - 6) * 64, lane2);
        else if (st < 18) store_nat<2>(acc, GQ + (size_t)tok0 * 256, 256, (st - 14) * 64, lane2);
        else if (st < 22) {
            store_nat<0>(acc, GK + (size_t)tok0 * 256, 256, (st - 18) * 64, lane2);
            if (!is_s) {
                const int l31b = lane2 & 31, hhb = lane2 >> 5;
                __bf16* gb = GKT + ((((size_t)(b * 4 + (st - 18)) * 128 + (s0 >> 4) + (l31b >> 4)) * 2) * 64 + 32 * ((l31b >> 2) & 1) + 4 * hhb) * 8 + 4 * ((l31b >> 3) & 1) + (l31b & 3);
#pragma unroll
                for (int mt = 0; mt < 2; ++mt)
#pragma unroll
                    for (int nt = 0; nt < 2; ++nt)
#pragma unroll
                        for (int r = 0; r < 16; ++r)
                            gb[(size_t)mt * 2 * 2 * 512 + nt * 512 + ((r & 3) + 8 * (r >> 2)) * 8] = (__bf16)acc[nt][mt][r];
            }
        } else if (st < 30) {
            if (tr) store_tr(acc, GVT, b * 4 + ((st - 22) >> 1), 4, ((st - 22) & 1) * 2, s0, lane2);
            else store_nat<0>(acc, GV + (size_t)tok0 * 512, 512, (st - 22) * 64, lane2);
        } else store_nat<1>(acc, GG + (size_t)tok0 * 512, 512, (st - 30) * 64, lane2);
    }
    if (mode >= 2) { __syncthreads(); return; }
    if (w < 7) { zero_acc(acc); gemm_2x2_stream<64, true>(winf + (size_t)sst * 2 * 64 * 64, winf + (size_t)sst * 2 * 64 * 64, fill, A, XS, lane, acc, ringa, ringb); }
    __syncthreads();
    unsigned char* Z = A;
    if (w < 7) {
        const int cb = (w < 4) ? 64 * w : (w < 6 ? 256 + 64 * (w - 4) : 384);
#pragma unroll
        for (int nt = 0; nt < 2; ++nt)
#pragma unroll
            for (int mt = 0; mt < 2; ++mt)
#pragma unroll
                for (int g = 0; g < 4; ++g) {
                    f32x4 v = {acc[nt][mt][4 * g], acc[nt][mt][4 * g + 1], acc[nt][mt][4 * g + 2], acc[nt][mt][4 * g + 3]};
                    *(f32x4*)(Z + (32 * mt + l31) * ZS + (cb + 32 * nt + 8 * g + 4 * hh) * 4) = v;
                }
    }
    __syncthreads();
    p1_post(p, it, lds);
}

__device__ __forceinline__ void p1_post(const Params& p, int it, unsigned char* lds) {
    int tid = threadIdx.x; asm volatile("" : "+v"(tid));
    const int lane = tid & 63, w = tid >> 6, l31 = lane & 31, hh = lane >> 5;
    const bool is_s = it >= 256;
    const int srow0 = is_s ? (it - 256) * 64 : 0;
    const int tok0 = is_s ? NTOK + srow0 : it * 64;
    const int b = it >> 5, s0 = (it & 31) * 64;
    unsigned char* Z = lds + LDS_BASE;
    const float* rope = (const float*)(p.ws + WS_ROPE);
    f32x16 acc[2][2];
    float* latout = p.out + (is_s ? OUT_LATS + (size_t)srow0 * 128 : OUT_LATP + (size_t)it * 64 * 128);
    for (int rr = 0; rr < 8; ++rr) {
        const int row = 8 * w + rr;
        unsigned char* zr = Z + row * ZS;
        const f32x4 v = *(const f32x4*)(zr + 16 * lane);
        const float ss = wave_sum(v[0] * v[0] + v[1] * v[1] + v[2] * v[2] + v[3] * v[3]);
        const float inv = rsqrtf(ss * (1.f / 256.f) + NORM_EPS);
        const f32x4 g = *(const f32x4*)(p.q_norm_g + 4 * lane);
        const f32x2 c = *(const f32x2*)(zr + 1024 + 8 * lane);
        const float ss2 = wave_sum(c[0] * c[0] + c[1] * c[1]);
        const float inv2 = rsqrtf(ss2 * (1.f / 128.f) + NORM_EPS);
        const f32x2 g2 = *(const f32x2*)(p.kv_norm_g + 2 * lane);
        const float y0 = c[0] * inv2 * g2[0], y1 = c[1] * inv2 * g2[1];
        *(u32x2*)(zr + 8 * lane) = pk4(v[0] * inv * g[0], v[1] * inv * g[1], v[2] * inv * g[2], v[3] * inv * g[3]);
        *(unsigned*)(zr + 1024 + 4 * lane) = pk2(y0, y1);
        f32x2 yo = {y0, y1};
        *(f32x2*)(latout + (size_t)row * 128 + 2 * lane) = yo;
    }
    {
        float* krout = p.out + (is_s ? OUT_KRS + (size_t)srow0 * 32 : OUT_KRP + (size_t)it * 64 * 32);
        __bf16* KR = (__bf16*)(p.ws + WS_KR);
#pragma unroll
        for (int q = 0; q < 2; ++q) {
            const int idx = tid + NTHR * q, row = idx >> 4, i = idx & 15;
            const float* zr = (const float*)(Z + row * ZS);
            const float x1 = zr[384 + i], x2 = zr[400 + i];
            const int pi = is_s ? 2048 : s0 + row;
            const float cs = rope[pi * 32 + i], sn = rope[pi * 32 + 16 + i];
            const float o1 = x1 * cs - x2 * sn, o2 = x2 * cs + x1 * sn;
            krout[row * 32 + i] = o1; krout[row * 32 + 16 + i] = o2;
            if (!is_s) { KR[((size_t)b * 2048 + s0 + row) * 32 + i] = (__bf16)o1; KR[((size_t)b * 2048 + s0 + row) * 32 + 16 + i] = (__bf16)o2; }
        }
    }
    {
        const int n = 32 * w + l31, h = w >> 1, dk = 32 * (w & 1) + l31;
        bf16x8 wb;
#pragma unroll
        for (int e = 0; e < 8; ++e) wb[e] = (__bf16)p.w_gate_up[(8 * hh + e) * 256 + n];
        const float bg = p.b_gate[n];
        f32x16 la[2];
#pragma unroll
        for (int mt = 0; mt < 2; ++mt) {
            const float* zr = (const float*)(Z + (32 * mt + l31) * ZS);
            const bf16x8 ga = cvt8(*(const f32x4*)(zr + 416 + 8 * hh), *(const f32x4*)(zr + 420 + 8 * hh));
#pragma unroll
            for (int r = 0; r < 16; ++r) la[mt][r] = 0.f;
            la[mt] = mfma32(ga, wb, la[mt]);
#pragma unroll
            for (int r = 0; r < 16; ++r) { const float a = la[mt][r] + bg; la[mt][r] = (fminf(a, 0.f) - __logf(1.f + __expf(-fabsf(a)))) * (1.f / 16.f); }
        }
        if (!is_s) {
            float carry = 0.f;
#pragma unroll
            for (int mt = 0; mt < 2; ++mt) {
                float bs[4], ps[4];
#pragma unroll
                for (int g = 0; g < 4; ++g) { bs[g] = (la[mt][4 * g] + la[mt][4 * g + 1]) + (la[mt][4 * g + 2] + la[mt][4 * g + 3]); ps[g] = __shfl_xor(bs[g], 32); }
#pragma unroll
                for (int g = 0; g < 4; ++g) {
                    const float b0s = hh ? ps[g] : bs[g], b1s = hh ? bs[g] : ps[g];
                    float run = carry + (hh ? b0s : 0.f);
#pragma unroll
                    for (int i = 0; i < 4; ++i) { run += la[mt][4 * g + i]; la[mt][4 * g + i] = run; }
                    carry += b0s + b1s;
                }
            }
        }
        float* LAB = (float*)(p.ws + WS_LAB) + (size_t)tok0 * 256 + n;
#pragma unroll
        for (int mt = 0; mt < 2; ++mt)
#pragma unroll
            for (int r = 0; r < 16; ++r) LAB[(size_t)(32 * mt + (r & 3) + 8 * (r >> 2) + 4 * hh) * 256] = la[mt][r];
        if (!is_s) {
            float* BT = (float*)(p.ws + WS_BT);
#pragma unroll
            for (int mt = 0; mt < 2; ++mt)
#pragma unroll
                for (int g = 0; g < 4; ++g) {
                    const int k16 = (s0 >> 4) + 2 * mt + (g >> 1);
                    f32x4 v = {la[mt][4 * g], la[mt][4 * g + 1], la[mt][4 * g + 2], la[mt][4 * g + 3]};
                    *(f32x4*)(BT + ((((size_t)(b * 4 + h) * 128 + k16) * 2 + (w & 1)) * 64 + lane) * 8 + 4 * (g & 1)) = v;
                }
            if (hh) ((float*)(p.ws + WS_BL))[((size_t)(b * 4 + h) * 32 + (s0 >> 6)) * 64 + dk] = la[1][15];
        }
    }
    __syncthreads();
    {
        const u32x4* wuqf = (const u32x4*)(p.ws + WS_WUQF);
        const int h = w;
        const unsigned char* x0 = Z + l31 * ZS + hh * 16;
        const unsigned char* x1 = x0 + 32 * ZS;
        const int qoff = (h < 4) ? 512 + 128 * h : 1280 + 128 * (h - 4);
        __bf16* QLR = (__bf16*)(p.ws + WS_QLR);
        __bf16* Q = (__bf16*)(p.ws + WS_Q) + ((size_t)(b * 8 + h) * 2048 + s0) * 96;
#pragma unroll 1
        for (int j = 0; j < 3; ++j) {
            f32x16 q[2];
#pragma unroll
            for (int m = 0; m < 2; ++m)
#pragma unroll
                for (int r = 0; r < 16; ++r) q[m][r] = 0.f;
            const u32x4* wq = wuqf + (size_t)(3 * h + j) * 16 * 64 + lane;
            u32x4 rq[16];
#pragma unroll
            for (int ks = 0; ks < 16; ++ks) rq[ks] = wq[ks * 64];
            __builtin_amdgcn_sched_barrier(0);
#pragma unroll
            for (int ks = 0; ks < 16; ++ks) {
                const bf16x8 a = __builtin_bit_cast(bf16x8, rq[ks]);
                const bf16x8 b0 = *(const bf16x8*)(x0 + ks * 32), b1 = *(const bf16x8*)(x1 + ks * 32);
                q[0] = mfma32(a, b0, q[0]); q[1] = mfma32(a, b1, q[1]);
            }
            if (j == 2) {
#pragma unroll
                for (int m = 0; m < 2; ++m) {
                    const int pi = is_s ? 2048 : s0 + 32 * m + l31;
#pragma unroll
                    for (int g = 0; g < 2; ++g) {
                        const f32x4 cs = *(const f32x4*)(rope + pi * 32 + 8 * g + 4 * hh);
                        const f32x4 sn = *(const f32x4*)(rope + pi * 32 + 16 + 8 * g + 4 * hh);
#pragma unroll
                        for (int i = 0; i < 4; ++i) {
                            const float x1v = q[m][4 * g + i], x2v = q[m][4 * g + 8 + i];
                            q[m][4 * g + i] = x1v * cs[i] - x2v * sn[i];
                            q[m][4 * g + 8 + i] = x2v * cs[i] + x1v * sn[i];
                        }
                    }
                }
            }
#pragma unroll
            for (int m = 0; m < 2; ++m)
#pragma unroll
                for (int g = 0; g < 4; ++g) {
                    const int tok = 32 * m + l31;
                    if (!is_s) {
                        *(u32x2*)(Q + (size_t)tok * 96 + 32 * j + 8 * g + 4 * hh) = pk4(q[m][4 * g] * QSCALE, q[m][4 * g + 1] * QSCALE, q[m][4 * g + 2] * QSCALE, q[m][4 * g + 3] * QSCALE);
                    } else if (j == 2) {
                        *(u32x2*)(QLR + ((size_t)(srow0 + tok) * 8 + h) * 160 + 128 + 8 * g + 4 * hh) = pk4(q[m][4 * g] * QSCALE, q[m][4 * g + 1] * QSCALE, q[m][4 * g + 2] * QSCALE, q[m][4 * g + 3] * QSCALE);
                    } else {
                        *(u32x2*)(Z + tok * ZS + qoff + (32 * j + 8 * g + 4 * hh) * 2) = pk4(q[m][4 * g], q[m][4 * g + 1], q[m][4 * g + 2], q[m][4 * g + 3]);
                    }
                }
        }
        if (is_s) {
            asm volatile("s_waitcnt lgkmcnt(0)" ::: "memory");
            const __bf16* wukb = (const __bf16*)(p.ws + WS_WUKB);
#pragma unroll 1
            for (int rt = 0; rt < 4; ++rt) {
                f32x16 ql[2];
#pragma unroll
                for (int m = 0; m < 2; ++m)
#pragma unroll
                    for (int r = 0; r < 16; ++r) ql[m][r] = 0.f;
#pragma unroll
                for (int ks = 0; ks < 4; ++ks) {
                    const bf16x8 b0 = *(const bf16x8*)(Z + l31 * ZS + qoff + (16 * ks + 8 * hh) * 2);
                    const bf16x8 b1 = *(const bf16x8*)(Z + (32 + l31) * ZS + qoff + (16 * ks + 8 * hh) * 2);
                    const bf16x8 a = *(const bf16x8*)(wukb + ((size_t)(32 * rt + l31) * 8 + h) * 64 + 16 * ks + 8 * hh);
                    ql[0] = mfma32(a, b0, ql[0]); ql[1] = mfma32(a, b1, ql[1]);
                }
#pragma unroll
                for (int m = 0; m < 2; ++m)
#pragma unroll
                    for (int g = 0; g < 4; ++g)
                        *(u32x2*)(QLR + ((size_t)(srow0 + 32 * m + l31) * 8 + h) * 160 + 32 * rt + 8 * g + 4 * hh) =
                            pk4(ql[m][4 * g] * QSCALE, ql[m][4 * g + 1] * QSCALE, ql[m][4 * g + 2] * QSCALE, ql[m][4 * g + 3] * QSCALE);
            }
        }
    }
    if (!is_s) {
        const u32x4* wkvf = (const u32x4*)(p.ws + WS_WKVF);
        __bf16* KN = (__bf16*)(p.ws + WS_KN);
        __bf16* VT = (__bf16*)(p.ws + WS_VT);
#pragma unroll 1
        for (int pp = 0; pp < 2; ++pp) {
            const int nt0 = 4 * w + 2 * pp;
            zero_acc(acc);
            if (w < 4) {
                gemm_2x2<8, true>(wkvf + (size_t)nt0 * 8 * 64, Z + 1024, ZS, lane, acc);
                const int hd = nt0 >> 1;
                store_nat<0>(acc, KN + ((size_t)(b * 8 + hd) * 2048 + s0) * 64, 64, 0, lane);
            } else {
                gemm_2x2<8, false>(wkvf + (size_t)nt0 * 8 * 64, Z + 1024, ZS, lane, acc);
                const int hd = (nt0 - 16) >> 1;
                store_tr(acc, VT, b * 8 + hd, 2, 0, s0, lane);
            }
        }
    }
    __syncthreads();
}

constexpr int KST = 208, VST = 144;
constexpr int KBUF = 64 * KST, VBUF = 8192;

__device__ void p2_attn(const Params& p, int bh, int qb, unsigned char* lds) {
    int tid = threadIdx.x; asm volatile("" : "+v"(tid));
    const int lane = tid & 63, w = tid >> 6, l31 = lane & 31, hh = lane >> 5;
    const int b = bh >> 3, h = bh & 7;
    const __bf16* Q = (const __bf16*)(p.ws + WS_Q) + (size_t)bh * 2048 * 96;
    const __bf16* KN = (const __bf16*)(p.ws + WS_KN) + (size_t)bh * 2048 * 64;
    const __bf16* KR = (const __bf16*)(p.ws + WS_KR) + (size_t)b * 2048 * 32;
    const __bf16* VT = (const __bf16*)(p.ws + WS_VT) + (size_t)bh * 64 * 2048;
    unsigned char* Kb = lds + LDS_BASE;
    unsigned char* Vb = Kb + 2 * KBUF;
    const int qrow0 = qb * 256 + 32 * w, qi = qrow0 + l31;
    bf16x8 qf[6];
#pragma unroll
    for (int ks = 0; ks < 6; ++ks) qf[ks] = *(const bf16x8*)(Q + (size_t)qi * 96 + 16 * ks + 8 * hh);
    f32x16 o[2];
#pragma unroll
    for (int d = 0; d < 2; ++d)
#pragma unroll
        for (int r = 0; r < 16; ++r) o[d][r] = 0.f;
    float m = -1e30f, l = 0.f;
    const int nkt = (qb + 1) * 4;
    const int key_k = tid >> 3, ch_k = tid & 7, key_r = tid >> 2, ch_r = tid & 3;
    u32x4 kA, rA = {0u, 0u, 0u, 0u}, vA, kB, rB = {0u, 0u, 0u, 0u}, vB;
#define ATT_LOAD(kx, rx, vx, jt_) do { const int jc_ = ((jt_) < nkt) ? (jt_) : (nkt - 1); const int k0_ = 64 * jc_; \
        kx = *(const u32x4*)(KN + (size_t)(k0_ + key_k) * 64 + 8 * ch_k); \
        if (tid < 256) rx = *(const u32x4*)(KR + (size_t)(k0_ + key_r) * 32 + 8 * ch_r); \
        vx = *(const u32x4*)(VT + (size_t)jc_ * 4096 + (size_t)tid * 8); } while (0)
#define ATT_STORE(kx, rx, vx, buf_) do { unsigned char* kn_ = Kb + (buf_) * KBUF; unsigned char* vn_ = Vb + (buf_) * VBUF; \
        *(u32x4*)(kn_ + key_k * KST + ch_k * 16) = kx; \
        if (tid < 256) *(u32x4*)(kn_ + key_r * KST + 128 + ch_r * 16) = rx; \
        *(u32x4*)(vn_ + tid * 16) = vx; } while (0)
#define ATT_COMPUTE(j_, cur_) do { \
        const unsigned char* kb = Kb + (cur_) * KBUF; \
        const unsigned char* vb = Vb + (cur_) * VBUF; \
        _Pragma("unroll") for (int sub = 0; sub < 2; ++sub) { \
            const int key_lo = 64 * (j_) + 32 * sub; \
            if (key_lo <= qrow0 + 31) { \
                f32x16 s; \
                _Pragma("unroll") for (int r = 0; r < 16; ++r) s[r] = 0.f; \
                _Pragma("unroll") for (int ks = 0; ks < 6; ++ks) { \
                    const bf16x8 kf = *(const bf16x8*)(kb + (32 * sub + l31) * KST + (16 * ks + 8 * hh) * 2); \
                    s = mfma32(kf, qf[ks], s); } \
                if (key_lo + 31 > qrow0) { \
                    _Pragma("unroll") for (int r = 0; r < 16; ++r) { const int key = key_lo + (r & 3) + 8 * (r >> 2) + 4 * hh; if (key > qi) s[r] = -1e30f; } } \
                float mx = s[0]; \
                _Pragma("unroll") for (int r = 1; r < 16; ++r) mx = fmaxf(mx, s[r]); \
                mx = fmaxf(mx, __shfl_xor(mx, 32)); \
                const float mn = fmaxf(m, mx), alpha = ex2(m - mn); \
                m = mn; \
                float ps = 0.f; \
                _Pragma("unroll") for (int r = 0; r < 16; ++r) { s[r] = ex2(s[r] - mn); ps += s[r]; } \
                l = l * alpha + ps; \
                _Pragma("unroll") for (int d = 0; d < 2; ++d) _Pragma("unroll") for (int r = 0; r < 16; ++r) o[d][r] *= alpha; \
                _Pragma("unroll") for (int sk = 0; sk < 2; ++sk) { \
                    bf16x8 pf; \
                    _Pragma("unroll") for (int e = 0; e < 8; ++e) pf[e] = (__bf16)s[8 * sk + e]; \
                    _Pragma("unroll") for (int d = 0; d < 2; ++d) { \
                        const bf16x8 vf = *(const bf16x8*)(vb + ((2 * sub + sk) * 2 + d) * 1024 + lane * 16); \
                        o[d] = mfma32(vf, pf, o[d]); } } } } } while (0)
    ATT_LOAD(kA, rA, vA, 0);
    ATT_LOAD(kB, rB, vB, 1);
    ATT_STORE(kA, rA, vA, 0);
    ATT_LOAD(kA, rA, vA, 2);
    __syncthreads();
    for (int j = 0; j < nkt; j += 2) {
        ATT_COMPUTE(j, 0);
        ATT_STORE(kB, rB, vB, 1);
        ATT_LOAD(kB, rB, vB, j + 3);
        __syncthreads();
        ATT_COMPUTE(j + 1, 1);
        ATT_STORE(kA, rA, vA, 0);
        ATT_LOAD(kA, rA, vA, j + 4);
        __syncthreads();
    }
#undef ATT_LOAD
#undef ATT_STORE
#undef ATT_COMPUTE
    const float lt = l + __shfl_xor(l, 32);
    const float inv = 1.f / lt;
    __bf16* AO = (__bf16*)(p.ws + WS_AO) + ((size_t)b * 2048 + qi) * 512 + h * 64;
#pragma unroll
    for (int d = 0; d < 2; ++d)
#pragma unroll
        for (int g = 0; g < 4; ++g)
            *(u32x2*)(AO + 32 * d + 8 * g + 4 * hh) = pk4(o[d][4 * g] * inv, o[d][4 * g + 1] * inv, o[d][4 * g + 2] * inv, o[d][4 * g + 3] * inv);
}

constexpr int DVS = 80;
constexpr int DW_BYTES = 8192 + 32 * DVS + 16 * DVS;
typedef short s16x4 __attribute__((ext_vector_type(4)));
__device__ __forceinline__ f32x4 mfma16(bf16x8 a, bf16x8 b, f32x4 c) { return __builtin_amdgcn_mfma_f32_16x16x32_bf16(a, b, c, 0, 0, 0); }
__device__ __forceinline__ s16x4 lds_tr16(const unsigned char* q) { return __builtin_amdgcn_ds_read_tr16_b64_v4i16((LAS s16x4*)q); }
__device__ void p2_decode(const Params& p, int bs, int split, unsigned char* lds) {
    int tid = threadIdx.x; asm volatile("" : "+v"(tid));
    const int lane = tid & 63, w = tid >> 6, l15 = lane & 15, q4 = lane >> 4;
    unsigned char* IMG = lds + LDS_BASE + w * DW_BYTES;
    unsigned char* KRI = IMG + 8192;
    unsigned char* WP = KRI + 32 * DVS;
    const __bf16* QLR = (const __bf16*)(p.ws + WS_QLR);
    const int pg0 = split * 16 + 2 * w;
    const int phys0 = p.page_table[bs * NPAGES + pg0], phys1 = p.page_table[bs * NPAGES + pg0 + 1];
    f32x4 raw[20];
#define DEC_ISSUE(tt_) do { const int phys_ = ((tt_) >> 2) ? phys1 : phys0; \
        const float* lp_ = p.cache_lat + ((size_t)phys_ * 128 + ((tt_) & 3) * 32) * 128 + 4 * lane; \
        const float* kp_ = p.cache_kr + ((size_t)phys_ * 128 + ((tt_) & 3) * 32) * 32 + 4 * lane; \
        _Pragma("unroll") for (int i = 0; i < 16; ++i) raw[i] = __builtin_nontemporal_load((const f32x4*)(lp_ + 256 * i)); \
        _Pragma("unroll") for (int i = 0; i < 4; ++i) raw[16 + i] = __builtin_nontemporal_load((const f32x4*)(kp_ + 256 * i)); } while (0)
    DEC_ISSUE(0);
    bf16x8 qf[5];
#pragma unroll
    for (int ks = 0; ks < 5; ++ks) {
        u32x4 v = *(const u32x4*)(QLR + ((size_t)bs * 8 + (l15 & 7)) * 160 + 32 * ks + 8 * q4);
        if (l15 >= 8) v = (u32x4){0u, 0u, 0u, 0u};
        qf[ks] = __builtin_bit_cast(bf16x8, v);
    }
    const int hi = lane >> 5;
    const int W0 = 256 * hi + 16 * (((lane & 31) >> 1) ^ (hi << 2)) + 8 * (lane & 1);
    const int KW0 = (lane >> 3) * DVS + 8 * (lane & 7);
    const int RB0 = 256 * l15 + 16 * (q4 ^ (l15 >> 2)) + 64 * (l15 & 3);
    const int TQ = l15 >> 2, TP = lane & 3;
    const int T00 = 256 * (8 * q4 + TQ) + 16 * ((TP >> 1) ^ ((TQ << 2) | ((2 * q4) & 3))) + 8 * (TP & 1);
    const int T01 = 256 * (8 * q4 + 4 + TQ) + 16 * ((TP >> 1) ^ ((TQ << 2) | ((2 * q4 + 1) & 3))) + 8 * (TP & 1);
    f32x4 o[8];
#pragma unroll
    for (int t = 0; t < 8; ++t) o[t] = (f32x4){0.f, 0.f, 0.f, 0.f};
    float m = -1e30f, l = 0.f;
#pragma unroll 1
    for (int tt = 0; tt < 8; ++tt) {
#pragma unroll
        for (int i = 0; i < 16; ++i) {
            const int ci = (((2 * i) & 3) << 2) | ((i >> 1) & 3);
            *(u32x2*)(IMG + 512 * i + (W0 ^ (ci << 4))) = pk4(raw[i][0], raw[i][1], raw[i][2], raw[i][3]);
        }
#pragma unroll
        for (int i = 0; i < 4; ++i) *(u32x2*)(KRI + 8 * i * DVS + KW0) = pk4(raw[16 + i][0], raw[16 + i][1], raw[16 + i][2], raw[16 + i][3]);
        asm volatile("" ::: "memory");
        DEC_ISSUE(tt < 7 ? tt + 1 : 7);
        f32x4 s[2];
#pragma unroll
        for (int j = 0; j < 2; ++j) {
            s[j] = (f32x4){0.f, 0.f, 0.f, 0.f};
#pragma unroll
            for (int ks = 0; ks < 4; ++ks) {
                const bf16x8 kf = *(const bf16x8*)(IMG + 4096 * j + (RB0 ^ (ks << 6)));
                s[j] = mfma16(kf, qf[ks], s[j]);
            }
            const bf16x8 kf = *(const bf16x8*)(KRI + (16 * j + l15) * DVS + 16 * q4);
            s[j] = mfma16(kf, qf[4], s[j]);
        }
        float mx = fmaxf(fmaxf(fmaxf(s[0][0], s[0][1]), fmaxf(s[0][2], s[0][3])), fmaxf(fmaxf(s[1][0], s[1][1]), fmaxf(s[1][2], s[1][3])));
        mx = fmaxf(mx, __shfl_xor(mx, 16)); mx = fmaxf(mx, __shfl_xor(mx, 32));
        const float mn = fmaxf(m, mx), alpha = ex2(m - mn);
        m = mn;
        float ps = 0.f;
#pragma unroll
        for (int j = 0; j < 2; ++j)
#pragma unroll
            for (int r = 0; r < 4; ++r) { s[j][r] = ex2(s[j][r] - mn); ps += s[j][r]; }
        l = l * alpha + ps;
#pragma unroll
        for (int t = 0; t < 8; ++t) o[t] *= alpha;
#pragma unroll
        for (int j = 0; j < 2; ++j) *(u32x2*)(WP + l15 * DVS + (16 * j + 4 * q4) * 2) = pk4(s[j][0], s[j][1], s[j][2], s[j][3]);
        {
            const bf16x8 pf = *(const bf16x8*)(WP + l15 * DVS + 8 * q4 * 2);
#pragma unroll
            for (int t = 0; t < 8; ++t) {
                const s16x4 v0 = lds_tr16(IMG + (T00 ^ (t << 5))), v1 = lds_tr16(IMG + (T01 ^ (t << 5)));
                typedef short s16x8 __attribute__((ext_vector_type(8)));
                const s16x8 vv = {v0[0], v0[1], v0[2], v0[3], v1[0], v1[1], v1[2], v1[3]};
                o[t] = mfma16(__builtin_bit_cast(bf16x8, vv), pf, o[t]);
            }
        }
    }
#undef DEC_ISSUE
    float lt = l + __shfl_xor(l, 16); lt += __shfl_xor(lt, 32);
    __syncthreads();
    float* MG = (float*)(lds + LDS_BASE);
    if (l15 < 8) {
        float* rec = MG + (w * 8 + l15) * 132;
        if (q4 == 0) { rec[0] = m; rec[1] = lt; }
#pragma unroll
        for (int t = 0; t < 8; ++t) *(f32x4*)(rec + 4 + 16 * t + 4 * q4) = o[t];
    }
    __syncthreads();
    {
        const int hd = tid >> 6, r2 = 2 * (tid & 63);
        float M = -1e30f;
#pragma unroll
        for (int ww = 0; ww < 8; ++ww) M = fmaxf(M, MG[(ww * 8 + hd) * 132]);
        float L = 0.f, o0 = 0.f, o1 = 0.f;
#pragma unroll
        for (int ww = 0; ww < 8; ++ww) {
            const float* rec = MG + (ww * 8 + hd) * 132;
            const float wt = ex2(rec[0] - M);
            L = fmaf(wt, rec[1], L); o0 = fmaf(wt, rec[4 + r2], o0); o1 = fmaf(wt, rec[5 + r2], o1);
        }
        float* dp = (float*)(p.ws + WS_DPART) + ((size_t)(bs * 4 + split) * 8 + hd) * 132;
        if ((tid & 63) == 0) { dp[0] = M; dp[1] = L; }
        f32x2 ov = {o0, o1};
        *(f32x2*)(dp + 4 + r2) = ov;
    }
    __syncthreads();
}

__device__ void p2_scan(const Params& p, int bh) {
    int tid = threadIdx.x; asm volatile("" : "+v"(tid));
    const int lane = tid & 63, w = tid >> 6, l31 = lane & 31, hh = lane >> 5;
    const int dkt = w & 1, dvt = w >> 1;
    const float* BT = (const float*)(p.ws + WS_BT) + (size_t)bh * 64 * 2048;
    const __bf16* GKT = (const __bf16*)(p.ws + WS_GKT) + (size_t)bh * 64 * 2048;
    const __bf16* GVT = (const __bf16*)(p.ws + WS_GVT) + (size_t)bh * 128 * 2048;
    const float* BL = (const float*)(p.ws + WS_BL) + (size_t)bh * 32 * 64;
    __bf16* ST2 = (__bf16*)(p.ws + WS_ST2) + (size_t)bh * 32 * 128 * 64;
    const int dkA = 32 * dkt + l31, dvB = 32 * dvt + l31;
    f32x16 S;
#pragma unroll
    for (int r = 0; r < 16; ++r) S[r] = 0.f;
    float decN[16], blN; u32x4 kN[4]; f32x4 b0N[4], b1N[4]; bf16x8 vN[4];
#define SCAN_LOAD(c_) do { \
        _Pragma("unroll") for (int r = 0; r < 16; ++r) decN[r] = BL[(c_) * 64 + 32 * dkt + (r & 3) + 8 * (r >> 2) + 4 * hh]; \
        blN = BL[(c_) * 64 + dkA]; \
        _Pragma("unroll") for (int ks = 0; ks < 4; ++ks) { const size_t k16 = (size_t)(c_) * 4 + ks; \
            kN[ks] = *(const u32x4*)(GKT + ((k16 * 2 + dkt) * 64 + lane) * 8); \
            b0N[ks] = *(const f32x4*)(BT + ((k16 * 2 + dkt) * 64 + lane) * 8); b1N[ks] = *(const f32x4*)(BT + ((k16 * 2 + dkt) * 64 + lane) * 8 + 4); \
            vN[ks] = *(const bf16x8*)(GVT + ((k16 * 4 + dvt) * 64 + lane) * 8); } \
    } while (0)
    SCAN_LOAD(0);
#pragma unroll 1
    for (int c = 0; c < 32; ++c) {
        float dec[16]; u32x4 kC[4]; f32x4 b0C[4], b1C[4]; bf16x8 vC[4];
        const float blast = blN;
#pragma unroll
        for (int r = 0; r < 16; ++r) dec[r] = decN[r];
#pragma unroll
        for (int ks = 0; ks < 4; ++ks) { kC[ks] = kN[ks]; b0C[ks] = b0N[ks]; b1C[ks] = b1N[ks]; vC[ks] = vN[ks]; }
        SCAN_LOAD(c + 1);
        __builtin_amdgcn_sched_barrier(0);
#pragma unroll
        for (int g = 0; g < 4; ++g)
            *(u32x2*)(ST2 + ((size_t)c * 128 + dvB) * 64 + 32 * dkt + 8 * g + 4 * hh) = pk4(S[4 * g], S[4 * g + 1], S[4 * g + 2], S[4 * g + 3]);
#pragma unroll
        for (int r = 0; r < 16; ++r) S[r] *= __expf(dec[r]);
#pragma unroll
        for (int ks = 0; ks < 4; ++ks) {
            float kv[8]; unpack8(kC[ks], kv);
            bf16x8 ka;
#pragma unroll
            for (int e = 0; e < 4; ++e) { ka[e] = (__bf16)(kv[e] * __expf(blast - b0C[ks][e])); ka[4 + e] = (__bf16)(kv[4 + e] * __expf(blast - b1C[ks][e])); }
            S = mfma32(ka, vC[ks], S);
        }
        __builtin_amdgcn_sched_barrier(0);
    }
#undef SCAN_LOAD
    float* stp = p.out + OUT_STP + (size_t)bh * 64 * 128;
#pragma unroll
    for (int r = 0; r < 16; ++r) {
        const int dkr = 32 * dkt + (r & 3) + 8 * (r >> 2) + 4 * hh;
        stp[(size_t)dkr * 128 + dvB] = S[r];
    }
}

__device__ void p2_glarec(const Params& p, int bs, unsigned char* lds) {
    int tid = threadIdx.x; asm volatile("" : "+v"(tid));
    float* sq = (float*)(lds + LDS_BASE); float* sk = sq + 256; float* se = sk + 256;
    const __bf16* GQ = (const __bf16*)(p.ws + WS_GQ) + (size_t)(NTOK + bs) * 256;
    const __bf16* GK = (const __bf16*)(p.ws + WS_GK) + (size_t)(NTOK + bs) * 256;
    const float* LAB = (const float*)(p.ws + WS_LAB) + (size_t)(NTOK + bs) * 256;
    if (tid < 256) { sq[tid] = (float)GQ[tid]; sk[tid] = (float)GK[tid]; se[tid] = __expf(LAB[tid]); }
    __syncthreads();
    const int h = tid >> 7, dv = tid & 127;
    const float v = (float)((const __bf16*)(p.ws + WS_GV))[(size_t)(NTOK + bs) * 512 + h * 128 + dv];
    const float* s0 = p.state_gla + ((size_t)(bs * 4 + h) * 64) * 128 + dv;
    float* s1 = p.out + OUT_STS + ((size_t)(bs * 4 + h) * 64) * 128 + dv;
    float o = 0.f;
#pragma unroll 8
    for (int dk = 0; dk < 64; ++dk) {
        const float ns = se[h * 64 + dk] * s0[(size_t)dk * 128] + sk[h * 64 + dk] * v;
        s1[(size_t)dk * 128] = ns;
        o = fmaf(sq[h * 64 + dk], ns, o);
    }
    ((float*)(p.ws + WS_GLAOS))[(size_t)(bs * 4 + h) * 128 + dv] = o;
    __syncthreads();
}

__device__ __forceinline__ void p3_outproj(const Params& p, int it, unsigned char* lds);
__device__ void p3_stripe(const Params& p, int it, unsigned char* lds) {
    int tid = threadIdx.x; asm volatile("" : "+v"(tid));
    const int lane = tid & 63, w = tid >> 6, l31 = lane & 31, hh = lane >> 5;
    const bool is_s = it >= 512;
    const int srow0 = is_s ? (it - 512) * 32 : 0;
    const int st = it >> 1, half = it & 1;
    const int tok0 = is_s ? NTOK + srow0 : st * 64 + 32 * half;
    const int b = st >> 5, c = st & 31, s0 = c * 64;
    unsigned char* A = lds + LDS_BASE;
    const __bf16* GM = (const __bf16*)(p.ws + WS_GM);
    const __bf16* GG = (const __bf16*)(p.ws + WS_GG);
    if (!is_s) {
        const __bf16* AO = (const __bf16*)(p.ws + WS_AO);
        const int h = w >> 1, dvh = w & 1, bh = b * 4 + h;
        const int ti = 32 * half + l31;
        const size_t trow = (size_t)(st * 64 + ti);
        const __bf16* GQ = (const __bf16*)(p.ws + WS_GQ);
        const __bf16* GK = (const __bf16*)(p.ws + WS_GK);
        const float* LAB = (const float*)(p.ws + WS_LAB);
        const __bf16* GVT = (const __bf16*)(p.ws + WS_GVT) + (size_t)bh * 128 * 2048;
        const __bf16* ST2 = (const __bf16*)(p.ws + WS_ST2) + ((size_t)bh * 32 + c) * 128 * 64;
        bf16x8 qf[4], kf0[4], vf0[2][2];
        {
            u32x4 av[4], gv[4];
            u32x4 qr[4], kr[4]; f32x4 qb0[4], qb1[4], kb0[4], kb1[4];
            const size_t jrow = (size_t)(st * 64 + l31);
#pragma unroll
            for (int i = 0; i < 4; ++i) {
                const int idx = i * NTHR + tid, row = idx >> 6, ch = idx & 63;
                av[i] = *(const u32x4*)(AO + (size_t)(tok0 + row) * 512 + 8 * ch);
                gv[i] = *(const u32x4*)(GM + (size_t)(tok0 + row) * 512 + 8 * ch);
            }
#pragma unroll
            for (int ks = 0; ks < 4; ++ks) {
                const int dk0 = h * 64 + 16 * ks + 8 * hh;
                qr[ks] = *(const u32x4*)(GQ + trow * 256 + dk0);
                qb0[ks] = *(const f32x4*)(LAB + trow * 256 + dk0); qb1[ks] = *(const f32x4*)(LAB + trow * 256 + dk0 + 4);
                kr[ks] = *(const u32x4*)(GK + jrow * 256 + dk0);
                kb0[ks] = *(const f32x4*)(LAB + jrow * 256 + dk0); kb1[ks] = *(const f32x4*)(LAB + jrow * 256 + dk0 + 4);
            }
#pragma unroll
            for (int sk = 0; sk < 2; ++sk)
#pragma unroll
                for (int t = 0; t < 2; ++t) vf0[sk][t] = *(const bf16x8*)(GVT + ((((size_t)(s0 >> 4) + sk) * 4 + 2 * dvh + t) * 64 + lane) * 8);
            __builtin_amdgcn_sched_barrier(0);
#pragma unroll
            for (int i = 0; i < 4; ++i) {
                const int idx = i * NTHR + tid, row = idx >> 6, ch = idx & 63;
                float af[8], gf[8]; unpack8(av[i], af); unpack8(gv[i], gf);
                u32x4 o; o.x = pk2(af[0] * gf[0], af[1] * gf[1]); o.y = pk2(af[2] * gf[2], af[3] * gf[3]); o.z = pk2(af[4] * gf[4], af[5] * gf[5]); o.w = pk2(af[6] * gf[6], af[7] * gf[7]);
                *(u32x4*)(A + row * XS + ch * 16) = o;
            }
#pragma unroll
            for (int ks = 0; ks < 4; ++ks) {
                float qv[8], kv[8]; unpack8(qr[ks], qv); unpack8(kr[ks], kv);
#pragma unroll
                for (int e = 0; e < 4; ++e) {
                    qf[ks][e] = (__bf16)(qv[e] * __expf(qb0[ks][e])); qf[ks][4 + e] = (__bf16)(qv[4 + e] * __expf(qb1[ks][e]));
                    kf0[ks][e] = (__bf16)(kv[e] * __expf(-kb0[ks][e])); kf0[ks][4 + e] = (__bf16)(kv[4 + e] * __expf(-kb1[ks][e]));
                }
            }
        }
        bf16x8 sf[4][2], vf1[2][2]; u32x4 kr1[4]; f32x4 kb10[4], kb11[4], gn[2][4]; u32x2 gg[2][4];
        {
            const size_t jrow1 = (size_t)(st * 64 + 32 + l31);
#pragma unroll
            for (int ks = 0; ks < 4; ++ks) {
                const int dk0 = h * 64 + 16 * ks + 8 * hh;
#pragma unroll
                for (int t = 0; t < 2; ++t) sf[ks][t] = *(const bf16x8*)(ST2 + (size_t)(32 * (2 * dvh + t) + l31) * 64 + 16 * ks + 8 * hh);
                kr1[ks] = *(const u32x4*)(GK + jrow1 * 256 + dk0);
                kb10[ks] = *(const f32x4*)(LAB + jrow1 * 256 + dk0); kb11[ks] = *(const f32x4*)(LAB + jrow1 * 256 + dk0 + 4);
            }
#pragma unroll
            for (int sk = 0; sk < 2; ++sk)
#pragma unroll
                for (int t = 0; t < 2; ++t) vf1[sk][t] = *(const bf16x8*)(GVT + ((((size_t)(s0 >> 4) + 2 + sk) * 4 + 2 * dvh + t) * 64 + lane) * 8);
#pragma unroll
            for (int t = 0; t < 2; ++t)
#pragma unroll
                for (int g = 0; g < 4; ++g) {
                    const int dv = 32 * (2 * dvh + t) + 8 * g + 4 * hh;
                    gn[t][g] = *(const f32x4*)(p.gla_norm_g + h * 128 + dv);
                    gg[t][g] = *(const u32x2*)(GG + trow * 512 + h * 128 + dv);
                }
        }
        __builtin_amdgcn_sched_barrier(0);
        f32x16 o[2];
#pragma unroll
        for (int t = 0; t < 2; ++t)
#pragma unroll
            for (int r = 0; r < 16; ++r) o[t][r] = 0.f;
        {
            f32x16 att;
#pragma unroll
            for (int r = 0; r < 16; ++r) att[r] = 0.f;
#pragma unroll
            for (int ks = 0; ks < 4; ++ks) att = mfma32(kf0[ks], qf[ks], att);
            if (half == 0) {
#pragma unroll
                for (int r = 0; r < 16; ++r) { const int j = (r & 3) + 8 * (r >> 2) + 4 * hh; if (j > l31) att[r] = 0.f; }
            }
#pragma unroll
            for (int sk = 0; sk < 2; ++sk) {
                bf16x8 pf;
#pragma unroll
                for (int e = 0; e < 8; ++e) pf[e] = (__bf16)att[8 * sk + e];
#pragma unroll
                for (int t = 0; t < 2; ++t) o[t] = mfma32(vf0[sk][t], pf, o[t]);
            }
        }
        __builtin_amdgcn_sched_barrier(0);
        if (half == 1) {
            f32x16 att;
#pragma unroll
            for (int r = 0; r < 16; ++r) att[r] = 0.f;
#pragma unroll
            for (int ks = 0; ks < 4; ++ks) {
                float kv[8]; unpack8(kr1[ks], kv);
                bf16x8 kf;
#pragma unroll
                for (int e = 0; e < 4; ++e) { kf[e] = (__bf16)(kv[e] * __expf(-kb10[ks][e])); kf[4 + e] = (__bf16)(kv[4 + e] * __expf(-kb11[ks][e])); }
                att = mfma32(kf, qf[ks], att);
            }
#pragma unroll
            for (int r = 0; r < 16; ++r) { const int j = (r & 3) + 8 * (r >> 2) + 4 * hh; if (j > l31) att[r] = 0.f; }
#pragma unroll
            for (int sk = 0; sk < 2; ++sk) {
                bf16x8 pf;
#pragma unroll
                for (int e = 0; e < 8; ++e) pf[e] = (__bf16)att[8 * sk + e];
#pragma unroll
                for (int t = 0; t < 2; ++t) o[t] = mfma32(vf1[sk][t], pf, o[t]);
            }
        }
#pragma unroll
        for (int ks = 0; ks < 4; ++ks)
#pragma unroll
            for (int t = 0; t < 2; ++t) o[t] = mfma32(sf[ks][t], qf[ks], o[t]);
        float ss = 0.f;
#pragma unroll
        for (int t = 0; t < 2; ++t)
#pragma unroll
            for (int r = 0; r < 16; ++r) ss = fmaf(o[t][r], o[t][r], ss);
        ss += __shfl_xor(ss, 32);
        float* SSX = (float*)(lds + LDS_BASE + 64 * XS);
        if (hh == 0) SSX[w * 32 + l31] = ss;
        __syncthreads();
        ss += SSX[(w ^ 1) * 32 + l31];
        const float inv = rsqrtf(ss * (1.f / 128.f) + NORM_EPS);
#pragma unroll
        for (int t = 0; t < 2; ++t)
#pragma unroll
            for (int g = 0; g < 4; ++g) {
                const int dv = 32 * (2 * dvh + t) + 8 * g + 4 * hh;
                *(u32x2*)(A + l31 * XS + (512 + h * 128 + dv) * 2) =
                    pk4(o[t][4 * g] * inv * gn[t][g][0] * bflo(gg[t][g].x), o[t][4 * g + 1] * inv * gn[t][g][1] * bfhi(gg[t][g].x),
                        o[t][4 * g + 2] * inv * gn[t][g][2] * bflo(gg[t][g].y), o[t][4 * g + 3] * inv * gn[t][g][3] * bfhi(gg[t][g].y));
            }
    }
    __syncthreads();
    p3_outproj(p, it, lds);
}

__device__ __forceinline__ void p3_outproj(const Params& p, int it, unsigned char* lds) {
    int tid = threadIdx.x; asm volatile("" : "+v"(tid));
    const int lane = tid & 63, w = tid >> 6, l31 = lane & 31, hh = lane >> 5;
    const bool is_s = it >= 512;
    const int srow0 = is_s ? (it - 512) * 32 : 0;
    const int st = it >> 1, half = it & 1, b = st >> 5;
    unsigned char* A = lds + LDS_BASE;
    const u32x4* woutf = (const u32x4*)(p.ws + WS_WOUTF);
    const float* mod = (const float*)(p.ws + WS_MOD);
    float s1 = 0.f, s2 = 0.f;
    const size_t row0 = is_s ? (size_t)srow0 : (size_t)st * 64 + 32 * half;
    const float* xb0 = (is_s ? p.x_sample : p.x_prompt) + (row0 + l31) * 1024 + 64 * w + 4 * hh;
    const float* gb0 = mod + (size_t)(is_s ? (8 + srow0 + l31) : b) * 3072 + 2048 + 64 * w + 4 * hh;
    float* yb0 = p.out + (is_s ? OUT_YS : OUT_YP) + (row0 + l31) * 1024 + 64 * w + 4 * hh;
    f32x16 vacc[2][2];
#pragma unroll
    for (int q = 0; q < 2; ++q) {
        f32x16 acc[2];
#pragma unroll
        for (int nt = 0; nt < 2; ++nt)
#pragma unroll
            for (int r = 0; r < 16; ++r) acc[nt][r] = 0.f;
        f32x4 xv[2][4];
        {
            const unsigned char* x0 = A + l31 * XS + hh * 16;
            const u32x4* w0 = woutf + (size_t)(w + 8 * q) * 2 * 64 * 64 + lane;
            const u32x4* w1 = w0 + 64 * 64;
            u32x4 ra[8], rb[8];
#pragma unroll
            for (int u = 0; u < 8; ++u) { ra[u] = w0[u * 64]; rb[u] = w1[u * 64]; }
#pragma unroll
            for (int g = 0; g < 4; ++g) xv[0][g] = *(const f32x4*)(xb0 + 512 * q + 8 * g);
            const float xtouch = xb0[512 * q + 32];
            bf16x8 b0 = *(const bf16x8*)(x0);
#pragma unroll 1
            for (int k0 = 0; k0 < 64; k0 += 8) {
#pragma unroll
                for (int u = 0; u < 8; ++u) {
                    const int ks = k0 + u;
                    const bf16x8 nb0 = *(const bf16x8*)(x0 + (ks + 1) * 32);
                    const bf16x8 a0 = __builtin_bit_cast(bf16x8, ra[u]), a1 = __builtin_bit_cast(bf16x8, rb[u]);
                    ra[u] = w0[(ks + 8) * 64]; rb[u] = w1[(ks + 8) * 64];
                    __builtin_amdgcn_sched_barrier(0);
                    acc[0] = mfma32(a0, b0, acc[0]); acc[1] = mfma32(a1, b0, acc[1]);
                    __builtin_amdgcn_sched_barrier(0);
                    b0 = nb0;
                }
            }
            asm volatile("" :: "v"(xtouch));
        }
        f32x4 gt[2][4];
#pragma unroll
        for (int nt = 0; nt < 2; ++nt)
#pragma unroll
            for (int g = 0; g < 4; ++g) gt[nt][g] = *(const f32x4*)(gb0 + 512 * q + 32 * nt + 8 * g);
#pragma unroll
        for (int g = 0; g < 4; ++g) xv[1][g] = *(const f32x4*)(xb0 + 512 * q + 32 + 8 * g);
        __builtin_amdgcn_sched_barrier(0);
#pragma unroll
        for (int nt = 0; nt < 2; ++nt)
#pragma unroll
            for (int g = 0; g < 4; ++g)
#pragma unroll
                for (int i = 0; i < 4; ++i) {
                    const float v = DN_ALPHA * xv[nt][g][i] + gt[nt][g][i] * acc[nt][4 * g + i];
                    vacc[q][nt][4 * g + i] = v;
                    s1 += v; s2 = fmaf(v, v, s2);
                }
        __builtin_amdgcn_sched_barrier(0);
    }
    float* LNP = (float*)(lds + LDS_BASE + 64 * XS);
    s1 += __shfl_xor(s1, 32); s2 += __shfl_xor(s2, 32);
    __syncthreads();
    if (hh == 0) { LNP[(w * 32 + l31) * 2] = s1; LNP[(w * 32 + l31) * 2 + 1] = s2; }
    __syncthreads();
    float mean, rstd;
    {
        float a = 0.f, bq = 0.f;
#pragma unroll
        for (int ww = 0; ww < 8; ++ww) { a += LNP[(ww * 32 + l31) * 2]; bq += LNP[(ww * 32 + l31) * 2 + 1]; }
        mean = a * (1.f / 1024.f);
        const float var = fmaxf(bq * (1.f / 1024.f) - mean * mean, 0.f);
        rstd = rsqrtf(var + NORM_EPS);
    }
    const float* lgb = p.ln_g + 64 * w + 4 * hh;
    const float* lbb = p.ln_b + 64 * w + 4 * hh;
#pragma unroll
    for (int q = 0; q < 2; ++q) {
        f32x4 lg[2][4], lb[2][4];
#pragma unroll
        for (int nt = 0; nt < 2; ++nt)
#pragma unroll
            for (int g = 0; g < 4; ++g) {
                const int off = 512 * q + 32 * nt + 8 * g;
                lg[nt][g] = *(const f32x4*)(lgb + off); lb[nt][g] = *(const f32x4*)(lbb + off);
            }
        __builtin_amdgcn_sched_barrier(0);
#pragma unroll
        for (int nt = 0; nt < 2; ++nt)
#pragma unroll
            for (int g = 0; g < 4; ++g) {
                const int off = 512 * q + 32 * nt + 8 * g;
                f32x4 y;
#pragma unroll
                for (int i = 0; i < 4; ++i) y[i] = (vacc[q][nt][4 * g + i] - mean) * rstd * lg[nt][g][i] + lb[nt][g][i];
                *(f32x4*)(yb0 + off) = y;
            }
        __builtin_amdgcn_sched_barrier(0);
    }
    __syncthreads();
}


__device__ void p3s_arows(const Params& p, int k, unsigned char* lds) {
    int tid = threadIdx.x; asm volatile("" : "+v"(tid));
    const int lane = tid & 63, w = tid >> 6, l31 = lane & 31, hh = lane >> 5;
    const int r0 = 8 * k, h = w;
    const __bf16* QLR = (const __bf16*)(p.ws + WS_QLR);
    const float* DP = (const float*)(p.ws + WS_DPART);
    const float* lat_s = p.out + OUT_LATS;
    const float* kr_s = p.out + OUT_KRS;
    const __bf16* GM = (const __bf16*)(p.ws + WS_GM);
    const __bf16* GG = (const __bf16*)(p.ws + WS_GG);
    __bf16* AS = (__bf16*)(p.ws + WS_AS);
    unsigned char* OL = lds + LDS_BASE + w * 2304;
#pragma unroll 1
    for (int q0 = 0; q0 < 8; q0 += 4) {
        float qa[4], qb[4], qc[4], la[4], lb2[4], kc[4], mi[4][4], li[4][4];
        f32x2 ln[4], ov[4][4];
#pragma unroll
        for (int u = 0; u < 4; ++u) {
            const int bs = r0 + q0 + u;
            const __bf16* ql = QLR + ((size_t)bs * 8 + h) * 160;
            qa[u] = (float)ql[lane]; qb[u] = (float)ql[64 + lane]; qc[u] = (float)ql[128 + (lane & 31)];
            la[u] = lat_s[(size_t)bs * 128 + lane]; lb2[u] = lat_s[(size_t)bs * 128 + 64 + lane]; kc[u] = kr_s[(size_t)bs * 32 + (lane & 31)];
            ln[u] = *(const f32x2*)(lat_s + (size_t)bs * 128 + 2 * lane);
#pragma unroll
            for (int sp = 0; sp < 4; ++sp) {
                const float* d = DP + ((size_t)(bs * 4 + sp) * 8 + h) * 132;
                mi[u][sp] = d[0]; li[u][sp] = d[1]; ov[u][sp] = *(const f32x2*)(d + 4 + 2 * lane);
            }
        }
        __builtin_amdgcn_sched_barrier(0);
#pragma unroll
        for (int u = 0; u < 4; ++u) {
            float part = qa[u] * la[u] + qb[u] * lb2[u];
            if (lane < 32) part += qc[u] * kc[u];
            const float sn = wave_sum(part);
            float M = sn;
#pragma unroll
            for (int sp = 0; sp < 4; ++sp) M = fmaxf(M, mi[u][sp]);
            const float wn = ex2(sn - M);
            float L = wn, o0 = wn * ln[u][0], o1 = wn * ln[u][1];
#pragma unroll
            for (int sp = 0; sp < 4; ++sp) {
                const float wt = ex2(mi[u][sp] - M);
                L = fmaf(wt, li[u][sp], L); o0 = fmaf(wt, ov[u][sp][0], o0); o1 = fmaf(wt, ov[u][sp][1], o1);
            }
            const float inv = __builtin_amdgcn_rcpf(L);
            *(unsigned*)(OL + (q0 + u) * 288 + 4 * lane) = pk2(o0 * inv, o1 * inv);
        }
    }
    asm volatile("s_waitcnt lgkmcnt(0)" ::: "memory");
    {
        const __bf16* wuvt = (const __bf16*)(p.ws + WS_WUVT);
        f32x16 mo[2];
#pragma unroll
        for (int vt = 0; vt < 2; ++vt)
#pragma unroll
            for (int r = 0; r < 16; ++r) mo[vt][r] = 0.f;
        bf16x8 ob[8], wa[2][8];
        const int tk = (l31 < 8) ? l31 : 7;
#pragma unroll
        for (int ks = 0; ks < 8; ++ks) {
            ob[ks] = *(const bf16x8*)(OL + tk * 288 + (16 * ks + 8 * hh) * 2);
            wa[0][ks] = *(const bf16x8*)(wuvt + ((size_t)h * 64 + l31) * 128 + 16 * ks + 8 * hh);
            wa[1][ks] = *(const bf16x8*)(wuvt + ((size_t)h * 64 + 32 + l31) * 128 + 16 * ks + 8 * hh);
        }
        __builtin_amdgcn_sched_barrier(0);
#pragma unroll
        for (int ks = 0; ks < 8; ++ks)
#pragma unroll
            for (int vt = 0; vt < 2; ++vt) mo[vt] = mfma32(wa[vt][ks], ob[ks], mo[vt]);
        if (l31 < 8) {
#pragma unroll
            for (int vt = 0; vt < 2; ++vt)
#pragma unroll
                for (int g = 0; g < 4; ++g) {
                    const int v = 32 * vt + 8 * g + 4 * hh;
                    const u32x2 gm = *(const u32x2*)(GM + (size_t)(NTOK + r0 + l31) * 512 + h * 64 + v);
                    *(u32x2*)(AS + (size_t)(r0 + l31) * 1024 + h * 64 + v) =
                        pk4(mo[vt][4 * g] * bflo(gm.x), mo[vt][4 * g + 1] * bfhi(gm.x), mo[vt][4 * g + 2] * bflo(gm.y), mo[vt][4 * g + 3] * bfhi(gm.y));
                }
        }
    }
    {
        const float* GLAOS = (const float*)(p.ws + WS_GLAOS);
        f32x2 ov[4], gn[4]; unsigned gg[4];
#pragma unroll
        for (int u = 0; u < 4; ++u) {
            const int pr = w * 4 + u, t = pr >> 2, hg = pr & 3, bs = r0 + t;
            ov[u] = *(const f32x2*)(GLAOS + ((size_t)bs * 4 + hg) * 128 + 2 * lane);
            gn[u] = *(const f32x2*)(p.gla_norm_g + hg * 128 + 2 * lane);
            gg[u] = *(const unsigned*)(GG + (size_t)(NTOK + bs) * 512 + hg * 128 + 2 * lane);
        }
        __builtin_amdgcn_sched_barrier(0);
#pragma unroll
        for (int u = 0; u < 4; ++u) {
            const int pr = w * 4 + u, t = pr >> 2, hg = pr & 3, bs = r0 + t;
            const float ss = wave_sum(ov[u][0] * ov[u][0] + ov[u][1] * ov[u][1]);
            const float inv = rsqrtf(ss * (1.f / 128.f) + NORM_EPS);
            *(unsigned*)(AS + (size_t)bs * 1024 + 512 + hg * 128 + 2 * lane) = pk2(ov[u][0] * inv * gn[u][0] * bflo(gg[u]), ov[u][1] * inv * gn[u][1] * bfhi(gg[u]));
        }
    }
    __syncthreads();
}
__device__ void p3s_cols(const Params& p, int k, unsigned char* lds) {
    int tid = threadIdx.x; asm volatile("" : "+v"(tid));
    const int lane = tid & 63, w = tid >> 6, l31 = lane & 31, hh = lane >> 5;
    const int nt = w >> 1, mt = w & 1;
    unsigned char* A = lds + LDS_BASE;
    const __bf16* AS = (const __bf16*)(p.ws + WS_AS);
    const u32x4* woutf = (const u32x4*)(p.ws + WS_WOUTF);
    const float* mod = (const float*)(p.ws + WS_MOD);
    float* ST = (float*)(lds + LDS_BASE + 64 * XS);
    float* STATS = (float*)(p.ws + WS_STATS);
#pragma unroll 1
    for (int pass = 0; pass < 2; ++pass) {
        {
            u32x4 t[16];
#pragma unroll
            for (int i = 0; i < 16; ++i) { const int idx = i * NTHR + tid, row = idx >> 7, ch = idx & 127; t[i] = *(const u32x4*)(AS + (size_t)(64 * pass + row) * 1024 + 8 * ch); }
            __builtin_amdgcn_sched_barrier(0);
#pragma unroll
            for (int i = 0; i < 16; ++i) { const int idx = i * NTHR + tid, row = idx >> 7, ch = idx & 127; *(u32x4*)(A + row * XS + ch * 16) = t[i]; }
        }
        __syncthreads();
        f32x16 acc;
#pragma unroll
        for (int r = 0; r < 16; ++r) acc[r] = 0.f;
        const int row = 64 * pass + 32 * mt + l31;
        const int ncol = 128 * k + 32 * nt + 4 * hh;
        f32x4 xv[4], gt[4];
#pragma unroll
        for (int g = 0; g < 4; ++g) { xv[g] = *(const f32x4*)(p.x_sample + (size_t)row * 1024 + ncol + 8 * g); gt[g] = *(const f32x4*)(mod + (size_t)(8 + row) * 3072 + 2048 + ncol + 8 * g); }
        {
            const unsigned char* x0 = A + (32 * mt + l31) * XS + hh * 16;
            const u32x4* w0 = woutf + (size_t)(4 * k + nt) * 64 * 64 + lane;
            u32x4 ra[8];
#pragma unroll
            for (int u = 0; u < 8; ++u) ra[u] = w0[u * 64];
#pragma unroll 1
            for (int k0 = 0; k0 < 64; k0 += 8) {
#pragma unroll
                for (int u = 0; u < 8; ++u) {
                    const int ks = k0 + u;
                    const bf16x8 b0 = *(const bf16x8*)(x0 + ks * 32);
                    const bf16x8 a0 = __builtin_bit_cast(bf16x8, ra[u]);
                    ra[u] = w0[(ks + 8) * 64];
                    __builtin_amdgcn_sched_barrier(0);
                    acc = mfma32(a0, b0, acc);
                    __builtin_amdgcn_sched_barrier(0);
                }
            }
        }
        float s1 = 0.f, s2 = 0.f;
        float* yb = p.out + OUT_YS + (size_t)row * 1024 + ncol;
#pragma unroll
        for (int g = 0; g < 4; ++g) {
            f32x4 v;
#pragma unroll
            for (int i = 0; i < 4; ++i) { v[i] = DN_ALPHA * xv[g][i] + gt[g][i] * acc[4 * g + i]; s1 += v[i]; s2 = fmaf(v[i], v[i], s2); }
            *(f32x4*)(yb + 8 * g) = v;
        }
        s1 += __shfl_xor(s1, 32); s2 += __shfl_xor(s2, 32);
        if (hh == 0) { ST[(w * 32 + l31) * 2] = s1; ST[(w * 32 + l31) * 2 + 1] = s2; }
        __syncthreads();
        if (tid < 64) {
            const int m2 = tid >> 5, tk = tid & 31;
            float a = 0.f, bq = 0.f;
#pragma unroll
            for (int n2 = 0; n2 < 4; ++n2) { a += ST[((2 * n2 + m2) * 32 + tk) * 2]; bq += ST[((2 * n2 + m2) * 32 + tk) * 2 + 1]; }
            STATS[((size_t)k * NDEC + 64 * pass + tid) * 2] = a; STATS[((size_t)k * NDEC + 64 * pass + tid) * 2 + 1] = bq;
        }
        __syncthreads();
    }
}
__device__ void p3s_ln(const Params& p, int k, unsigned char* lds) {
    int tid = threadIdx.x; asm volatile("" : "+v"(tid));
    const int row = 32 * k + (tid >> 4), c0 = (tid & 15) * 64;
    const float* STATS = (const float*)(p.ws + WS_STATS);
    float a = 0.f, bq = 0.f;
#pragma unroll
    for (int j = 0; j < 8; ++j) { a += STATS[((size_t)j * NDEC + row) * 2]; bq += STATS[((size_t)j * NDEC + row) * 2 + 1]; }
    const float mean = a * (1.f / 1024.f);
    const float rstd = rsqrtf(fmaxf(bq * (1.f / 1024.f) - mean * mean, 0.f) + NORM_EPS);
    float* y = p.out + OUT_YS + (size_t)row * 1024 + c0;
    f32x4 v[16];
#pragma unroll
    for (int i = 0; i < 16; ++i) v[i] = *(const f32x4*)(y + 4 * i);
    __builtin_amdgcn_sched_barrier(0);
#pragma unroll
    for (int i = 0; i < 16; ++i) {
        const f32x4 lg = *(const f32x4*)(p.ln_g + c0 + 4 * i), lb = *(const f32x4*)(p.ln_b + c0 + 4 * i);
        f32x4 o;
#pragma unroll
        for (int e = 0; e < 4; ++e) o[e] = (v[i][e] - mean) * rstd * lg[e] + lb[e];
        *(f32x4*)(y + 4 * i) = o;
    }
}

__device__ __forceinline__ int q_next(unsigned* cnt, unsigned char* lds) {
    volatile LAS unsigned* slot = (volatile LAS unsigned*)(lds + 16);
    __syncthreads();
    if (threadIdx.x == 0) *slot = __hip_atomic_fetch_add(cnt, 1u, __ATOMIC_RELAXED, __HIP_MEMORY_SCOPE_AGENT);
    __syncthreads();
    return (int)*slot;
}
__device__ __forceinline__ void signal_done(unsigned* cnt) {
    asm volatile("s_waitcnt vmcnt(0)" ::: "memory");
    __syncthreads();
    if (threadIdx.x == 0) {
        __builtin_amdgcn_fence(__ATOMIC_RELEASE, "agent");
        asm volatile("s_waitcnt vmcnt(0)" ::: "memory");
        (void)__hip_atomic_fetch_add(cnt, 1u, __ATOMIC_RELAXED, __HIP_MEMORY_SCOPE_AGENT);
    }
}
__device__ __forceinline__ void wait_count(unsigned* bar, unsigned* cnt, unsigned want) {
    if (threadIdx.x == 0) {
        XB_SPIN(xb_ld(cnt) < want, bar);
        __builtin_amdgcn_fence(__ATOMIC_ACQUIRE, "agent");
        asm volatile("s_waitcnt vmcnt(0)" ::: "memory");
    }
    __syncthreads();
}

__global__ void __launch_bounds__(NTHR) fwd_mega(Params p, int ph_lo, int ph_hi, int use_bar) {
    extern __shared__ __attribute__((aligned(16))) unsigned char lds[];
    const int tid = threadIdx.x;
    if (use_bar) {
        if (tid == 0) { *(u32x4*)lds = (u32x4){0u, 0u, 0u, 0u}; }
        __syncthreads();
        (void)xcd_barrier_post((unsigned*)(p.ws + WS_CTL), (volatile LAS unsigned*)lds);
    }
    const int G = gridDim.x, bid = blockIdx.x;
    unsigned* ctl = (unsigned*)(p.ws + WS_CTL);
    for (int ph = ph_lo; ph < ph_hi; ++ph) {
        for (int rep = 0; rep < ((ph == REP_PH) ? 2 : 1); ++rep) {
        if (ph == 0) {
            for (int item = bid; item < 96; item += G) p0_mod_item(p, item, lds);
            p0_convert(p);
        } else if (ph == 1) {
            const bool isD = (bid >> 3) < ND_CU8;
            bool sample_ok = false, b17_ok = false, b0_ok = false;
            bool exG = false, exA = false, exB = false, exF = false, exD = false, exE = false;
            unsigned* qc = ctl + CW_Q2 + 32 * rep;
            int stage = (bid < 10) ? 0 : 1, local = 0;
            for (;;) {
                int kind, a0, a1;
                if (stage == 0) { kind = 0; if (bid < 2) { a0 = 256 + bid; a1 = 1; } else { a0 = 256 + ((bid - 2) >> 2); a1 = 2 + ((bid - 2) & 3); } }
                else if (stage == 1) { a0 = bid + local * G; ++local; kind = 0; a1 = 0; if (a0 >= 256) { stage = 2; continue; } }
                else {
                    int q;
                    if (isD) { if (!exD) q = 4; else if (!exA) q = 1; else if (!exF) q = 3; else if (!exB) q = 2; else if (!exG) q = 0; else if (!exE) q = 5; else break; }
                    else { if (!exG) q = 0; else if (!exA) q = 1; else if (!exB) q = 2; else if (!exF) q = 3; else if (!exD) q = 4; else if (!exE) q = 5; else break; }
                    const int i = q_next(qc + 4 * q, lds);
                    a1 = 0;
                    if (q == 0) { if (i >= 28) { exG = true; continue; } kind = 1; a0 = i + 4; }
                    else if (q == 1) { if (i >= 168) { exA = true; continue; } const int qd = i / 56; kind = 2; a0 = 8 + (i - 56 * qd); a1 = 7 - qd; }
                    else if (q == 2) { if (i >= 68) { exB = true; continue; } if (i < 4) { kind = 1; a0 = i; } else { kind = 2; a0 = (i - 4) & 7; a1 = 7 - ((i - 4) >> 3); } }
                    else if (q == 3) { if (i >= 168) { exF = true; continue; } const int qd = i / 56; kind = 2; a0 = 8 + (i - 56 * qd); a1 = 4 - qd; }
                    else if (q == 4) { if (i >= 640) { exD = true; continue; } if (i < 128) { kind = 3; a0 = i; } else { kind = 4; a0 = (i - 128) >> 2; a1 = (i - 128) & 3; } }
                    else { if (i >= 112) { exE = true; continue; } const int qd = i / 56; kind = 2; a0 = 8 + (i - 56 * qd); a1 = 1 - qd; }
                }
                if (kind >= 3 && !sample_ok) { wait_count(ctl, ctl + CW_SAMPLE, 10u * (rep + 1)); sample_ok = true; }
                if (kind == 1 || kind == 2) {
                    const int b = (kind == 1) ? (a0 >> 2) : (a0 >> 3);
                    if (b == 0) { if (!b0_ok) { wait_count(ctl, ctl + CW_B0, 32u * (rep + 1)); b0_ok = true; } }
                    else if (!b17_ok) { wait_count(ctl, ctl + CW_B17, 224u * (rep + 1)); b17_ok = true; }
                }
                if (kind == 0) {
                    p1_stripe(p, a0, a1, lds);
                    if (stage == 0) { signal_done(ctl + CW_SAMPLE); stage = 1; } else signal_done((a0 >> 5) == 0 ? ctl + CW_B0 : ctl + CW_B17);
                }
                else if (kind == 1) p2_scan(p, a0);
                else if (kind == 2) p2_attn(p, a0, a1, lds);
                else if (kind == 3) p2_glarec(p, a0, lds);
                else p2_decode(p, a0, a1, lds);
            }
        } else if (ph == 2) {
        } else {
            for (;;) {
                const int qi = q_next(ctl + CW_Q3 + 16 * rep, lds);
                if (qi >= 540) break;
                if (qi < 16) { p3s_arows(p, qi, lds); signal_done(ctl + CW_AS); }
                else if (qi < 272) p3_stripe(p, qi - 16, lds);
                else if (qi < 280) { wait_count(ctl, ctl + CW_AS, 16u * (rep + 1)); p3s_cols(p, qi - 272, lds); signal_done(ctl + CW_COL); }
                else if (qi < 536) p3_stripe(p, qi - 280 + 256, lds);
                else { wait_count(ctl, ctl + CW_COL, 8u * (rep + 1)); p3s_ln(p, qi - 536, lds); }
            }
        }
        }
        if (use_bar && ph + 1 < ph_hi && ph != 1) {
            XcdBarrier xb; xb.bar = (unsigned*)(p.ws + WS_CTL); xb.x = xb_xcc_id(); xb.st = (volatile LAS unsigned*)lds;
            xcd_barrier(xb);
        }
    }
}


extern "C" void kernel_launch(void* const* d_in, const int* in_sizes, int n_in, void* d_out, int out_size, void* d_ws, size_t ws_size, hipStream_t stream) {
    static int grid = 0;
    if (grid == 0) {
        if (n_in != 22 || (size_t)out_size != OUT_END || ws_size < WS_END) { fprintf(stderr, "kernel_launch: unexpected shapes (n_in %d out %d ws %zu)\n", n_in, out_size, ws_size); grid = -1; return; }
        int dev = 0, cus = 0, per_cu = 0;
        if (hipGetDevice(&dev) != hipSuccess || hipDeviceGetAttribute(&cus, hipDeviceAttributeMultiprocessorCount, dev) != hipSuccess) { grid = -1; return; }
        if (hipFuncSetAttribute((const void*)fwd_mega, hipFuncAttributeMaxDynamicSharedMemorySize, LDS_BYTES) != hipSuccess) { fprintf(stderr, "kernel_launch: hipFuncSetAttribute failed\n"); grid = -1; return; }
        if (hipOccupancyMaxActiveBlocksPerMultiprocessor(&per_cu, (const void*)fwd_mega, NTHR, LDS_BYTES) != hipSuccess || per_cu < 1) { fprintf(stderr, "kernel_launch: occupancy query says %d\n", per_cu); grid = -1; return; }
        (void)hipGetLastError();
        grid = cus;
    }
    if (grid < 0) return;
    Params p{};
    p.x_prompt = (const float*)d_in[0]; p.x_sample = (const float*)d_in[1]; p.cache_lat = (const float*)d_in[2]; p.cache_kr = (const float*)d_in[3];
    p.state_gla = (const float*)d_in[4]; p.page_table = (const int*)d_in[5]; p.c_prompt = (const float*)d_in[6]; p.c_sample = (const float*)d_in[7];
    p.w_ada = (const float*)d_in[8]; p.b_ada = (const float*)d_in[9]; p.w_in = (const float*)d_in[10]; p.q_norm_g = (const float*)d_in[11];
    p.w_uq = (const float*)d_in[12]; p.kv_norm_g = (const float*)d_in[13]; p.w_uk = (const float*)d_in[14]; p.w_uv = (const float*)d_in[15];
    p.w_gate_up = (const float*)d_in[16]; p.b_gate = (const float*)d_in[17]; p.gla_norm_g = (const float*)d_in[18]; p.w_out = (const float*)d_in[19];
    p.ln_g = (const float*)d_in[20]; p.ln_b = (const float*)d_in[21];
    p.out = (float*)d_out; p.ws = (unsigned char*)d_ws;
    if (hipMemsetAsync((char*)d_ws + WS_CTL, 0, CTL_BYTES, stream) != hipSuccess) { fprintf(stderr, "kernel_launch: memset failed\n"); return; }
#if N_LAUNCHES == 1
    hipLaunchKernelGGL(fwd_mega, dim3(grid), dim3(NTHR), LDS_BYTES, stream, p, 0, 4, 1);
#else
    for (int ph = 0; ph < 4; ++ph) hipLaunchKernelGGL(fwd_mega, dim3(grid), dim3(NTHR), LDS_BYTES, stream, p, ph, ph + 1, 0);
#endif
    const hipError_t le = hipPeekAtLastError();
    if (le != hipSuccess) fprintf(stderr, "kernel_launch: launch failed: %s\n", hipGetErrorName(le));
}
```

```cpp
#include <hip/hip_runtime.h>
#include <cstdint>
#include <cstdio>

typedef __bf16 bf16x8 __attribute__((ext_vector_type(8)));
typedef __bf16 bf16x4 __attribute__((ext_vector_type(4)));
typedef __bf16 bf16x2 __attribute__((ext_vector_type(2)));
typedef float f32x16 __attribute__((ext_vector_type(16)));
typedef float f32x4 __attribute__((ext_vector_type(4)));
typedef float f32x2 __attribute__((ext_vector_type(2)));
typedef unsigned u32x4 __attribute__((ext_vector_type(4)));
typedef unsigned u32x2 __attribute__((ext_vector_type(2)));

#define NTHR 512
#define N_LAUNCHES 1
#define REP_PH (-1)
#define LDS_BYTES 143360
#define LDS_BASE 256

constexpr int DM = 1024, SEQ = 2048, NB = 8, NTOK = 16384, NDEC = 128, RT = NTOK + NDEC;
constexpr int NPAGES = 64;
constexpr float NORM_EPS = 1e-6f;
constexpr float LOG2E = 1.4426950408889634f;
constexpr float QSCALE = 0.10206207261596577f * 1.4426950408889634f;
constexpr float DN_ALPHA = 1.189207115002721f;

constexpr size_t OUT_YP = 0;
constexpr size_t OUT_YS = OUT_YP + (size_t)NTOK * 1024;
constexpr size_t OUT_LATP = OUT_YS + (size_t)NDEC * 1024;
constexpr size_t OUT_KRP = OUT_LATP + (size_t)NTOK * 128;
constexpr size_t OUT_STP = OUT_KRP + (size_t)NTOK * 32;
constexpr size_t OUT_LATS = OUT_STP + (size_t)NB * 4 * 64 * 128;
constexpr size_t OUT_KRS = OUT_LATS + (size_t)NDEC * 128;
constexpr size_t OUT_STS = OUT_KRS + (size_t)NDEC * 32;
constexpr size_t OUT_END = OUT_STS + (size_t)NDEC * 4 * 64 * 128;

constexpr size_t al256(size_t x) { return (x + 255) & ~(size_t)255; }
constexpr size_t WS_CTL = 0;
constexpr size_t CTL_BYTES = 16384;
constexpr size_t WS_MOD = WS_CTL + CTL_BYTES;
constexpr size_t WS_ROPE = WS_MOD + al256((size_t)136 * 3072 * 4);
constexpr size_t WS_WINF = WS_ROPE + al256((size_t)2049 * 32 * 4);
constexpr size_t WS_WUQF = WS_WINF + (size_t)78 * 64 * 1024;
constexpr size_t WS_WKVF = WS_WUQF + (size_t)24 * 16 * 1024;
constexpr size_t WS_WOUTF = WS_WKVF + (size_t)32 * 8 * 1024;
constexpr size_t WS_WUKB = WS_WOUTF + (size_t)32 * 64 * 1024;
constexpr size_t WS_WUVT = WS_WUKB + (size_t)65536 * 2;
constexpr size_t WS_GM = WS_WUVT + (size_t)65536 * 2;
constexpr size_t WS_GQ = WS_GM + al256((size_t)RT * 512 * 2);
constexpr size_t WS_GK = WS_GQ + al256((size_t)RT * 256 * 2);
constexpr size_t WS_GV = WS_GK + al256((size_t)RT * 256 * 2);
constexpr size_t WS_GG = WS_GV + al256((size_t)RT * 512 * 2);
constexpr size_t WS_LAB = WS_GG + al256((size_t)RT * 512 * 2);
constexpr size_t WS_BT = WS_LAB + al256((size_t)RT * 256 * 4);
constexpr size_t WS_GKT = WS_BT + (size_t)NB * 4 * 64 * 2048 * 4;
constexpr size_t WS_GVT = WS_GKT + (size_t)NB * 4 * 64 * 2048 * 2;
constexpr size_t WS_Q = WS_GVT + (size_t)NB * 4 * 128 * 2048 * 2;
constexpr size_t WS_KN = WS_Q + (size_t)NB * 8 * 2048 * 96 * 2;
constexpr size_t WS_KR = WS_KN + (size_t)NB * 8 * 2048 * 64 * 2;
constexpr size_t WS_VT = WS_KR + (size_t)NB * 2048 * 32 * 2;
constexpr size_t WS_AO = WS_VT + (size_t)NB * 8 * 64 * 2048 * 2;
constexpr size_t WS_ST2 = WS_AO + (size_t)NTOK * 512 * 2;
constexpr size_t WS_BL = WS_ST2 + (size_t)NB * 4 * 32 * 128 * 64 * 2;
constexpr size_t WS_QLR = WS_BL + (size_t)NB * 4 * 32 * 64 * 4;
constexpr size_t WS_DPART = WS_QLR + al256((size_t)NDEC * 8 * 160 * 2);
constexpr size_t WS_GLAOS = WS_DPART + al256((size_t)NDEC * 4 * 8 * 132 * 4);
constexpr size_t WS_OLAT = WS_GLAOS + al256((size_t)NDEC * 4 * 128 * 4);
constexpr size_t WS_AS = WS_OLAT + al256((size_t)NDEC * 8 * 128 * 2);
constexpr size_t WS_STATS = WS_AS + (size_t)NDEC * 1024 * 2;
constexpr size_t WS_SC = WS_STATS + (size_t)8 * NDEC * 2 * 4;
constexpr size_t WS_END = WS_SC + (size_t)5 * 64 * 64 * 16;

struct Params {
    const float* x_prompt; const float* x_sample; const float* cache_lat; const float* cache_kr; const float* state_gla;
    const int* page_table; const float* c_prompt; const float* c_sample;
    const float* w_ada; const float* b_ada; const float* w_in; const float* q_norm_g; const float* w_uq; const float* kv_norm_g;
    const float* w_uk; const float* w_uv; const float* w_gate_up; const float* b_gate; const float* gla_norm_g;
    const float* w_out; const float* ln_g; const float* ln_b;
    float* out; unsigned char* ws;
};

__device__ __forceinline__ f32x16 mfma32(bf16x8 a, bf16x8 b, f32x16 c) { return __builtin_amdgcn_mfma_f32_32x32x16_bf16(a, b, c, 0, 0, 0); }
__device__ __forceinline__ unsigned pk2(float lo, float hi) { bf16x2 v = {(__bf16)lo, (__bf16)hi}; return __builtin_bit_cast(unsigned, v); }
__device__ __forceinline__ u32x2 pk4(float a, float b, float c, float d) { u32x2 r; r.x = pk2(a, b); r.y = pk2(c, d); return r; }
__device__ __forceinline__ float bflo(unsigned u) { return __builtin_bit_cast(float, u << 16); }
__device__ __forceinline__ float bfhi(unsigned u) { return __builtin_bit_cast(float, u & 0xffff0000u); }
__device__ __forceinline__ float siluf(float x) { return x * __builtin_amdgcn_rcpf(1.f + __expf(-x)); }
__device__ __forceinline__ float ex2(float x) { return __builtin_amdgcn_exp2f(x); }
__device__ __forceinline__ float mul1(float a, float b) { float t = a * b; asm("" : "+v"(t)); return t; }
template <int CTRL> __device__ __forceinline__ float dppf(float x) { return __builtin_bit_cast(float, __builtin_amdgcn_mov_dpp(__builtin_bit_cast(int, x), CTRL, 0xf, 0xf, true)); }
__device__ __forceinline__ float xor32_sum(float x) { auto t = __builtin_amdgcn_permlane32_swap(__float_as_uint(x), __float_as_uint(x), false, false); return __uint_as_float(t[0]) + __uint_as_float(t[1]); }
__device__ __forceinline__ float xor32_max(float x) { auto t = __builtin_amdgcn_permlane32_swap(__float_as_uint(x), __float_as_uint(x), false, false); return fmaxf(__uint_as_float(t[0]), __uint_as_float(t[1])); }
__device__ __forceinline__ float xor16_sum(float x) { auto t = __builtin_amdgcn_permlane16_swap(__float_as_uint(x), __float_as_uint(x), false, false); return __uint_as_float(t[0]) + __uint_as_float(t[1]); }
__device__ __forceinline__ float xor16_max(float x) { auto t = __builtin_amdgcn_permlane16_swap(__float_as_uint(x), __float_as_uint(x), false, false); return fmaxf(__uint_as_float(t[0]), __uint_as_float(t[1])); }
__device__ __forceinline__ float wave_sum(float v) {
    v += dppf<0xB1>(v);
    v += dppf<0x4E>(v);
    v += dppf<0x141>(v);
    v += dppf<0x140>(v);
    v = xor16_sum(v);
    return xor32_sum(v);
}
__device__ __forceinline__ bf16x8 cvt8(f32x4 a, f32x4 b) {
    bf16x8 r; r[0] = (__bf16)a[0]; r[1] = (__bf16)a[1]; r[2] = (__bf16)a[2]; r[3] = (__bf16)a[3]; r[4] = (__bf16)b[0]; r[5] = (__bf16)b[1]; r[6] = (__bf16)b[2]; r[7] = (__bf16)b[3]; return r;
}
__device__ __forceinline__ void unpack8(u32x4 u, float (&f)[8]) {
    f[0] = bflo(u.x); f[1] = bfhi(u.x); f[2] = bflo(u.y); f[3] = bfhi(u.y); f[4] = bflo(u.z); f[5] = bfhi(u.z); f[6] = bflo(u.w); f[7] = bfhi(u.w);
}
__device__ __forceinline__ u32x4 widen_pair(u32x2 a, u32x2 b) {
    const auto rx = __builtin_amdgcn_permlane32_swap(a.x, b.x, false, false);
    const auto ry = __builtin_amdgcn_permlane32_swap(a.y, b.y, false, false);
    u32x4 o; o.x = rx[0]; o.y = ry[0]; o.z = rx[1]; o.w = ry[1];
    return o;
}
__device__ __forceinline__ int permpos(int s) { return (s & ~12) | ((s & 4) << 1) | ((s & 8) >> 1); }

#define XB_TMO      128
#define XB_XCNT(j)  (256  + 64 * (j))
#define XB_XSUB(j)  (1280 + 64 * (j))
#define XB_XGEN(j)  (2304 + 64 * (j))
#define XB_TOP      3328
#define XB_TOPGEN   3392
#define XCD_BAR_WORDS 3456
#define CW_Q2 3520
#define CW_Q3 3584
#define CW_SAMPLE 3648
#define CW_AS 3712
#define CW_COL 3776
#define CW_SC 3840
#define XB_SPIN_CAP (1u << 22)
#define LAS __attribute__((address_space(3)))
__device__ __forceinline__ unsigned xb_ld(unsigned* p)              { return __hip_atomic_load(p, __ATOMIC_RELAXED, __HIP_MEMORY_SCOPE_AGENT); }
__device__ __forceinline__ unsigned xb_add(unsigned* p, unsigned v) { return __hip_atomic_fetch_add(p, v, __ATOMIC_RELAXED, __HIP_MEMORY_SCOPE_AGENT); }
__device__ __forceinline__ unsigned xb_xcc_id() { return (unsigned)__builtin_amdgcn_s_getreg((3 << 11) | 20) & 0xFu; }
#define XB_SPIN(cond, bar) do { unsigned _sp = 0; while (cond) { __builtin_amdgcn_s_sleep(1); \
    if ((++_sp & 255u) == 0u) { if (xb_ld(&(bar)[XB_TMO])) break; if (_sp > XB_SPIN_CAP) { atomicAdd(&(bar)[XB_TMO], 1u); break; } } } } while (0)
struct XcdBarrier { unsigned* bar; unsigned x; volatile LAS unsigned* st; };
__device__ __forceinline__ XcdBarrier xcd_barrier_post(unsigned* bar, volatile LAS unsigned* st) {
    XcdBarrier b; b.bar = bar; b.x = xb_xcc_id(); b.st = st;
    if (threadIdx.x == 0) (void)xb_add(&bar[XB_XCNT(b.x)], 1u);
    return b;
}
__device__ __forceinline__ void xcd_barrier_complete(unsigned* bar, unsigned x, unsigned& nloc, unsigned& nx) {
    const unsigned G = gridDim.x * gridDim.y * gridDim.z;
    unsigned sum, cnt, mine, sp = 0u;
    for (;;) {
        sum = 0u; cnt = 0u; mine = 0u;
#pragma unroll
        for (unsigned j = 0; j < 16; ++j) { const unsigned c = xb_ld(&bar[XB_XCNT(j)]); sum += c; cnt += (c > 0u) ? 1u : 0u; mine = (j == x) ? c : mine; }
        if (sum == G) break;
        __builtin_amdgcn_s_sleep(1);
        if ((++sp & 255u) == 0u) { if (xb_ld(&bar[XB_TMO])) break; if (sp > XB_SPIN_CAP) { atomicAdd(&bar[XB_TMO], 1u); break; } }
    }
    nloc = mine > 0u ? mine : 1u; nx = cnt > 0u ? cnt : 1u;
}
__device__ __forceinline__ void xcd_barrier(const XcdBarrier& b) {
    asm volatile("s_waitcnt vmcnt(0)" ::: "memory");
    __syncthreads();
    if (threadIdx.x == 0) {
        unsigned* bar = b.bar;
        __builtin_amdgcn_s_waitcnt(0);
        unsigned nloc = b.st[0], nx = b.st[1];
        if (nloc == 0u) { xcd_barrier_complete(bar, b.x, nloc, nx); b.st[0] = nloc; b.st[1] = nx; }
        const unsigned old = xb_add(&bar[XB_XSUB(b.x)], 1u);
        const unsigned gen = old / nloc;
        if (old + 1u == (gen + 1u) * nloc) {
            __builtin_amdgcn_fence(__ATOMIC_RELEASE, "agent");
            asm volatile("s_waitcnt vmcnt(0)" ::: "memory");
            const unsigned og = xb_add(&bar[XB_TOP], 1u);
            const unsigned tg = og / nx;
            if (og + 1u == (tg + 1u) * nx) xb_add(&bar[XB_TOPGEN], 1u);
            else XB_SPIN(xb_ld(&bar[XB_TOPGEN]) == tg, bar);
            __builtin_amdgcn_fence(__ATOMIC_ACQUIRE, "agent");
            xb_add(&bar[XB_XGEN(b.x)], 1u);
            asm volatile("s_waitcnt vmcnt(0)" ::: "memory");
        } else {
            XB_SPIN(xb_ld(&bar[XB_XGEN(b.x)]) == gen, bar);
            __builtin_amdgcn_fence(__ATOMIC_ACQUIRE, "agent");
            asm volatile("s_waitcnt vmcnt(0)" ::: "memory");
        }
    }
    __syncthreads();
}

template <int KS, bool SW>
__device__ __forceinline__ void gemm_2x2(const u32x4* __restrict__ wf, const unsigned char* xl, int xstride, int lane, f32x16 (&acc)[2][2]) {
    constexpr int PF = 8;
    static_assert(KS % PF == 0, "KS must be a multiple of the prefetch depth");
    const int l31 = lane & 31, hh = lane >> 5;
    const unsigned char* x0 = xl + l31 * xstride + hh * 16;
    const unsigned char* x1 = x0 + 32 * xstride;
    const u32x4* w0 = wf + lane;
    const u32x4* w1 = wf + KS * 64 + lane;
    u32x4 ra[PF], rb[PF];
#pragma unroll
    for (int u = 0; u < PF; ++u) { ra[u] = w0[u * 64]; rb[u] = w1[u * 64]; }
#pragma unroll 1
    for (int k0 = 0; k0 < KS; k0 += PF) {
#pragma unroll
        for (int u = 0; u < PF; ++u) {
            const int ks = k0 + u;
            const bf16x8 b0 = *(const bf16x8*)(x0 + ks * 32);
            const bf16x8 b1 = *(const bf16x8*)(x1 + ks * 32);
            const bf16x8 a0 = __builtin_bit_cast(bf16x8, ra[u]);
            const bf16x8 a1 = __builtin_bit_cast(bf16x8, rb[u]);
            if (KS > PF) { ra[u] = w0[(ks + PF) * 64]; rb[u] = w1[(ks + PF) * 64]; }
            __builtin_amdgcn_sched_barrier(0);
            if (SW) {
                acc[0][0] = mfma32(a0, b0, acc[0][0]); acc[0][1] = mfma32(a0, b1, acc[0][1]);
                acc[1][0] = mfma32(a1, b0, acc[1][0]); acc[1][1] = mfma32(a1, b1, acc[1][1]);
            } else {
                acc[0][0] = mfma32(b0, a0, acc[0][0]); acc[0][1] = mfma32(b1, a0, acc[0][1]);
                acc[1][0] = mfma32(b0, a1, acc[1][0]); acc[1][1] = mfma32(b1, a1, acc[1][1]);
            }
            __builtin_amdgcn_sched_barrier(0);
        }
    }
}
constexpr int GPF = 8;
template <int KS, bool SW, int KSTR = KS>
__device__ __forceinline__ void gemm_2x2_stream(const u32x4* __restrict__ wf, const u32x4* __restrict__ wfn, bool fill, const unsigned char* xl, int xstride, int lane,
                                                f32x16 (&acc)[2][2], u32x4 (&ra)[GPF], u32x4 (&rb)[GPF]) {
    static_assert(KS % GPF == 0 && KS >= 2 * GPF, "KS must be a multiple of (and larger than) the prefetch depth");
    const int l31 = lane & 31, hh = lane >> 5;
    const unsigned char* x0 = xl + l31 * xstride + hh * 16;
    const unsigned char* x1 = x0 + 32 * xstride;
    const u32x4* w0 = wf + lane;
    const u32x4* w1 = wf + KSTR * 64 + lane;
    if (fill) {
#pragma unroll
        for (int u = 0; u < GPF; ++u) { ra[u] = w0[u * 64]; rb[u] = w1[u * 64]; }
    }
    bf16x8 b0 = *(const bf16x8*)(x0), b1 = *(const bf16x8*)(x1);
#pragma unroll 1
    for (int k0 = 0; k0 < KS; k0 += GPF) {
        const bool last = (k0 + GPF >= KS);
        const u32x4* n0 = last ? (wfn + lane) : (w0 + (k0 + GPF) * 64);
        const u32x4* n1 = last ? (wfn + KSTR * 64 + lane) : (w1 + (k0 + GPF) * 64);
#pragma unroll
        for (int u = 0; u < GPF; ++u) {
            const int ks = k0 + u;
            const bf16x8 nb0 = *(const bf16x8*)(x0 + (ks + 1) * 32);
            const bf16x8 nb1 = *(const bf16x8*)(x1 + (ks + 1) * 32);
            const bf16x8 a0 = __builtin_bit_cast(bf16x8, ra[u]);
            const bf16x8 a1 = __builtin_bit_cast(bf16x8, rb[u]);
            ra[u] = n0[u * 64]; rb[u] = n1[u * 64];
            __builtin_amdgcn_sched_barrier(0);
            if (SW) {
                acc[0][0] = mfma32(a0, b0, acc[0][0]); acc[0][1] = mfma32(a0, b1, acc[0][1]);
                acc[1][0] = mfma32(a1, b0, acc[1][0]); acc[1][1] = mfma32(a1, b1, acc[1][1]);
            } else {
                acc[0][0] = mfma32(b0, a0, acc[0][0]); acc[0][1] = mfma32(b1, a0, acc[0][1]);
                acc[1][0] = mfma32(b0, a1, acc[1][0]); acc[1][1] = mfma32(b1, a1, acc[1][1]);
            }
            __builtin_amdgcn_sched_barrier(0);
            b0 = nb0; b1 = nb1;
        }
    }
}
__device__ __forceinline__ void zero_acc(f32x16 (&acc)[2][2]) {
#pragma unroll
    for (int a = 0; a < 2; ++a)
#pragma unroll
        for (int b = 0; b < 2; ++b)
#pragma unroll
            for (int r = 0; r < 16; ++r) acc[a][b][r] = 0.f;
}
template <int MODE>
__device__ __forceinline__ void store_nat(const f32x16 (&acc)[2][2], __bf16* dst, int ld, int col0, int lane) {
    const int l31 = lane & 31, hh = lane >> 5;
#pragma unroll
    for (int nt = 0; nt < 2; ++nt)
#pragma unroll
        for (int mt = 0; mt < 2; ++mt)
#pragma unroll
            for (int gp = 0; gp < 2; ++gp) {
                u32x2 pc[2];
#pragma unroll
                for (int gg = 0; gg < 2; ++gg) {
                    const int g = 2 * gp + gg;
                    float v[4];
#pragma unroll
                    for (int i = 0; i < 4; ++i) {
                        float t = acc[nt][mt][4 * g + i];
                        if (MODE == 1) t = siluf(t);
                        if (MODE == 2) t *= 0.125f;
                        if (MODE == 3) t *= QSCALE;
                        v[i] = t;
                    }
                    pc[gg] = pk4(v[0], v[1], v[2], v[3]);
                }
                *(u32x4*)(dst + (size_t)(32 * mt + l31) * ld + col0 + 32 * nt + 16 * gp + 8 * hh) = widen_pair(pc[0], pc[1]);
            }
}
template <int MODE>
__device__ __forceinline__ void store_frag8(const f32x16 (&acc)[2][2], __bf16* dst, int head, int lane) {
#pragma unroll
    for (int nt = 0; nt < 2; ++nt)
#pragma unroll
        for (int mt = 0; mt < 2; ++mt)
#pragma unroll
            for (int gp = 0; gp < 2; ++gp) {
                u32x2 pc[2];
#pragma unroll
                for (int gg = 0; gg < 2; ++gg) {
                    const int g = 2 * gp + gg;
                    float v[4];
#pragma unroll
                    for (int i = 0; i < 4; ++i) { float t = acc[nt][mt][4 * g + i]; if (MODE == 2) t = mul1(t, 0.125f); v[i] = t; }
                    pc[gg] = pk4(v[0], v[1], v[2], v[3]);
                }
                *(u32x4*)(dst + ((size_t)((mt * 4 + head) * 4 + 2 * nt + gp) * 64 + lane) * 8) = widen_pair(pc[0], pc[1]);
            }
}
__device__ __forceinline__ void store_lane16_silu(const f32x16 (&acc)[2][2], __bf16* dst, int tile, int lane) {
#pragma unroll
    for (int nt = 0; nt < 2; ++nt)
#pragma unroll
        for (int mt = 0; mt < 2; ++mt)
#pragma unroll
            for (int gp = 0; gp < 2; ++gp) {
                u32x2 pc[2];
#pragma unroll
                for (int gg = 0; gg < 2; ++gg) {
                    const int g = 2 * gp + gg;
                    pc[gg] = pk4(siluf(acc[nt][mt][4 * g]), siluf(acc[nt][mt][4 * g + 1]), siluf(acc[nt][mt][4 * g + 2]), siluf(acc[nt][mt][4 * g + 3]));
                }
                u32x4 o; o.x = pc[0].x; o.y = pc[0].y; o.z = pc[1].x; o.w = pc[1].y;
                *(u32x4*)(dst + ((size_t)((mt * 8 + tile) * 2 + nt) * 64 + lane) * 16 + 8 * gp) = o;
            }
}
__device__ __forceinline__ void store_tr(const f32x16 (&acc)[2][2], __bf16* dst, int group, int NT, int rowtile0, int s0, int lane) {
#pragma unroll
    for (int nt = 0; nt < 2; ++nt)
#pragma unroll
        for (int mt = 0; mt < 2; ++mt)
#pragma unroll
            for (int gp = 0; gp < 2; ++gp) {
                const int k16 = (s0 >> 4) + 2 * mt + gp;
                const u32x2 lo = pk4(acc[nt][mt][8 * gp], acc[nt][mt][8 * gp + 1], acc[nt][mt][8 * gp + 2], acc[nt][mt][8 * gp + 3]);
                const u32x2 hi = pk4(acc[nt][mt][8 * gp + 4], acc[nt][mt][8 * gp + 5], acc[nt][mt][8 * gp + 6], acc[nt][mt][8 * gp + 7]);
                u32x4 o; o.x = lo.x; o.y = lo.y; o.z = hi.x; o.w = hi.y;
                *(u32x4*)(dst + ((((size_t)group * 128 + k16) * NT + rowtile0 + nt) * 64 + lane) * 8) = o;
            }
}

__device__ __forceinline__ int win_col(int np) {
    if (np < 384) return np;
    if (np < 896) return 416 + (np - 384);
    if (np < 1152) return 928 + (np - 896);
    if (np < 1408) return 1184 + (np - 1152);
    if (np < 1920) return 1440 + (np - 1408);
    if (np < 2432) return 1968 + (np - 1920);
    if (np < 2464) return 384 + (np - 2432);
    if (np < 2480) return 1952 + (np - 2464);
    return -1;
}
__device__ void p0_silu_c(const Params& p, int blk) {
    int tid = threadIdx.x; asm volatile("" : "+v"(tid));
    const int idx = blk * NTHR + tid;
    const int lane = idx & 63, ks = (idx >> 6) & 63, m = idx >> 12;
    const int rr = 32 * m + (lane & 31), row = min(rr, 135), k0 = 16 * ks + 8 * (lane >> 5);
    const float* cp = (row < 8) ? (p.c_prompt + (size_t)row * 1024) : (p.c_sample + (size_t)(row - 8) * 1024);
    const f32x4 c0 = *(const f32x4*)(cp + k0), c1 = *(const f32x4*)(cp + k0 + 4);
    const bool live = rr < 136;
    u32x4 o;
    o.x = pk2(live ? siluf(c0[0]) : 0.f, live ? siluf(c0[1]) : 0.f); o.y = pk2(live ? siluf(c0[2]) : 0.f, live ? siluf(c0[3]) : 0.f);
    o.z = pk2(live ? siluf(c1[0]) : 0.f, live ? siluf(c1[1]) : 0.f); o.w = pk2(live ? siluf(c1[2]) : 0.f, live ? siluf(c1[3]) : 0.f);
    ((u32x4*)(p.ws + WS_SC))[idx] = o;
}
__device__ void p0_mod_item(const Params& p, int item, unsigned char* lds) {
    int tid = threadIdx.x; asm volatile("" : "+v"(tid));
    const int lane = tid & 63, w = tid >> 6, l31 = lane & 31, hh = lane >> 5;
    const int n0 = item * 32;
    float* mod = (float*)(p.ws + WS_MOD);
    const u32x4* SC = (const u32x4*)(p.ws + WS_SC);
    f32x16 acc[5];
#pragma unroll
    for (int m = 0; m < 5; ++m)
#pragma unroll
        for (int r = 0; r < 16; ++r) acc[m][r] = 0.f;
    float aS[3][8]; u32x4 bS[3][5];
#define MOD_LOAD(s_, k8_) do { const int ks_ = 8 * w + (k8_), k0_ = 16 * ks_ + 8 * hh; \
        _Pragma("unroll") for (int j = 0; j < 8; ++j) aS[s_][j] = p.w_ada[(size_t)(k0_ + j) * 3072 + n0 + l31]; \
        _Pragma("unroll") for (int m = 0; m < 5; ++m) bS[s_][m] = SC[((size_t)m * 64 + ks_) * 64 + lane]; } while (0)
    MOD_LOAD(0, 0); MOD_LOAD(1, 1); MOD_LOAD(2, 2);
#pragma unroll
    for (int k8 = 0; k8 < 8; ++k8) {
        __builtin_amdgcn_sched_barrier(0);
        bf16x8 a;
#pragma unroll
        for (int j = 0; j < 8; ++j) a[j] = (__bf16)aS[k8 % 3][j];
#pragma unroll
        for (int m = 0; m < 5; ++m) acc[m] = mfma32(a, __builtin_bit_cast(bf16x8, bS[k8 % 3][m]), acc[m]);
        __builtin_amdgcn_sched_barrier(0);
        if (k8 + 3 < 8) MOD_LOAD(k8 % 3, k8 + 3);
    }
#undef MOD_LOAD
    float* red = (float*)(lds + LDS_BASE);
#pragma unroll
    for (int m = 0; m < 5; ++m) {
#pragma unroll
        for (int r = 0; r < 16; ++r) red[(w * 16 + r) * 64 + lane] = acc[m][r];
        __syncthreads();
#pragma unroll
        for (int q = 0; q < 2; ++q) {
            const int o = tid + 512 * q, r = o >> 6, ln = o & 63;
            float s = 0.f;
#pragma unroll
            for (int ww = 0; ww < 8; ++ww) s += red[(ww * 16 + r) * 64 + ln];
            const int n = n0 + (r & 3) + 8 * (r >> 2) + 4 * (ln >> 5), row = 32 * m + (ln & 31);
            if (row < 136) mod[(size_t)row * 3072 + n] = s + p.b_ada[n];
        }
        __syncthreads();
    }
}
__device__ void p0_convert(const Params& p, int cb0, int ncb) {
    int tid0 = threadIdx.x; asm volatile("" : "+v"(tid0));
    int gdx = ncb; asm volatile("" : "+s"(gdx));
    const int gt = ((int)blockIdx.x - cb0) * NTHR + tid0, GT = gdx * NTHR;
    constexpr int N_IN = 78 * 64 * 64, N_OUT = 32 * 64 * 64, N_UQ = 24 * 16 * 64, N_KV = 32 * 8 * 64, N_UKV = 65536, N_ROPE = 2049 * 16;
    constexpr int N_S = N_UQ + N_KV + N_UKV + N_ROPE;
    u32x4* winf = (u32x4*)(p.ws + WS_WINF);
    u32x4* woutf = (u32x4*)(p.ws + WS_WOUTF);
    u32x4* wuqf = (u32x4*)(p.ws + WS_WUQF);
    u32x4* wkvf = (u32x4*)(p.ws + WS_WKVF);
    __bf16* wukb = (__bf16*)(p.ws + WS_WUKB);
    __bf16* wuvt = (__bf16*)(p.ws + WS_WUVT);
    float* rope = (float*)(p.ws + WS_ROPE);
    const int rounds = __builtin_amdgcn_readfirstlane(max(max((N_IN + 2 * GT - 1) / (2 * GT), (N_OUT + GT - 1) / GT), (N_S + GT - 1) / GT));
#pragma unroll 1
    for (int r = 0; r < rounds; ++r) {
        float vi[2][8], vo[1][8], vs[1][8];
#pragma unroll
        for (int u = 0; u < 2; ++u) {
            const int idx = min(gt + (2 * r + u) * GT, N_IN - 1);
            const int lane = idx & 63, fk = idx >> 6, ks = fk & 63, nt = fk >> 6;
            const int col = win_col(nt * 32 + (lane & 31)), k0 = ks * 16 + 8 * (lane >> 5);
#pragma unroll
            for (int j = 0; j < 8; ++j) vi[u][j] = (col >= 0) ? p.w_in[(size_t)(k0 + j) * 2480 + col] : 0.f;
        }
#pragma unroll
        for (int u = 0; u < 1; ++u) {
            const int idx = min(gt + (r + u) * GT, N_OUT - 1);
            const int lane = idx & 63, fk = idx >> 6, ks = fk & 63, nt = fk >> 6;
            const int n = nt * 32 + (lane & 31), k0 = ks * 16 + 8 * (lane >> 5);
#pragma unroll
            for (int j = 0; j < 8; ++j) vo[u][j] = p.w_out[(size_t)(k0 + j) * 1024 + n];
        }
#pragma unroll
        for (int u = 0; u < 1; ++u) {
            const int sidx = gt + (r + u) * GT;
#pragma unroll
            for (int j = 0; j < 8; ++j) vs[u][j] = 0.f;
            if (sidx < N_UQ) {
                const int idx = sidx, lane = idx & 63, fk = idx >> 6, ks = fk & 15, nt = fk >> 4;
                const int n = nt * 32 + (lane & 31), k0 = ks * 16 + 8 * (lane >> 5);
#pragma unroll
                for (int j = 0; j < 8; ++j) vs[u][j] = p.w_uq[(size_t)(k0 + j) * 768 + n];
            } else if (sidx < N_UQ + N_KV) {
                const int idx = sidx - N_UQ, lane = idx & 63, fk = idx >> 6, ks = fk & 7, nt = fk >> 3;
                const int n = nt * 32 + (lane & 31), k0 = ks * 16 + 8 * (lane >> 5);
#pragma unroll
                for (int j = 0; j < 8; ++j) vs[u][j] = (n < 512) ? p.w_uk[(size_t)(k0 + j) * 512 + n] : p.w_uv[(size_t)(k0 + j) * 512 + (n - 512)];
            } else if (sidx < N_UQ + N_KV + N_UKV) {
                const int idx = sidx - N_UQ - N_KV;
                const int rr = idx & 127, v = (idx >> 7) & 63, h = idx >> 13;
                vs[u][0] = p.w_uk[idx];
                vs[u][1] = p.w_uv[(size_t)rr * 512 + h * 64 + v];
            }
        }
        __builtin_amdgcn_sched_barrier(0);
#pragma unroll
        for (int u = 0; u < 2; ++u) {
            const int idx = gt + (2 * r + u) * GT;
            if (idx < N_IN) { u32x4 o; o.x = pk2(vi[u][0], vi[u][1]); o.y = pk2(vi[u][2], vi[u][3]); o.z = pk2(vi[u][4], vi[u][5]); o.w = pk2(vi[u][6], vi[u][7]); winf[idx] = o; }
        }
#pragma unroll
        for (int u = 0; u < 1; ++u) {
            const int idx = gt + (r + u) * GT;
            if (idx < N_OUT) { u32x4 o; o.x = pk2(vo[u][0], vo[u][1]); o.y = pk2(vo[u][2], vo[u][3]); o.z = pk2(vo[u][4], vo[u][5]); o.w = pk2(vo[u][6], vo[u][7]); woutf[idx] = o; }
        }
#pragma unroll
        for (int u = 0; u < 1; ++u) {
            const int sidx = gt + (r + u) * GT;
            u32x4 o; o.x = pk2(vs[u][0], vs[u][1]); o.y = pk2(vs[u][2], vs[u][3]); o.z = pk2(vs[u][4], vs[u][5]); o.w = pk2(vs[u][6], vs[u][7]);
            if (sidx < N_UQ) wuqf[sidx] = o;
            else if (sidx < N_UQ + N_KV) wkvf[sidx - N_UQ] = o;
            else if (sidx < N_UQ + N_KV + N_UKV) { const int idx = sidx - N_UQ - N_KV; wukb[idx] = (__bf16)vs[u][0]; wuvt[idx] = (__bf16)vs[u][1]; }
            else if (sidx < N_S) {
                const int idx = sidx - N_UQ - N_KV - N_UKV;
                const int pi = idx >> 4, i = idx & 15;
                const float pos = (pi == 2048) ? 8192.f : (float)pi;
                const float inv = __builtin_amdgcn_exp2f(-(float)(2 * i) * (13.287712379549449f / 32.f));
                const double rev = (double)(pos * inv) * 0.15915494309189535;
                const float fr = (float)(rev - floor(rev));
                const float sn = __builtin_amdgcn_sinf(fr), cs = __builtin_amdgcn_cosf(fr);
                rope[pi * 32 + i] = cs; rope[pi * 32 + 16 + i] = sn;
            }
        }
    }
}

constexpr int XS = 2064;
constexpr int ZS = 1808;

__device__ __forceinline__ void p1_post(const Params& p, int it, unsigned char* lds, int part);
__device__ void p1_stripe(const Params& p, int it, int mode, unsigned char* lds) {
    int tid = threadIdx.x; asm volatile("" : "+v"(tid));
    const int lane = tid & 63, w = tid >> 6, l31 = lane & 31, hh = lane >> 5;
    const bool is_s = it >= 256;
    const int srow0 = is_s ? (it - 256) * 64 : 0;
    const int tok0 = is_s ? NTOK + srow0 : it * 64;
    const int b = it >> 5, s0 = (it & 31) * 64;
    unsigned char* A = lds + LDS_BASE;
    const float* mod = (const float*)(p.ws + WS_MOD);
    const float* rope = (const float*)(p.ws + WS_ROPE);
    f32x4 xb[8], shB = {0.f, 0.f, 0.f, 0.f}, scB = {0.f, 0.f, 0.f, 0.f};
    {
        const int c4 = tid & 255, rb = tid >> 8;
        if (!is_s) {
            const int c = tid & 63, rq = tid >> 6;
            f32x4 shA[3], scA[3];
#pragma unroll
            for (int qd = 0; qd < 3; ++qd) { shA[qd] = *(const f32x4*)(mod + (size_t)b * 3072 + 256 * qd + 4 * c); scA[qd] = *(const f32x4*)(mod + (size_t)b * 3072 + 1024 + 256 * qd + 4 * c); }
            shB = *(const f32x4*)(mod + (size_t)b * 3072 + 768 + 4 * c); scB = *(const f32x4*)(mod + (size_t)b * 3072 + 1792 + 4 * c);
            const float* xr = p.x_prompt + (size_t)(it * 64 + rq) * 1024 + 4 * c;
            f32x4 xa[3][8];
#pragma unroll
            for (int qd = 0; qd < 3; ++qd)
#pragma unroll
                for (int u = 0; u < 8; ++u) xa[qd][u] = *(const f32x4*)(xr + (size_t)u * 8192 + 256 * qd);
#pragma unroll
            for (int u = 0; u < 8; ++u) xb[u] = *(const f32x4*)(xr + (size_t)u * 8192 + 768);
            __builtin_amdgcn_sched_barrier(0);
#pragma unroll
            for (int qd = 0; qd < 3; ++qd)
#pragma unroll
                for (int u = 0; u < 8; ++u)
                    *(u32x2*)(A + (8 * u + rq) * XS + 512 * qd + c * 8) = pk4(xa[qd][u][0] * (1.f + scA[qd][0]) + shA[qd][0], xa[qd][u][1] * (1.f + scA[qd][1]) + shA[qd][1],
                                                                              xa[qd][u][2] * (1.f + scA[qd][2]) + shA[qd][2], xa[qd][u][3] * (1.f + scA[qd][3]) + shA[qd][3]);
        } else {
#pragma unroll 1
            for (int i0 = 0; i0 < 32; i0 += 16) {
                f32x4 x[16], sh[16], sc[16];
#pragma unroll
                for (int u = 0; u < 16; ++u) {
                    const int row = 2 * (i0 + u) + rb;
                    x[u] = *(const f32x4*)(p.x_sample + (size_t)(srow0 + row) * 1024 + 4 * c4);
                    sh[u] = *(const f32x4*)(mod + (size_t)(8 + srow0 + row) * 3072 + 4 * c4);
                    sc[u] = *(const f32x4*)(mod + (size_t)(8 + srow0 + row) * 3072 + 1024 + 4 * c4);
                }
                __builtin_amdgcn_sched_barrier(0);
#pragma unroll
                for (int u = 0; u < 16; ++u)
                    *(u32x2*)(A + (2 * (i0 + u) + rb) * XS + c4 * 8) = pk4(x[u][0] * (1.f + sc[u][0]) + sh[u][0], x[u][1] * (1.f + sc[u][1]) + sh[u][1], x[u][2] * (1.f + sc[u][2]) + sh[u][2], x[u][3] * (1.f + sc[u][3]) + sh[u][3]);
            }
        }
    }
    __syncthreads();
    const u32x4* winf = (const u32x4*)(p.ws + WS_WINF);
    __bf16* GM = (__bf16*)(p.ws + WS_GM); __bf16* GQ = (__bf16*)(p.ws + WS_GQ); __bf16* GK = (__bf16*)(p.ws + WS_GK);
    __bf16* GV = (__bf16*)(p.ws + WS_GV); __bf16* GG = (__bf16*)(p.ws + WS_GG);
    __bf16* GKT = (__bf16*)(p.ws + WS_GKT); __bf16* GVT = (__bf16*)(p.ws + WS_GVT);
    f32x16 acc[2][2];
    u32x4 ringa[GPF], ringb[GPF];
    const int sst = (w < 6) ? w : 38;
    bool fill = true;
    if (mode == 0) {
        const int st = 6 + w;
        zero_acc(acc);
        gemm_2x2_stream<48, true, 64>(winf + (size_t)st * 2 * 64 * 64, winf + (size_t)st * 2 * 64 * 64 + 48 * 64, true, A, XS, lane, acc, ringa, ringb);
        {
            int t2 = threadIdx.x; asm volatile("" : "+v"(t2));
            const int c = t2 & 63, rq = t2 >> 6;
#pragma unroll
            for (int u = 0; u < 8; ++u)
                *(u32x2*)(A + (8 * u + rq) * XS + 1536 + c * 8) = pk4(xb[u][0] * (1.f + scB[0]) + shB[0], xb[u][1] * (1.f + scB[1]) + shB[1], xb[u][2] * (1.f + scB[2]) + shB[2], xb[u][3] * (1.f + scB[3]) + shB[3]);
        }
        __syncthreads();
        gemm_2x2_stream<16, true, 64>(winf + (size_t)st * 2 * 64 * 64 + 48 * 64, winf + (size_t)(st + 8) * 2 * 64 * 64, false, A + 1536, XS, lane, acc, ringa, ringb);
        fill = false;
        int lane2 = lane; asm volatile("" : "+v"(lane2));
        __bf16* gmb = GM + (size_t)tok0 * 512;
#pragma unroll
        for (int nt = 0; nt < 2; ++nt)
#pragma unroll
            for (int mt = 0; mt < 2; ++mt)
#pragma unroll
                for (int gp = 0; gp < 2; ++gp)
                    *(u32x4*)(gmb + ((size_t)((((mt * 8 + (st - 6)) * 2 + nt) * 2 + gp) * 64) + lane2) * 8) =
                        widen_pair(pk4(siluf(acc[nt][mt][8 * gp]), siluf(acc[nt][mt][8 * gp + 1]), siluf(acc[nt][mt][8 * gp + 2]), siluf(acc[nt][mt][8 * gp + 3])),
                                   pk4(siluf(acc[nt][mt][8 * gp + 4]), siluf(acc[nt][mt][8 * gp + 5]), siluf(acc[nt][mt][8 * gp + 6]), siluf(acc[nt][mt][8 * gp + 7])));
    }
#pragma unroll 1
    for (int i = (mode == 0) ? 1 : 0; i < 4; ++i) {
        if (mode == 1 || mode >= 6 || (mode >= 2 && i != mode - 2)) continue;
        const int st = 6 + w + 8 * i;
        const int stn = (mode == 0) ? ((i < 3) ? st + 8 : ((w < 7) ? sst : st)) : st;
        zero_acc(acc);
        const bool tr = (!is_s) && (st >= 22 && st < 30);
        if (tr) gemm_2x2_stream<64, false>(winf + (size_t)st * 2 * 64 * 64, winf + (size_t)stn * 2 * 64 * 64, fill, A, XS, lane, acc, ringa, ringb);
        else    gemm_2x2_stream<64, true >(winf + (size_t)st * 2 * 64 * 64, winf + (size_t)stn * 2 * 64 * 64, fill, A, XS, lane, acc, ringa, ringb);
        fill = (mode != 0);
        int lane2 = lane; asm volatile("" : "+v"(lane2));
        if (st < 14) {
            if (is_s) store_nat<1>(acc, GM + (size_t)tok0 * 512, 512, (st - 6) * 64, lane2);
            else {
                __bf16* gmb = GM + (size_t)tok0 * 512;
#pragma unroll
                for (int nt = 0; nt < 2; ++nt)
#pragma unroll
                    for (int mt = 0; mt < 2; ++mt)
#pragma unroll
                        for (int gp = 0; gp < 2; ++gp)
                            *(u32x4*)(gmb + ((size_t)((((mt * 8 + (st - 6)) * 2 + nt) * 2 + gp) * 64) + lane2) * 8) =
                                widen_pair(pk4(siluf(acc[nt][mt][8 * gp]), siluf(acc[nt][mt][8 * gp + 1]), siluf(acc[nt][mt][8 * gp + 2]), siluf(acc[nt][mt][8 * gp + 3])),
                                           pk4(siluf(acc[nt][mt][8 * gp + 4]), siluf(acc[nt][mt][8 * gp + 5]), siluf(acc[nt][mt][8 * gp + 6]), siluf(acc[nt][mt][8 * gp + 7])));
            }
        }
        else if (st < 18) { if (is_s) store_nat<2>(acc, GQ + (size_t)tok0 * 256, 256, (st - 14) * 64, lane2); else store_frag8<2>(acc, GQ + (size_t)tok0 * 256, st - 14, lane2); }
        else if (st < 22) {
            if (is_s) store_nat<0>(acc, GK + (size_t)tok0 * 256, 256, (st - 18) * 64, lane2); else store_frag8<0>(acc, GK + (size_t)tok0 * 256, st - 18, lane2);
            if (!is_s) {
                const int l31b = lane2 & 31, hhb = lane2 >> 5;
                __bf16* gb = GKT + ((((size_t)(b * 4 + (st - 18)) * 128 + (s0 >> 4) + (l31b >> 4)) * 2) * 64 + 32 * ((l31b >> 2) & 1) + 4 * hhb) * 8 + 4 * ((l31b >> 3) & 1) + (l31b & 3);
#pragma unroll
                for (int mt = 0; mt < 2; ++mt)
#pragma unroll
                    for (int nt = 0; nt < 2; ++nt)
#pragma unroll
                        for (int r = 0; r < 16; ++r)
                            gb[(size_t)mt * 2 * 2 * 512 + nt * 512 + ((r & 3) + 8 * (r >> 2)) * 8] = (__bf16)acc[nt][mt][r];
            }
        } else if (st < 30) {
            if (tr) store_tr(acc, GVT, b * 4 + ((st - 22) >> 1), 4, ((st - 22) & 1) * 2, s0, lane2);
            else store_nat<0>(acc, GV + (size_t)tok0 * 512, 512, (st - 22) * 64, lane2);
        } else { if (is_s) store_nat<1>(acc, GG + (size_t)tok0 * 512, 512, (st - 30) * 64, lane2); else store_lane16_silu(acc, GG + (size_t)tok0 * 512, st - 30, lane2); }
    }
    if (mode >= 2 && mode < 6) { __syncthreads(); return; }
    const bool sp_on = (mode == 6) ? (w < 4) : ((mode == 7) ? (w >= 4 && w < 7) : (w < 7));
    if (sp_on) { zero_acc(acc); gemm_2x2_stream<64, true>(winf + (size_t)sst * 2 * 64 * 64, winf + (size_t)sst * 2 * 64 * 64, fill, A, XS, lane, acc, ringa, ringb); }
    __syncthreads();
    unsigned char* Z = A;
    if (sp_on) {
        const int cb = (w < 4) ? 64 * w : (w < 6 ? 256 + 64 * (w - 4) : 384);
#pragma unroll
        for (int nt = 0; nt < 2; ++nt)
#pragma unroll
            for (int mt = 0; mt < 2; ++mt)
#pragma unroll
                for (int g = 0; g < 4; ++g) {
                    f32x4 v = {acc[nt][mt][4 * g], acc[nt][mt][4 * g + 1], acc[nt][mt][4 * g + 2], acc[nt][mt][4 * g + 3]};
                    *(f32x4*)(Z + (32 * mt + l31) * ZS + (cb + 32 * nt + 8 * g + 4 * hh) * 4) = v;
                }
    }
    __syncthreads();
    p1_post(p, it, lds, (mode == 6) ? 1 : (mode == 7) ? 2 : 0);
}

__device__ __forceinline__ void p1_post(const Params& p, int it, unsigned char* lds, int part) {
    int tid = threadIdx.x; asm volatile("" : "+v"(tid));
    const int lane = tid & 63, w = tid >> 6, l31 = lane & 31, hh = lane >> 5;
    const bool is_s = it >= 256;
    const int srow0 = is_s ? (it - 256) * 64 : 0;
    const int tok0 = is_s ? NTOK + srow0 : it * 64;
    const int b = it >> 5, s0 = (it & 31) * 64;
    unsigned char* Z = lds + LDS_BASE;
    const float* rope = (const float*)(p.ws + WS_ROPE);
    f32x16 acc[2][2];
    float* latout = p.out + (is_s ? OUT_LATS + (size_t)srow0 * 128 : OUT_LATP + (size_t)it * 64 * 128);
    for (int rr = 0; rr < 8; ++rr) {
        const int row = 8 * w + rr;
        unsigned char* zr = Z + row * ZS;
        if (part != 2) {
            const f32x4 v = *(const f32x4*)(zr + 16 * lane);
            const float ss = wave_sum(v[0] * v[0] + v[1] * v[1] + v[2] * v[2] + v[3] * v[3]);
            const float inv = rsqrtf(ss * (1.f / 256.f) + NORM_EPS);
            const f32x4 g = *(const f32x4*)(p.q_norm_g + 4 * lane);
            *(u32x2*)(zr + 8 * lane) = pk4(v[0] * inv * g[0], v[1] * inv * g[1], v[2] * inv * g[2], v[3] * inv * g[3]);
        }
        if (part != 1) {
            const f32x2 c = *(const f32x2*)(zr + 1024 + 8 * lane);
            const float ss2 = wave_sum(c[0] * c[0] + c[1] * c[1]);
            const float inv2 = rsqrtf(ss2 * (1.f / 128.f) + NORM_EPS);
            const f32x2 g2 = *(const f32x2*)(p.kv_norm_g + 2 * lane);
            const float y0 = c[0] * inv2 * g2[0], y1 = c[1] * inv2 * g2[1];
            *(unsigned*)(zr + 1024 + 4 * lane) = pk2(y0, y1);
            f32x2 yo = {y0, y1};
            *(f32x2*)(latout + (size_t)row * 128 + 2 * lane) = yo;
        }
    }
    if (part != 1) {
        float* krout = p.out + (is_s ? OUT_KRS + (size_t)srow0 * 32 : OUT_KRP + (size_t)it * 64 * 32);
        __bf16* KR = (__bf16*)(p.ws + WS_KR);
#pragma unroll
        for (int q = 0; q < 2; ++q) {
            const int idx = tid + NTHR * q, row = idx >> 4, i = idx & 15;
            const float* zr = (const float*)(Z + row * ZS);
            const float x1 = zr[384 + i], x2 = zr[400 + i];
            const int pi = is_s ? 2048 : s0 + row;
            const float cs = rope[pi * 32 + i], sn = rope[pi * 32 + 16 + i];
            const float o1 = x1 * cs - x2 * sn, o2 = x2 * cs + x1 * sn;
            krout[row * 32 + i] = o1; krout[row * 32 + 16 + i] = o2;
            if (!is_s) { KR[((size_t)b * 2048 + s0 + row) * 32 + i] = (__bf16)o1; KR[((size_t)b * 2048 + s0 + row) * 32 + 16 + i] = (__bf16)o2; }
        }
    }
    if (part != 1) {
        const int n = 32 * w + l31, h = w >> 1, dk = 32 * (w & 1) + l31;
        bf16x8 wb;
#pragma unroll
        for (int e = 0; e < 8; ++e) wb[e] = (__bf16)p.w_gate_up[(8 * hh + e) * 256 + n];
        const float bg = p.b_gate[n];
        f32x16 la[2];
#pragma unroll
        for (int mt = 0; mt < 2; ++mt) {
            const float* zr = (const float*)(Z + (32 * mt + l31) * ZS);
            const bf16x8 ga = cvt8(*(const f32x4*)(zr + 416 + 8 * hh), *(const f32x4*)(zr + 420 + 8 * hh));
#pragma unroll
            for (int r = 0; r < 16; ++r) la[mt][r] = 0.f;
            la[mt] = mfma32(ga, wb, la[mt]);
#pragma unroll
            for (int r = 0; r < 16; ++r) { const float a = la[mt][r] + bg; la[mt][r] = (fminf(a, 0.f) - __logf(1.f + __expf(-fabsf(a)))) * (1.f / 16.f); }
        }
        if (!is_s) {
            float carry = 0.f;
#pragma unroll
            for (int mt = 0; mt < 2; ++mt) {
                float bs[4], ps[4];
#pragma unroll
                for (int g = 0; g < 4; ++g) { bs[g] = (la[mt][4 * g] + la[mt][4 * g + 1]) + (la[mt][4 * g + 2] + la[mt][4 * g + 3]); ps[g] = __shfl_xor(bs[g], 32); }
#pragma unroll
                for (int g = 0; g < 4; ++g) {
                    const float b0s = hh ? ps[g] : bs[g], b1s = hh ? bs[g] : ps[g];
                    float run = carry + (hh ? b0s : 0.f);
#pragma unroll
                    for (int i = 0; i < 4; ++i) { run += la[mt][4 * g + i]; la[mt][4 * g + i] = run; }
                    carry += b0s + b1s;
                }
            }
        }
        float* LAB = (float*)(p.ws + WS_LAB) + (size_t)tok0 * 256 + n;
#pragma unroll
        for (int mt = 0; mt < 2; ++mt)
#pragma unroll
            for (int r = 0; r < 16; ++r) LAB[(size_t)(32 * mt + (r & 3) + 8 * (r >> 2) + 4 * hh) * 256] = la[mt][r];
        if (!is_s) {
            float* BT = (float*)(p.ws + WS_BT);
#pragma unroll
            for (int mt = 0; mt < 2; ++mt)
#pragma unroll
                for (int g = 0; g < 4; ++g) {
                    const int k16 = (s0 >> 4) + 2 * mt + (g >> 1);
                    f32x4 v = {la[mt][4 * g], la[mt][4 * g + 1], la[mt][4 * g + 2], la[mt][4 * g + 3]};
                    *(f32x4*)(BT + ((((size_t)(b * 4 + h) * 128 + k16) * 2 + (w & 1)) * 64 + lane) * 8 + 4 * (g & 1)) = v;
                }
            if (hh) ((float*)(p.ws + WS_BL))[((size_t)(b * 4 + h) * 32 + (s0 >> 6)) * 64 + dk] = la[1][15];
        }
    }
    __syncthreads();
    if (part != 2) {
        const u32x4* wuqf = (const u32x4*)(p.ws + WS_WUQF);
        const int h = w;
        const unsigned char* x0 = Z + l31 * ZS + hh * 16;
        const unsigned char* x1 = x0 + 32 * ZS;
        const int qoff = (h < 4) ? 512 + 128 * h : 1280 + 128 * (h - 4);
        __bf16* QLR = (__bf16*)(p.ws + WS_QLR);
        __bf16* Q = (__bf16*)(p.ws + WS_Q) + ((size_t)(b * 8 + h) * 2048 + s0) * 96;
        u32x4 rqA[16], rqB[16];
#pragma unroll
        for (int ks = 0; ks < 16; ++ks) { rqA[ks] = wuqf[((size_t)(3 * h + 0) * 16 + ks) * 64 + lane]; rqB[ks] = wuqf[((size_t)(3 * h + 1) * 16 + ks) * 64 + lane]; }
#pragma unroll
        for (int j = 0; j < 3; ++j) {
            f32x16 q[2];
#pragma unroll
            for (int m = 0; m < 2; ++m)
#pragma unroll
                for (int r = 0; r < 16; ++r) q[m][r] = 0.f;
            __builtin_amdgcn_sched_barrier(0);
#pragma unroll
            for (int ks = 0; ks < 16; ++ks) {
                const bf16x8 a = __builtin_bit_cast(bf16x8, (j == 1) ? rqB[ks] : rqA[ks]);
                const bf16x8 b0 = *(const bf16x8*)(x0 + ks * 32), b1 = *(const bf16x8*)(x1 + ks * 32);
                q[0] = mfma32(a, b0, q[0]); q[1] = mfma32(a, b1, q[1]);
            }
            if (j == 0) {
#pragma unroll
                for (int ks = 0; ks < 16; ++ks) rqA[ks] = wuqf[((size_t)(3 * h + 2) * 16 + ks) * 64 + lane];
            }
            if (j == 2) {
#pragma unroll
                for (int m = 0; m < 2; ++m) {
                    const int pi = is_s ? 2048 : s0 + 32 * m + l31;
#pragma unroll
                    for (int g = 0; g < 2; ++g) {
                        const f32x4 cs = *(const f32x4*)(rope + pi * 32 + 8 * g + 4 * hh);
                        const f32x4 sn = *(const f32x4*)(rope + pi * 32 + 16 + 8 * g + 4 * hh);
#pragma unroll
                        for (int i = 0; i < 4; ++i) {
                            const float x1v = q[m][4 * g + i], x2v = q[m][4 * g + 8 + i];
                            q[m][4 * g + i] = x1v * cs[i] - x2v * sn[i];
                            q[m][4 * g + 8 + i] = x2v * cs[i] + x1v * sn[i];
                        }
                    }
                }
            }
#pragma unroll
            for (int m = 0; m < 2; ++m)
#pragma unroll
                for (int g = 0; g < 4; ++g) {
                    const int tok = 32 * m + l31;
                    if (!is_s) {
                        if ((g & 1) == 0)
                            *(u32x4*)(Q + ((size_t)((m * 6 + 2 * j + (g >> 1)) * 64) + lane) * 8) =
                                widen_pair(pk4(q[m][4 * g] * QSCALE, q[m][4 * g + 1] * QSCALE, q[m][4 * g + 2] * QSCALE, q[m][4 * g + 3] * QSCALE),
                                           pk4(q[m][4 * g + 4] * QSCALE, q[m][4 * g + 5] * QSCALE, q[m][4 * g + 6] * QSCALE, q[m][4 * g + 7] * QSCALE));
                    } else if (j == 2) {
                        *(u32x2*)(QLR + ((size_t)(srow0 + tok) * 8 + h) * 160 + 128 + 8 * g + 4 * hh) = pk4(q[m][4 * g] * QSCALE, q[m][4 * g + 1] * QSCALE, q[m][4 * g + 2] * QSCALE, q[m][4 * g + 3] * QSCALE);
                    } else {
                        *(u32x2*)(Z + tok * ZS + qoff + (32 * j + 8 * g + 4 * hh) * 2) = pk4(q[m][4 * g], q[m][4 * g + 1], q[m][4 * g + 2], q[m][4 * g + 3]);
                    }
                }
        }
        if (is_s) {
            asm volatile("s_waitcnt lgkmcnt(0)" ::: "memory");
            const __bf16* wukb = (const __bf16*)(p.ws + WS_WUKB);
            bf16x8 aw[4][4];
#pragma unroll
            for (int rt = 0; rt < 4; ++rt)
#pragma unroll
                for (int ks = 0; ks < 4; ++ks) aw[rt][ks] = *(const bf16x8*)(wukb + ((size_t)(32 * rt + l31) * 8 + h) * 64 + 16 * ks + 8 * hh);
            __builtin_amdgcn_sched_barrier(0);
#pragma unroll
            for (int rt = 0; rt < 4; ++rt) {
                f32x16 ql[2];
#pragma unroll
                for (int m = 0; m < 2; ++m)
#pragma unroll
                    for (int r = 0; r < 16; ++r) ql[m][r] = 0.f;
#pragma unroll
                for (int ks = 0; ks < 4; ++ks) {
                    const bf16x8 b0 = *(const bf16x8*)(Z + l31 * ZS + qoff + (16 * ks + 8 * hh) * 2);
                    const bf16x8 b1 = *(const bf16x8*)(Z + (32 + l31) * ZS + qoff + (16 * ks + 8 * hh) * 2);
                    const bf16x8 a = aw[rt][ks];
                    ql[0] = mfma32(a, b0, ql[0]); ql[1] = mfma32(a, b1, ql[1]);
                }
#pragma unroll
                for (int m = 0; m < 2; ++m)
#pragma unroll
                    for (int g = 0; g < 4; ++g)
                        *(u32x2*)(QLR + ((size_t)(srow0 + 32 * m + l31) * 8 + h) * 160 + 32 * rt + 8 * g + 4 * hh) =
                            pk4(ql[m][4 * g] * QSCALE, ql[m][4 * g + 1] * QSCALE, ql[m][4 * g + 2] * QSCALE, ql[m][4 * g + 3] * QSCALE);
            }
        }
    }
    if (!is_s) {
        const u32x4* wkvf = (const u32x4*)(p.ws + WS_WKVF);
        __bf16* KN = (__bf16*)(p.ws + WS_KN);
        __bf16* VT = (__bf16*)(p.ws + WS_VT);
        u32x4 wka[2][8], wkb[2][8];
#pragma unroll
        for (int pp = 0; pp < 2; ++pp)
#pragma unroll
            for (int u = 0; u < 8; ++u) {
                const u32x4* wf = wkvf + (size_t)(4 * w + 2 * pp) * 8 * 64 + lane;
                wka[pp][u] = wf[u * 64]; wkb[pp][u] = wf[(8 + u) * 64];
            }
        __builtin_amdgcn_sched_barrier(0);
        const unsigned char* kx0 = Z + 1024 + l31 * ZS + hh * 16;
        const unsigned char* kx1 = kx0 + 32 * ZS;
#pragma unroll
        for (int pp = 0; pp < 2; ++pp) {
            const int nt0 = 4 * w + 2 * pp;
            zero_acc(acc);
            if (w < 4) {
#pragma unroll
                for (int ks = 0; ks < 8; ++ks) {
                    const bf16x8 b0 = *(const bf16x8*)(kx0 + ks * 32), b1 = *(const bf16x8*)(kx1 + ks * 32);
                    const bf16x8 a0 = __builtin_bit_cast(bf16x8, wka[pp][ks]), a1 = __builtin_bit_cast(bf16x8, wkb[pp][ks]);
                    acc[0][0] = mfma32(a0, b0, acc[0][0]); acc[0][1] = mfma32(a0, b1, acc[0][1]);
                    acc[1][0] = mfma32(a1, b0, acc[1][0]); acc[1][1] = mfma32(a1, b1, acc[1][1]);
                }
                const int hd = nt0 >> 1;
                {
                    __bf16* kt = KN + ((size_t)(b * 8 + hd) * 2048 + s0) * 64;
#pragma unroll
                    for (int nt = 0; nt < 2; ++nt)
#pragma unroll
                        for (int mt = 0; mt < 2; ++mt)
#pragma unroll
                            for (int gp = 0; gp < 2; ++gp)
                                *(u32x4*)(kt + ((size_t)(((mt * 2 + nt) * 2 + gp) * 64) + lane) * 8) =
                                    widen_pair(pk4(acc[nt][mt][8 * gp], acc[nt][mt][8 * gp + 1], acc[nt][mt][8 * gp + 2], acc[nt][mt][8 * gp + 3]),
                                               pk4(acc[nt][mt][8 * gp + 4], acc[nt][mt][8 * gp + 5], acc[nt][mt][8 * gp + 6], acc[nt][mt][8 * gp + 7]));
                }
            } else {
#pragma unroll
                for (int ks = 0; ks < 8; ++ks) {
                    const bf16x8 b0 = *(const bf16x8*)(kx0 + ks * 32), b1 = *(const bf16x8*)(kx1 + ks * 32);
                    const bf16x8 a0 = __builtin_bit_cast(bf16x8, wka[pp][ks]), a1 = __builtin_bit_cast(bf16x8, wkb[pp][ks]);
                    acc[0][0] = mfma32(b0, a0, acc[0][0]); acc[0][1] = mfma32(b1, a0, acc[0][1]);
                    acc[1][0] = mfma32(b0, a1, acc[1][0]); acc[1][1] = mfma32(b1, a1, acc[1][1]);
                }
                const int hd = (nt0 - 16) >> 1;
                store_tr(acc, VT, b * 8 + hd, 2, 0, s0, lane);
            }
        }
    }
    __syncthreads();
}

constexpr int KST = 208, VST = 144;
constexpr int KBUF = 64 * KST, VBUF = 8192;

__device__ void p2_attn(const Params& p, int bh, int qb, unsigned char* lds) {
    int tid = threadIdx.x; asm volatile("" : "+v"(tid));
    const int lane = tid & 63, w = tid >> 6, l31 = lane & 31, hh = lane >> 5;
    const int b = bh >> 3, h = bh & 7;
    const __bf16* Q = (const __bf16*)(p.ws + WS_Q) + (size_t)bh * 2048 * 96;
    const __bf16* KN = (const __bf16*)(p.ws + WS_KN) + (size_t)bh * 2048 * 64;
    const __bf16* KR = (const __bf16*)(p.ws + WS_KR) + (size_t)b * 2048 * 32;
    const __bf16* VT = (const __bf16*)(p.ws + WS_VT) + (size_t)bh * 64 * 2048;
    unsigned char* Kb = lds + LDS_BASE;
    unsigned char* Vb = Kb + 2 * KBUF;
    const int qrow0 = qb * 256 + 32 * w, qi = qrow0 + l31;
    bf16x8 qf[6];
#pragma unroll
    for (int ks = 0; ks < 6; ++ks) qf[ks] = *(const bf16x8*)(Q + (size_t)(4 * qb + (w >> 1)) * 6144 + ((size_t)(((w & 1) * 6 + ks) * 64) + lane) * 8);
    f32x16 o[2];
#pragma unroll
    for (int d = 0; d < 2; ++d)
#pragma unroll
        for (int r = 0; r < 16; ++r) o[d][r] = 0.f;
    float m = -1e30f, l = 0.f;
    const int nkt = (qb + 1) * 4;
    const int key_k = 32 * (tid >> 8) + (tid & 31), ch_k = 4 * ((tid >> 7) & 1) + 2 * ((tid >> 6) & 1) + ((tid >> 5) & 1), key_r = tid >> 2, ch_r = tid & 3;
    u32x4 kA, rA = {0u, 0u, 0u, 0u}, vA, kB, rB = {0u, 0u, 0u, 0u}, vB;
#define ATT_LOAD(kx, rx, vx, jt_) do { const int jc_ = ((jt_) < nkt) ? (jt_) : (nkt - 1); const int k0_ = 64 * jc_; \
        kx = *(const u32x4*)(KN + (size_t)k0_ * 64 + (size_t)tid * 8); \
        if (tid < 256) rx = *(const u32x4*)(KR + (size_t)(k0_ + key_r) * 32 + 8 * ch_r); \
        vx = *(const u32x4*)(VT + (size_t)jc_ * 4096 + (size_t)tid * 8); } while (0)
#define ATT_STORE(kx, rx, vx, buf_) do { unsigned char* kn_ = Kb + (buf_) * KBUF; unsigned char* vn_ = Vb + (buf_) * VBUF; \
        *(u32x4*)(kn_ + key_k * KST + ch_k * 16) = kx; \
        if (tid < 256) *(u32x4*)(kn_ + key_r * KST + 128 + ch_r * 16) = rx; \
        *(u32x4*)(vn_ + tid * 16) = vx; } while (0)
#define ATT_COMPUTE(j_, cur_) do { \
        const unsigned char* kb = Kb + (cur_) * KBUF; \
        const unsigned char* vb = Vb + (cur_) * VBUF; \
        _Pragma("unroll") for (int sub = 0; sub < 2; ++sub) { \
            const int key_lo = 64 * (j_) + 32 * sub; \
            if (key_lo <= qrow0 + 31) { \
                f32x16 s; \
                _Pragma("unroll") for (int r = 0; r < 16; ++r) s[r] = 0.f; \
                _Pragma("unroll") for (int ks = 0; ks < 6; ++ks) { \
                    const bf16x8 kf = *(const bf16x8*)(kb + (32 * sub + l31) * KST + (16 * ks + 8 * hh) * 2); \
                    s = mfma32(kf, qf[ks], s); } \
                if (key_lo + 31 > qrow0) { \
                    _Pragma("unroll") for (int r = 0; r < 16; ++r) { const int key = key_lo + (r & 3) + 8 * (r >> 2) + 4 * hh; if (key > qi) s[r] = -1e30f; } } \
                float mx = s[0]; \
                _Pragma("unroll") for (int r = 1; r < 16; ++r) mx = fmaxf(mx, s[r]); \
                mx = xor32_max(mx); \
                  \
                  \
                if (__ballot(mx > m + 8.f) != 0ull) { \
                    const float mn = fmaxf(m, mx), alpha = ex2(m - mn); \
                    m = mn; l *= alpha; \
                    _Pragma("unroll") for (int d = 0; d < 2; ++d) _Pragma("unroll") for (int r = 0; r < 16; ++r) o[d][r] = mul1(o[d][r], alpha); \
                } \
                float ps = 0.f; \
                _Pragma("unroll") for (int r = 0; r < 16; ++r) { s[r] = ex2(s[r] - m); ps += s[r]; } \
                l += ps; \
                _Pragma("unroll") for (int sk = 0; sk < 2; ++sk) { \
                    bf16x8 pf; \
                    _Pragma("unroll") for (int e = 0; e < 8; ++e) pf[e] = (__bf16)s[8 * sk + e]; \
                    _Pragma("unroll") for (int d = 0; d < 2; ++d) { \
                        const bf16x8 vf = *(const bf16x8*)(vb + ((2 * sub + sk) * 2 + d) * 1024 + lane * 16); \
                        o[d] = mfma32(vf, pf, o[d]); } } } } } while (0)
    ATT_LOAD(kA, rA, vA, 0);
    ATT_LOAD(kB, rB, vB, 1);
    ATT_STORE(kA, rA, vA, 0);
    ATT_LOAD(kA, rA, vA, 2);
    __syncthreads();
    for (int j = 0; j < nkt; j += 2) {
        ATT_COMPUTE(j, 0);
        ATT_STORE(kB, rB, vB, 1);
        ATT_LOAD(kB, rB, vB, j + 3);
        __syncthreads();
        ATT_COMPUTE(j + 1, 1);
        ATT_STORE(kA, rA, vA, 0);
        ATT_LOAD(kA, rA, vA, j + 4);
        __syncthreads();
    }
#undef ATT_LOAD
#undef ATT_STORE
#undef ATT_COMPUTE
    const float lt = xor32_sum(l);
    const float inv = 1.f / lt;
    __bf16* AO = (__bf16*)(p.ws + WS_AO) + ((size_t)b * 32 + 4 * qb + (w >> 1)) * 32768 + (size_t)(((w & 1) * 8 + h) * 4) * 512;
#pragma unroll
    for (int d = 0; d < 2; ++d)
#pragma unroll
        for (int gp = 0; gp < 2; ++gp)
            *(u32x4*)(AO + ((size_t)((d * 2 + gp) * 64) + lane) * 8) = widen_pair(pk4(o[d][8 * gp] * inv, o[d][8 * gp + 1] * inv, o[d][8 * gp + 2] * inv, o[d][8 * gp + 3] * inv),
                                                                    pk4(o[d][8 * gp + 4] * inv, o[d][8 * gp + 5] * inv, o[d][8 * gp + 6] * inv, o[d][8 * gp + 7] * inv));
}

constexpr int DVS = 80;
constexpr int DW_BYTES = 8192 + 32 * DVS + 16 * DVS;
typedef short s16x4 __attribute__((ext_vector_type(4)));
__device__ __forceinline__ f32x4 mfma16(bf16x8 a, bf16x8 b, f32x4 c) { return __builtin_amdgcn_mfma_f32_16x16x32_bf16(a, b, c, 0, 0, 0); }
__device__ __forceinline__ s16x4 lds_tr16(const unsigned char* q) { return __builtin_amdgcn_ds_read_tr16_b64_v4i16((LAS s16x4*)q); }
__device__ void p2_decode(const Params& p, int bs, int split, unsigned char* lds) {
    int tid = threadIdx.x; asm volatile("" : "+v"(tid));
    const int lane = tid & 63, w = tid >> 6, l15 = lane & 15, q4 = lane >> 4;
    unsigned char* IMG = lds + LDS_BASE + w * DW_BYTES;
    unsigned char* KRI = IMG + 8192;
    unsigned char* WP = KRI + 32 * DVS;
    const __bf16* QLR = (const __bf16*)(p.ws + WS_QLR);
    const int pg0 = split * 16 + 2 * w;
    const int phys0 = p.page_table[bs * NPAGES + pg0], phys1 = p.page_table[bs * NPAGES + pg0 + 1];
    f32x4 raw[20];
#define DEC_ISSUE(tt_) do { const int phys_ = ((tt_) >> 2) ? phys1 : phys0; \
        const float* lp_ = p.cache_lat + ((size_t)phys_ * 128 + ((tt_) & 3) * 32) * 128 + 4 * lane; \
        const float* kp_ = p.cache_kr + ((size_t)phys_ * 128 + ((tt_) & 3) * 32) * 32 + 4 * lane; \
        _Pragma("unroll") for (int i = 0; i < 16; ++i) raw[i] = __builtin_nontemporal_load((const f32x4*)(lp_ + 256 * i)); \
        _Pragma("unroll") for (int i = 0; i < 4; ++i) raw[16 + i] = __builtin_nontemporal_load((const f32x4*)(kp_ + 256 * i)); } while (0)
    DEC_ISSUE(0);
    bf16x8 qf[5];
#pragma unroll
    for (int ks = 0; ks < 5; ++ks) {
        u32x4 v = *(const u32x4*)(QLR + ((size_t)bs * 8 + (l15 & 7)) * 160 + 32 * ks + 8 * q4);
        if (l15 >= 8) v = (u32x4){0u, 0u, 0u, 0u};
        qf[ks] = __builtin_bit_cast(bf16x8, v);
    }
    const int hi = lane >> 5;
    const int W0 = 256 * hi + 16 * (((lane & 31) >> 1) ^ (hi << 2)) + 8 * (lane & 1);
    const int KW0 = (lane >> 3) * DVS + 8 * (lane & 7);
    const int RB0 = 256 * l15 + 16 * (q4 ^ (l15 >> 2)) + 64 * (l15 & 3);
    const int TQ = l15 >> 2, TP = lane & 3;
    const int T00 = 256 * (8 * q4 + TQ) + 16 * ((TP >> 1) ^ ((TQ << 2) | ((2 * q4) & 3))) + 8 * (TP & 1);
    const int T01 = 256 * (8 * q4 + 4 + TQ) + 16 * ((TP >> 1) ^ ((TQ << 2) | ((2 * q4 + 1) & 3))) + 8 * (TP & 1);
    f32x4 o[8];
#pragma unroll
    for (int t = 0; t < 8; ++t) o[t] = (f32x4){0.f, 0.f, 0.f, 0.f};
    float m = -1e30f, l = 0.f;
#pragma unroll 1
    for (int tt = 0; tt < 8; ++tt) {
#pragma unroll
        for (int i = 0; i < 16; ++i) {
            const int ci = (((2 * i) & 3) << 2) | ((i >> 1) & 3);
            *(u32x2*)(IMG + 512 * i + (W0 ^ (ci << 4))) = pk4(raw[i][0], raw[i][1], raw[i][2], raw[i][3]);
        }
#pragma unroll
        for (int i = 0; i < 4; ++i) *(u32x2*)(KRI + 8 * i * DVS + KW0) = pk4(raw[16 + i][0], raw[16 + i][1], raw[16 + i][2], raw[16 + i][3]);
        asm volatile("" ::: "memory");
        DEC_ISSUE(tt < 7 ? tt + 1 : 7);
        f32x4 s[2];
#pragma unroll
        for (int j = 0; j < 2; ++j) {
            s[j] = (f32x4){0.f, 0.f, 0.f, 0.f};
#pragma unroll
            for (int ks = 0; ks < 4; ++ks) {
                const bf16x8 kf = *(const bf16x8*)(IMG + 4096 * j + (RB0 ^ (ks << 6)));
                s[j] = mfma16(kf, qf[ks], s[j]);
            }
            const bf16x8 kf = *(const bf16x8*)(KRI + (16 * j + l15) * DVS + 16 * q4);
            s[j] = mfma16(kf, qf[4], s[j]);
        }
        float mx = fmaxf(fmaxf(fmaxf(s[0][0], s[0][1]), fmaxf(s[0][2], s[0][3])), fmaxf(fmaxf(s[1][0], s[1][1]), fmaxf(s[1][2], s[1][3])));
        mx = xor32_max(xor16_max(mx));
        const float mn = fmaxf(m, mx), alpha = ex2(m - mn);
        m = mn;
        float ps = 0.f;
#pragma unroll
        for (int j = 0; j < 2; ++j)
#pragma unroll
            for (int r = 0; r < 4; ++r) { s[j][r] = ex2(s[j][r] - mn); ps += s[j][r]; }
        l = l * alpha + ps;
#pragma unroll
        for (int t = 0; t < 8; ++t)
#pragma unroll
            for (int r = 0; r < 4; ++r) o[t][r] = mul1(o[t][r], alpha);
#pragma unroll
        for (int j = 0; j < 2; ++j) *(u32x2*)(WP + l15 * DVS + (16 * j + 4 * q4) * 2) = pk4(s[j][0], s[j][1], s[j][2], s[j][3]);
        {
            const bf16x8 pf = *(const bf16x8*)(WP + l15 * DVS + 8 * q4 * 2);
#pragma unroll
            for (int t = 0; t < 8; ++t) {
                const s16x4 v0 = lds_tr16(IMG + (T00 ^ (t << 5))), v1 = lds_tr16(IMG + (T01 ^ (t << 5)));
                typedef short s16x8 __attribute__((ext_vector_type(8)));
                const s16x8 vv = {v0[0], v0[1], v0[2], v0[3], v1[0], v1[1], v1[2], v1[3]};
                o[t] = mfma16(__builtin_bit_cast(bf16x8, vv), pf, o[t]);
            }
        }
    }
#undef DEC_ISSUE
    float lt = xor32_sum(xor16_sum(l));
    __syncthreads();
    float* MG = (float*)(lds + LDS_BASE);
    if (l15 < 8) {
        float* rec = MG + (w * 8 + l15) * 132;
        if (q4 == 0) { rec[0] = m; rec[1] = lt; }
#pragma unroll
        for (int t = 0; t < 8; ++t) *(f32x4*)(rec + 4 + 16 * t + 4 * q4) = o[t];
    }
    __syncthreads();
    {
        const int hd = tid >> 6, r2 = 2 * (tid & 63);
        float M = -1e30f;
#pragma unroll
        for (int ww = 0; ww < 8; ++ww) M = fmaxf(M, MG[(ww * 8 + hd) * 132]);
        float L = 0.f, o0 = 0.f, o1 = 0.f;
#pragma unroll
        for (int ww = 0; ww < 8; ++ww) {
            const float* rec = MG + (ww * 8 + hd) * 132;
            const float wt = ex2(rec[0] - M);
            L = fmaf(wt, rec[1], L); o0 = fmaf(wt, rec[4 + r2], o0); o1 = fmaf(wt, rec[5 + r2], o1);
        }
        float* dp = (float*)(p.ws + WS_DPART) + ((size_t)(bs * 4 + split) * 8 + hd) * 132;
        if ((tid & 63) == 0) { dp[0] = M; dp[1] = L; }
        f32x2 ov = {o0, o1};
        *(f32x2*)(dp + 4 + r2) = ov;
    }
    __syncthreads();
}

__device__ void p2_scan(const Params& p, int bh) {
    int tid = threadIdx.x; asm volatile("" : "+v"(tid));
    const int lane = tid & 63, w = tid >> 6, l31 = lane & 31, hh = lane >> 5;
    const int dkt = w & 1, dvt = w >> 1;
    const float* BT = (const float*)(p.ws + WS_BT) + (size_t)bh * 64 * 2048;
    const __bf16* GKT = (const __bf16*)(p.ws + WS_GKT) + (size_t)bh * 64 * 2048;
    const __bf16* GVT = (const __bf16*)(p.ws + WS_GVT) + (size_t)bh * 128 * 2048;
    const float* BL = (const float*)(p.ws + WS_BL) + (size_t)bh * 32 * 64;
    __bf16* ST2 = (__bf16*)(p.ws + WS_ST2) + (size_t)bh * 32 * 128 * 64;
    const int dkA = 32 * dkt + l31, dvB = 32 * dvt + l31;
    f32x16 S;
#pragma unroll
    for (int r = 0; r < 16; ++r) S[r] = 0.f;
    float decN[16], blN; u32x4 kN[4]; f32x4 b0N[4], b1N[4]; bf16x8 vN[4];
#define SCAN_LOAD(c_) do { \
        _Pragma("unroll") for (int r = 0; r < 16; ++r) decN[r] = BL[(c_) * 64 + 32 * dkt + (r & 3) + 8 * (r >> 2) + 4 * hh]; \
        blN = BL[(c_) * 64 + dkA]; \
        _Pragma("unroll") for (int ks = 0; ks < 4; ++ks) { const size_t k16 = (size_t)(c_) * 4 + ks; \
            kN[ks] = *(const u32x4*)(GKT + ((k16 * 2 + dkt) * 64 + lane) * 8); \
            b0N[ks] = *(const f32x4*)(BT + ((k16 * 2 + dkt) * 64 + lane) * 8); b1N[ks] = *(const f32x4*)(BT + ((k16 * 2 + dkt) * 64 + lane) * 8 + 4); \
            vN[ks] = *(const bf16x8*)(GVT + ((k16 * 4 + dvt) * 64 + lane) * 8); } \
    } while (0)
    SCAN_LOAD(0);
#pragma unroll 1
    for (int c = 0; c < 32; ++c) {
        float dec[16]; u32x4 kC[4]; f32x4 b0C[4], b1C[4]; bf16x8 vC[4];
        const float blast = blN;
#pragma unroll
        for (int r = 0; r < 16; ++r) dec[r] = decN[r];
#pragma unroll
        for (int ks = 0; ks < 4; ++ks) { kC[ks] = kN[ks]; b0C[ks] = b0N[ks]; b1C[ks] = b1N[ks]; vC[ks] = vN[ks]; }
        SCAN_LOAD(c + 1);
        __builtin_amdgcn_sched_barrier(0);
#pragma unroll
        for (int gp = 0; gp < 2; ++gp)
            *(u32x4*)(ST2 + (size_t)c * 8192 + ((size_t)((dvt * 4 + 2 * dkt + gp) * 64) + lane) * 8) = widen_pair(        pk4(S[8 * gp], S[8 * gp + 1], S[8 * gp + 2], S[8 * gp + 3]), pk4(S[8 * gp + 4], S[8 * gp + 5], S[8 * gp + 6], S[8 * gp + 7]));
#pragma unroll
        for (int r = 0; r < 16; ++r) S[r] *= __expf(dec[r]);
#pragma unroll
        for (int ks = 0; ks < 4; ++ks) {
            float kv[8]; unpack8(kC[ks], kv);
            bf16x8 ka;
#pragma unroll
            for (int e = 0; e < 4; ++e) { ka[e] = (__bf16)(kv[e] * __expf(blast - b0C[ks][e])); ka[4 + e] = (__bf16)(kv[4 + e] * __expf(blast - b1C[ks][e])); }
            S = mfma32(ka, vC[ks], S);
        }
        __builtin_amdgcn_sched_barrier(0);
    }
#undef SCAN_LOAD
    float* stp = p.out + OUT_STP + (size_t)bh * 64 * 128;
#pragma unroll
    for (int r = 0; r < 16; ++r) {
        const int dkr = 32 * dkt + (r & 3) + 8 * (r >> 2) + 4 * hh;
        stp[(size_t)dkr * 128 + dvB] = S[r];
    }
}

__device__ void p2_glarec(const Params& p, int bs, unsigned char* lds) {
    int tid = threadIdx.x; asm volatile("" : "+v"(tid));
    float* sq = (float*)(lds + LDS_BASE); float* sk = sq + 256; float* se = sk + 256;
    const __bf16* GQ = (const __bf16*)(p.ws + WS_GQ) + (size_t)(NTOK + bs) * 256;
    const __bf16* GK = (const __bf16*)(p.ws + WS_GK) + (size_t)(NTOK + bs) * 256;
    const float* LAB = (const float*)(p.ws + WS_LAB) + (size_t)(NTOK + bs) * 256;
    if (tid < 256) { sq[tid] = (float)GQ[tid]; sk[tid] = (float)GK[tid]; se[tid] = __expf(LAB[tid]); }
    __syncthreads();
    const int h = tid >> 7, dv = tid & 127;
    const float v = (float)((const __bf16*)(p.ws + WS_GV))[(size_t)(NTOK + bs) * 512 + h * 128 + dv];
    const float* s0 = p.state_gla + ((size_t)(bs * 4 + h) * 64) * 128 + dv;
    float* s1 = p.out + OUT_STS + ((size_t)(bs * 4 + h) * 64) * 128 + dv;
    float o = 0.f;
#pragma unroll 1
    for (int d0 = 0; d0 < 64; d0 += 32) {
        float sv[32];
#pragma unroll
        for (int u = 0; u < 32; ++u) sv[u] = __builtin_nontemporal_load(s0 + (size_t)(d0 + u) * 128);
        __builtin_amdgcn_sched_barrier(0);
#pragma unroll
        for (int u = 0; u < 32; ++u) {
            const int dk = d0 + u;
            const float ns = se[h * 64 + dk] * sv[u] + sk[h * 64 + dk] * v;
            __builtin_nontemporal_store(ns, s1 + (size_t)dk * 128);
            o = fmaf(sq[h * 64 + dk], ns, o);
        }
    }
    ((float*)(p.ws + WS_GLAOS))[(size_t)(bs * 4 + h) * 128 + dv] = o;
    __syncthreads();
}

__device__ __forceinline__ void p3_outproj(const Params& p, int it, unsigned char* lds);
__device__ void p3_stripe(const Params& p, int it, unsigned char* lds) {
    int tid = threadIdx.x; asm volatile("" : "+v"(tid));
    const int lane = tid & 63, w = tid >> 6, l31 = lane & 31, hh = lane >> 5;
    const bool is_s = it >= 512;
    const int srow0 = is_s ? (it - 512) * 32 : 0;
    const int st = it >> 1, half = it & 1;
    const int tok0 = is_s ? NTOK + srow0 : st * 64 + 32 * half;
    const int b = st >> 5, c = st & 31, s0 = c * 64;
    unsigned char* A = lds + LDS_BASE;
    unsigned char* LB = A + 32 * XS;
    constexpr int LBS = 1040;
    const __bf16* GM = (const __bf16*)(p.ws + WS_GM);
    const __bf16* GG = (const __bf16*)(p.ws + WS_GG);
    if (!is_s) {
        const __bf16* AO = (const __bf16*)(p.ws + WS_AO);
        const int h = w >> 1, dvh = w & 1, bh = b * 4 + h;
        const int ti = 32 * half + l31;
        const size_t trow = (size_t)(st * 64 + ti);
        const __bf16* GQ = (const __bf16*)(p.ws + WS_GQ);
        const __bf16* GK = (const __bf16*)(p.ws + WS_GK);
        const float* LAB = (const float*)(p.ws + WS_LAB);
        const __bf16* GVT = (const __bf16*)(p.ws + WS_GVT) + (size_t)bh * 128 * 2048;
        const __bf16* ST2 = (const __bf16*)(p.ws + WS_ST2) + ((size_t)bh * 32 + c) * 128 * 64;
        bf16x8 qf[4], kf0[4], vf0[2][2];
        {
            u32x4 av[4], gv[4];
            u32x4 qr[4], kr[4]; f32x4 qb0[4], qb1[4], kb0[4], kb1[4];
            f32x4 lab[8];
            const int nlab = half ? 8 : 4;
            const size_t jrow = (size_t)(st * 64 + l31);
#pragma unroll
            for (int i = 0; i < 4; ++i) {
                const int idx = i * NTHR + tid, row = idx >> 6, ch = idx & 63;
                av[i] = *(const u32x4*)(AO + (size_t)st * 32768 + ((size_t)half * 2048 + idx) * 8);
                gv[i] = *(const u32x4*)(GM + (size_t)st * 32768 + ((size_t)half * 2048 + idx) * 8);
            }
#pragma unroll
            for (int ks = 0; ks < 4; ++ks) {
                const int dk0 = h * 64 + 16 * ks + 8 * hh;
                qr[ks] = *(const u32x4*)(GQ + (size_t)st * 64 * 256 + ((size_t)((half * 4 + h) * 4 + ks) * 64 + lane) * 8);
                kr[ks] = *(const u32x4*)(GK + (size_t)st * 64 * 256 + ((size_t)((0 * 4 + h) * 4 + ks) * 64 + lane) * 8);
            }
#pragma unroll
            for (int sk = 0; sk < 2; ++sk)
#pragma unroll
                for (int t = 0; t < 2; ++t) vf0[sk][t] = *(const bf16x8*)(GVT + ((((size_t)(s0 >> 4) + sk) * 4 + 2 * dvh + t) * 64 + lane) * 8);
#pragma unroll
            for (int i = 0; i < 8; ++i) if (i < nlab) lab[i] = *(const f32x4*)(LAB + (size_t)st * 64 * 256 + (size_t)(i * NTHR + tid) * 4);
            __builtin_amdgcn_sched_barrier(0);
#pragma unroll
            for (int i = 0; i < 4; ++i) {
                const int idx = i * NTHR + tid, row = idx & 31, ch = 8 * (idx >> 8) + 4 * ((idx >> 7) & 1) + 2 * ((idx >> 6) & 1) + ((idx >> 5) & 1);
                float af[8], gf[8]; unpack8(av[i], af); unpack8(gv[i], gf);
                u32x4 o; o.x = pk2(af[0] * gf[0], af[1] * gf[1]); o.y = pk2(af[2] * gf[2], af[3] * gf[3]); o.z = pk2(af[4] * gf[4], af[5] * gf[5]); o.w = pk2(af[6] * gf[6], af[7] * gf[7]);
                *(u32x4*)(A + row * XS + ch * 16) = o;
            }
#pragma unroll
            for (int i = 0; i < 8; ++i) if (i < nlab) { const int idx = i * NTHR + tid; *(f32x4*)(LB + (idx >> 6) * LBS + (idx & 63) * 16) = lab[i]; }
            __syncthreads();
#pragma unroll
            for (int ks = 0; ks < 4; ++ks) {
                const int cb = (h * 64 + 16 * ks + 8 * hh) * 4;
                qb0[ks] = *(const f32x4*)(LB + (32 * half + l31) * LBS + cb); qb1[ks] = *(const f32x4*)(LB + (32 * half + l31) * LBS + cb + 16);
                kb0[ks] = *(const f32x4*)(LB + l31 * LBS + cb); kb1[ks] = *(const f32x4*)(LB + l31 * LBS + cb + 16);
            }
#pragma unroll
            for (int ks = 0; ks < 4; ++ks) {
                float qv[8], kv[8]; unpack8(qr[ks], qv); unpack8(kr[ks], kv);
#pragma unroll
                for (int e = 0; e < 4; ++e) {
                    qf[ks][e] = (__bf16)(qv[e] * __expf(qb0[ks][e])); qf[ks][4 + e] = (__bf16)(qv[4 + e] * __expf(qb1[ks][e]));
                    kf0[ks][e] = (__bf16)(kv[e] * __expf(-kb0[ks][e])); kf0[ks][4 + e] = (__bf16)(kv[4 + e] * __expf(-kb1[ks][e]));
                }
            }
        }
        bf16x8 sf[4][2], vf1[2][2]; u32x4 kr1[4]; f32x4 kb10[4], kb11[4], gn[2][4]; u32x2 gg[2][4];
        {
            const size_t jrow1 = (size_t)(st * 64 + 32 + l31);
#pragma unroll
            for (int ks = 0; ks < 4; ++ks) {
                const int dk0 = h * 64 + 16 * ks + 8 * hh;
#pragma unroll
                for (int t = 0; t < 2; ++t) sf[ks][t] = *(const bf16x8*)(ST2 + ((size_t)(((2 * dvh + t) * 4 + ks) * 64) + lane) * 8);
                kr1[ks] = *(const u32x4*)(GK + (size_t)st * 64 * 256 + ((size_t)((1 * 4 + h) * 4 + ks) * 64 + lane) * 8);
                kb10[ks] = *(const f32x4*)(LB + (32 + l31) * LBS + dk0 * 4); kb11[ks] = *(const f32x4*)(LB + (32 + l31) * LBS + dk0 * 4 + 16);
            }
#pragma unroll
            for (int sk = 0; sk < 2; ++sk)
#pragma unroll
                for (int t = 0; t < 2; ++t) vf1[sk][t] = *(const bf16x8*)(GVT + ((((size_t)(s0 >> 4) + 2 + sk) * 4 + 2 * dvh + t) * 64 + lane) * 8);
#pragma unroll
            for (int t = 0; t < 2; ++t)
#pragma unroll
                for (int g = 0; g < 4; ++g) {
                    const int dv = 32 * (2 * dvh + t) + 8 * g + 4 * hh;
                    gn[t][g] = *(const f32x4*)(p.gla_norm_g + h * 128 + dv);
                    if (g == 0) {
                        const u32x4* gq_ = (const u32x4*)(GG + (size_t)st * 64 * 512 + ((size_t)((half * 8 + 2 * h + dvh) * 2 + t) * 64 + lane) * 16);
                        const u32x4 lo = gq_[0], hi = gq_[1];
                        gg[t][0].x = lo.x; gg[t][0].y = lo.y; gg[t][1].x = lo.z; gg[t][1].y = lo.w;
                        gg[t][2].x = hi.x; gg[t][2].y = hi.y; gg[t][3].x = hi.z; gg[t][3].y = hi.w;
                    }
                }
        }
        __builtin_amdgcn_sched_barrier(0);
        f32x16 o[2];
#pragma unroll
        for (int t = 0; t < 2; ++t)
#pragma unroll
            for (int r = 0; r < 16; ++r) o[t][r] = 0.f;
        {
            f32x16 att;
#pragma unroll
            for (int r = 0; r < 16; ++r) att[r] = 0.f;
#pragma unroll
            for (int ks = 0; ks < 4; ++ks) att = mfma32(kf0[ks], qf[ks], att);
            if (half == 0) {
#pragma unroll
                for (int r = 0; r < 16; ++r) { const int j = (r & 3) + 8 * (r >> 2) + 4 * hh; if (j > l31) att[r] = 0.f; }
            }
#pragma unroll
            for (int sk = 0; sk < 2; ++sk) {
                bf16x8 pf;
#pragma unroll
                for (int e = 0; e < 8; ++e) pf[e] = (__bf16)att[8 * sk + e];
#pragma unroll
                for (int t = 0; t < 2; ++t) o[t] = mfma32(vf0[sk][t], pf, o[t]);
            }
        }
        __builtin_amdgcn_sched_barrier(0);
        if (half == 1) {
            f32x16 att;
#pragma unroll
            for (int r = 0; r < 16; ++r) att[r] = 0.f;
#pragma unroll
            for (int ks = 0; ks < 4; ++ks) {
                float kv[8]; unpack8(kr1[ks], kv);
                bf16x8 kf;
#pragma unroll
                for (int e = 0; e < 4; ++e) { kf[e] = (__bf16)(kv[e] * __expf(-kb10[ks][e])); kf[4 + e] = (__bf16)(kv[4 + e] * __expf(-kb11[ks][e])); }
                att = mfma32(kf, qf[ks], att);
            }
#pragma unroll
            for (int r = 0; r < 16; ++r) { const int j = (r & 3) + 8 * (r >> 2) + 4 * hh; if (j > l31) att[r] = 0.f; }
#pragma unroll
            for (int sk = 0; sk < 2; ++sk) {
                bf16x8 pf;
#pragma unroll
                for (int e = 0; e < 8; ++e) pf[e] = (__bf16)att[8 * sk + e];
#pragma unroll
                for (int t = 0; t < 2; ++t) o[t] = mfma32(vf1[sk][t], pf, o[t]);
            }
        }
#pragma unroll
        for (int ks = 0; ks < 4; ++ks)
#pragma unroll
            for (int t = 0; t < 2; ++t) o[t] = mfma32(sf[ks][t], qf[ks], o[t]);
        float ss = 0.f;
#pragma unroll
        for (int t = 0; t < 2; ++t)
#pragma unroll
            for (int r = 0; r < 16; ++r) ss = fmaf(o[t][r], o[t][r], ss);
        ss = xor32_sum(ss);
        float* SSX = (float*)(lds + LDS_BASE + 64 * XS + 1024);
        if (hh == 0) SSX[w * 32 + l31] = ss;
        __syncthreads();
        ss += SSX[(w ^ 1) * 32 + l31];
        const float inv = rsqrtf(ss * (1.f / 128.f) + NORM_EPS);
#pragma unroll
        for (int t = 0; t < 2; ++t)
#pragma unroll
            for (int g = 0; g < 4; ++g) {
                const int dv = 32 * (2 * dvh + t) + 8 * g + 4 * hh;
                *(u32x2*)(A + l31 * XS + (512 + h * 128 + dv) * 2) =
                    pk4(o[t][4 * g] * inv * gn[t][g][0] * bflo(gg[t][g].x), o[t][4 * g + 1] * inv * gn[t][g][1] * bfhi(gg[t][g].x),
                        o[t][4 * g + 2] * inv * gn[t][g][2] * bflo(gg[t][g].y), o[t][4 * g + 3] * inv * gn[t][g][3] * bfhi(gg[t][g].y));
            }
    }
    __syncthreads();
    p3_outproj(p, it, lds);
}

__device__ __forceinline__ void p3_outproj(const Params& p, int it, unsigned char* lds) {
    int tid = threadIdx.x; asm volatile("" : "+v"(tid));
    const int lane = tid & 63, w = tid >> 6, l31 = lane & 31, hh = lane >> 5;
    const int st = it >> 1, half = it & 1, b = st >> 5;
    unsigned char* A = lds + LDS_BASE;
    unsigned char* G0 = A + 32 * XS;
    const u32x4* woutf = (const u32x4*)(p.ws + WS_WOUTF);
    const size_t row0 = (size_t)st * 64 + 32 * half;
    f32x4 xr[4][4];
    f32x4 gt[4], lg[4], lb[4];
    u32x4 ra[8], rb[8];
    {
        const u32x4* w0 = woutf + (size_t)w * 2 * 64 * 64 + lane;
#pragma unroll
        for (int u = 0; u < 8; ++u) { ra[u] = w0[u * 64]; rb[u] = w0[(64 + u) * 64]; }
    }
#pragma unroll
    for (int q = 0; q < 2; ++q) {
        f32x16 acc[2];
#pragma unroll
        for (int nt = 0; nt < 2; ++nt)
#pragma unroll
            for (int r = 0; r < 16; ++r) acc[nt][r] = 0.f;
        {
            const unsigned char* x0 = A + l31 * XS + hh * 16;
            const u32x4* w0 = woutf + (size_t)(w + 8 * q) * 2 * 64 * 64 + lane;
            const u32x4* w1 = w0 + 64 * 64;
            const u32x4* nx0 = woutf + (size_t)(w + 8) * 2 * 64 * 64 + lane;
            if (q == 1) {
                const float* xp = p.x_prompt + (row0 + 4 * w) * 1024 + 4 * lane;
#pragma unroll
                for (int i = 0; i < 4; ++i)
#pragma unroll
                    for (int j = 0; j < 4; ++j) xr[i][j] = __builtin_nontemporal_load((const f32x4*)(xp + (size_t)i * 1024 + 256 * j));
            }
            bf16x8 b0 = *(const bf16x8*)(x0);
#pragma unroll 1
            for (int k0 = 0; k0 < 64; k0 += 8) {
#pragma unroll
                for (int u = 0; u < 8; ++u) {
                    const int ks = k0 + u;
                    const bf16x8 nb0 = *(const bf16x8*)(x0 + (ks + 1) * 32);
                    const bf16x8 a0 = __builtin_bit_cast(bf16x8, ra[u]), a1 = __builtin_bit_cast(bf16x8, rb[u]);
                    if (k0 < 56) { ra[u] = w0[(ks + 8) * 64]; rb[u] = w1[(ks + 8) * 64]; }
                    else { ra[u] = nx0[u * 64]; rb[u] = nx0[(64 + u) * 64]; }
                    __builtin_amdgcn_sched_barrier(0);
                    acc[0] = mfma32(a0, b0, acc[0]); acc[1] = mfma32(a1, b0, acc[1]);
                    __builtin_amdgcn_sched_barrier(0);
                    b0 = nb0;
                }
            }
        }
        if (q == 1) {
            const float* mod = (const float*)(p.ws + WS_MOD);
#pragma unroll
            for (int j = 0; j < 4; ++j) {
                gt[j] = *(const f32x4*)(mod + (size_t)b * 3072 + 2048 + 256 * j + 4 * lane);
                lg[j] = *(const f32x4*)(p.ln_g + 256 * j + 4 * lane);
                lb[j] = *(const f32x4*)(p.ln_b + 256 * j + 4 * lane);
            }
            __syncthreads();
        }
        unsigned char* G = (q == 0) ? G0 : A;
#pragma unroll
        for (int nt = 0; nt < 2; ++nt)
#pragma unroll
            for (int g = 0; g < 4; ++g) {
                f32x4 v = {acc[nt][4 * g], acc[nt][4 * g + 1], acc[nt][4 * g + 2], acc[nt][4 * g + 3]};
                *(f32x4*)(G + l31 * XS + (64 * w + 32 * nt + 8 * g + 4 * hh) * 4) = v;
            }
    }
    __syncthreads();
    {
#pragma unroll
        for (int i = 0; i < 4; ++i) {
            const int r = 4 * w + i;
            f32x4 v[4];
            float s1 = 0.f, s2 = 0.f;
#pragma unroll
            for (int j = 0; j < 4; ++j) {
                const f32x4 gv = *(const f32x4*)(((j < 2) ? G0 : A) + r * XS + (256 * (j & 1) + 4 * lane) * 4);
#pragma unroll
                for (int e = 0; e < 4; ++e) { const float t = DN_ALPHA * xr[i][j][e] + gt[j][e] * gv[e]; v[j][e] = t; s1 += t; s2 = fmaf(t, t, s2); }
            }
            s1 = wave_sum(s1); s2 = wave_sum(s2);
            const float mean = s1 * (1.f / 1024.f);
            const float var = fmaxf(s2 * (1.f / 1024.f) - mean * mean, 0.f);
            const float rstd = rsqrtf(var + NORM_EPS);
            float* yp = p.out + OUT_YP + (row0 + r) * 1024 + 4 * lane;
#pragma unroll
            for (int j = 0; j < 4; ++j) {
                f32x4 y;
#pragma unroll
                for (int e = 0; e < 4; ++e) y[e] = (v[j][e] - mean) * rstd * lg[j][e] + lb[j][e];
                __builtin_nontemporal_store(y, (f32x4*)(yp + 256 * j));
            }
        }
    }
    __syncthreads();
}

__device__ void p3s_arows(const Params& p, int k, unsigned char* lds) {
    int tid = threadIdx.x; asm volatile("" : "+v"(tid));
    const int lane = tid & 63, w = tid >> 6, l31 = lane & 31, hh = lane >> 5;
    const int r0 = 8 * k, h = w;
    const __bf16* QLR = (const __bf16*)(p.ws + WS_QLR);
    const float* DP = (const float*)(p.ws + WS_DPART);
    const float* lat_s = p.out + OUT_LATS;
    const float* kr_s = p.out + OUT_KRS;
    const __bf16* GM = (const __bf16*)(p.ws + WS_GM);
    const __bf16* GG = (const __bf16*)(p.ws + WS_GG);
    __bf16* AS = (__bf16*)(p.ws + WS_AS);
    unsigned char* OL = lds + LDS_BASE + w * 2304;
#pragma unroll 1
    for (int q0 = 0; q0 < 8; q0 += 4) {
        float qa[4], qb[4], qc[4], la[4], lb2[4], kc[4], mi[4][4], li[4][4];
        f32x2 ln[4], ov[4][4];
#pragma unroll
        for (int u = 0; u < 4; ++u) {
            const int bs = r0 + q0 + u;
            const __bf16* ql = QLR + ((size_t)bs * 8 + h) * 160;
            qa[u] = (float)ql[lane]; qb[u] = (float)ql[64 + lane]; qc[u] = (float)ql[128 + (lane & 31)];
            la[u] = lat_s[(size_t)bs * 128 + lane]; lb2[u] = lat_s[(size_t)bs * 128 + 64 + lane]; kc[u] = kr_s[(size_t)bs * 32 + (lane & 31)];
            ln[u] = *(const f32x2*)(lat_s + (size_t)bs * 128 + 2 * lane);
#pragma unroll
            for (int sp = 0; sp < 4; ++sp) {
                const float* d = DP + ((size_t)(bs * 4 + sp) * 8 + h) * 132;
                mi[u][sp] = d[0]; li[u][sp] = d[1]; ov[u][sp] = *(const f32x2*)(d + 4 + 2 * lane);
            }
        }
        __builtin_amdgcn_sched_barrier(0);
#pragma unroll
        for (int u = 0; u < 4; ++u) {
            float part = qa[u] * la[u] + qb[u] * lb2[u];
            if (lane < 32) part += qc[u] * kc[u];
            const float sn = wave_sum(part);
            float M = sn;
#pragma unroll
            for (int sp = 0; sp < 4; ++sp) M = fmaxf(M, mi[u][sp]);
            const float wn = ex2(sn - M);
            float L = wn, o0 = wn * ln[u][0], o1 = wn * ln[u][1];
#pragma unroll
            for (int sp = 0; sp < 4; ++sp) {
                const float wt = ex2(mi[u][sp] - M);
                L = fmaf(wt, li[u][sp], L); o0 = fmaf(wt, ov[u][sp][0], o0); o1 = fmaf(wt, ov[u][sp][1], o1);
            }
            const float inv = __builtin_amdgcn_rcpf(L);
            *(unsigned*)(OL + (q0 + u) * 288 + 4 * lane) = pk2(o0 * inv, o1 * inv);
        }
    }
    asm volatile("s_waitcnt lgkmcnt(0)" ::: "memory");
    {
        const __bf16* wuvt = (const __bf16*)(p.ws + WS_WUVT);
        f32x16 mo[2];
#pragma unroll
        for (int vt = 0; vt < 2; ++vt)
#pragma unroll
            for (int r = 0; r < 16; ++r) mo[vt][r] = 0.f;
        bf16x8 ob[8], wa[2][8];
        const int tk = (l31 < 8) ? l31 : 7;
#pragma unroll
        for (int ks = 0; ks < 8; ++ks) {
            ob[ks] = *(const bf16x8*)(OL + tk * 288 + (16 * ks + 8 * hh) * 2);
            wa[0][ks] = *(const bf16x8*)(wuvt + ((size_t)h * 64 + l31) * 128 + 16 * ks + 8 * hh);
            wa[1][ks] = *(const bf16x8*)(wuvt + ((size_t)h * 64 + 32 + l31) * 128 + 16 * ks + 8 * hh);
        }
        __builtin_amdgcn_sched_barrier(0);
#pragma unroll
        for (int ks = 0; ks < 8; ++ks)
#pragma unroll
            for (int vt = 0; vt < 2; ++vt) mo[vt] = mfma32(wa[vt][ks], ob[ks], mo[vt]);
        if (l31 < 8) {
#pragma unroll
            for (int vt = 0; vt < 2; ++vt)
#pragma unroll
                for (int g = 0; g < 4; ++g) {
                    const int v = 32 * vt + 8 * g + 4 * hh;
                    const u32x2 gm = *(const u32x2*)(GM + (size_t)(NTOK + r0 + l31) * 512 + h * 64 + v);
                    *(u32x2*)(AS + (size_t)(r0 + l31) * 1024 + h * 64 + v) =
                        pk4(mo[vt][4 * g] * bflo(gm.x), mo[vt][4 * g + 1] * bfhi(gm.x), mo[vt][4 * g + 2] * bflo(gm.y), mo[vt][4 * g + 3] * bfhi(gm.y));
                }
        }
    }
    {
        const float* GLAOS = (const float*)(p.ws + WS_GLAOS);
        f32x2 ov[4], gn[4]; unsigned gg[4];
#pragma unroll
        for (int u = 0; u < 4; ++u) {
            const int pr = w * 4 + u, t = pr >> 2, hg = pr & 3, bs = r0 + t;
            ov[u] = *(const f32x2*)(GLAOS + ((size_t)bs * 4 + hg) * 128 + 2 * lane);
            gn[u] = *(const f32x2*)(p.gla_norm_g + hg * 128 + 2 * lane);
            gg[u] = *(const unsigned*)(GG + (size_t)(NTOK + bs) * 512 + hg * 128 + 2 * lane);
        }
        __builtin_amdgcn_sched_barrier(0);
#pragma unroll
        for (int u = 0; u < 4; ++u) {
            const int pr = w * 4 + u, t = pr >> 2, hg = pr & 3, bs = r0 + t;
            const float ss = wave_sum(ov[u][0] * ov[u][0] + ov[u][1] * ov[u][1]);
            const float inv = rsqrtf(ss * (1.f / 128.f) + NORM_EPS);
            *(unsigned*)(AS + (size_t)bs * 1024 + 512 + hg * 128 + 2 * lane) = pk2(ov[u][0] * inv * gn[u][0] * bflo(gg[u]), ov[u][1] * inv * gn[u][1] * bfhi(gg[u]));
        }
    }
    __syncthreads();
}
__device__ void p3s_cols(const Params& p, int k, unsigned char* lds) {
    int tid = threadIdx.x; asm volatile("" : "+v"(tid));
    const int lane = tid & 63, w = tid >> 6, l31 = lane & 31, hh = lane >> 5;
    const int nt = w >> 1, mt = w & 1;
    unsigned char* A = lds + LDS_BASE;
    const __bf16* AS = (const __bf16*)(p.ws + WS_AS);
    const u32x4* woutf = (const u32x4*)(p.ws + WS_WOUTF);
    const float* mod = (const float*)(p.ws + WS_MOD);
    float* ST = (float*)(lds + LDS_BASE + 64 * XS);
    float* STATS = (float*)(p.ws + WS_STATS);
#pragma unroll 1
    for (int pass = 0; pass < 2; ++pass) {
        {
            u32x4 t[16];
#pragma unroll
            for (int i = 0; i < 16; ++i) { const int idx = i * NTHR + tid, row = idx >> 7, ch = idx & 127; t[i] = *(const u32x4*)(AS + (size_t)(64 * pass + row) * 1024 + 8 * ch); }
            __builtin_amdgcn_sched_barrier(0);
#pragma unroll
            for (int i = 0; i < 16; ++i) { const int idx = i * NTHR + tid, row = idx >> 7, ch = idx & 127; *(u32x4*)(A + row * XS + ch * 16) = t[i]; }
        }
        __syncthreads();
        f32x16 acc;
#pragma unroll
        for (int r = 0; r < 16; ++r) acc[r] = 0.f;
        const int row = 64 * pass + 32 * mt + l31;
        const int ncol = 128 * k + 32 * nt + 4 * hh;
        f32x4 xv[4], gt[4];
#pragma unroll
        for (int g = 0; g < 4; ++g) { xv[g] = *(const f32x4*)(p.x_sample + (size_t)row * 1024 + ncol + 8 * g); gt[g] = *(const f32x4*)(mod + (size_t)(8 + row) * 3072 + 2048 + ncol + 8 * g); }
        {
            const unsigned char* x0 = A + (32 * mt + l31) * XS + hh * 16;
            const u32x4* w0 = woutf + (size_t)(4 * k + nt) * 64 * 64 + lane;
            u32x4 ra[8];
#pragma unroll
            for (int u = 0; u < 8; ++u) ra[u] = w0[u * 64];
#pragma unroll 1
            for (int k0 = 0; k0 < 64; k0 += 8) {
#pragma unroll
                for (int u = 0; u < 8; ++u) {
                    const int ks = k0 + u;
                    const bf16x8 b0 = *(const bf16x8*)(x0 + ks * 32);
                    const bf16x8 a0 = __builtin_bit_cast(bf16x8, ra[u]);
                    ra[u] = w0[(ks + 8) * 64];
                    __builtin_amdgcn_sched_barrier(0);
                    acc = mfma32(a0, b0, acc);
                    __builtin_amdgcn_sched_barrier(0);
                }
            }
        }
        float s1 = 0.f, s2 = 0.f;
        float* yb = p.out + OUT_YS + (size_t)row * 1024 + ncol;
#pragma unroll
        for (int g = 0; g < 4; ++g) {
            f32x4 v;
#pragma unroll
            for (int i = 0; i < 4; ++i) { v[i] = DN_ALPHA * xv[g][i] + gt[g][i] * acc[4 * g + i]; s1 += v[i]; s2 = fmaf(v[i], v[i], s2); }
            *(f32x4*)(yb + 8 * g) = v;
        }
        s1 += __shfl_xor(s1, 32); s2 += __shfl_xor(s2, 32);
        if (hh == 0) { ST[(w * 32 + l31) * 2] = s1; ST[(w * 32 + l31) * 2 + 1] = s2; }
        __syncthreads();
        if (tid < 64) {
            const int m2 = tid >> 5, tk = tid & 31;
            float a = 0.f, bq = 0.f;
#pragma unroll
            for (int n2 = 0; n2 < 4; ++n2) { a += ST[((2 * n2 + m2) * 32 + tk) * 2]; bq += ST[((2 * n2 + m2) * 32 + tk) * 2 + 1]; }
            STATS[((size_t)k * NDEC + 64 * pass + tid) * 2] = a; STATS[((size_t)k * NDEC + 64 * pass + tid) * 2 + 1] = bq;
        }
        __syncthreads();
    }
}
__device__ void p3s_ln(const Params& p, int k, unsigned char* lds) {
    int tid = threadIdx.x; asm volatile("" : "+v"(tid));
    const int row = 32 * k + (tid >> 4), c0 = (tid & 15) * 64;
    const float* STATS = (const float*)(p.ws + WS_STATS);
    float a = 0.f, bq = 0.f;
#pragma unroll
    for (int j = 0; j < 8; ++j) { a += STATS[((size_t)j * NDEC + row) * 2]; bq += STATS[((size_t)j * NDEC + row) * 2 + 1]; }
    const float mean = a * (1.f / 1024.f);
    const float rstd = rsqrtf(fmaxf(bq * (1.f / 1024.f) - mean * mean, 0.f) + NORM_EPS);
    float* y = p.out + OUT_YS + (size_t)row * 1024 + c0;
    f32x4 v[16];
#pragma unroll
    for (int i = 0; i < 16; ++i) v[i] = *(const f32x4*)(y + 4 * i);
    __builtin_amdgcn_sched_barrier(0);
#pragma unroll
    for (int i = 0; i < 16; ++i) {
        const f32x4 lg = *(const f32x4*)(p.ln_g + c0 + 4 * i), lb = *(const f32x4*)(p.ln_b + c0 + 4 * i);
        f32x4 o;
#pragma unroll
        for (int e = 0; e < 4; ++e) o[e] = (v[i][e] - mean) * rstd * lg[e] + lb[e];
        *(f32x4*)(y + 4 * i) = o;
    }
}

__device__ __forceinline__ int q_next(unsigned* cnt, unsigned char* lds) {
    volatile LAS unsigned* slot = (volatile LAS unsigned*)(lds + 16);
    __syncthreads();
    if (threadIdx.x == 0) *slot = __hip_atomic_fetch_add(cnt, 1u, __ATOMIC_RELAXED, __HIP_MEMORY_SCOPE_AGENT);
    __syncthreads();
    return (int)*slot;
}
__device__ __forceinline__ void signal_done(unsigned* cnt) {
    asm volatile("s_waitcnt vmcnt(0)" ::: "memory");
    __syncthreads();
    if (threadIdx.x == 0) {
        __builtin_amdgcn_fence(__ATOMIC_RELEASE, "agent");
        asm volatile("s_waitcnt vmcnt(0)" ::: "memory");
        (void)__hip_atomic_fetch_add(cnt, 1u, __ATOMIC_RELAXED, __HIP_MEMORY_SCOPE_AGENT);
    }
}
__device__ __forceinline__ void wait_count(unsigned* bar, unsigned* cnt, unsigned want) {
    if (threadIdx.x == 0) {
        XB_SPIN(xb_ld(cnt) < want, bar);
        __builtin_amdgcn_fence(__ATOMIC_ACQUIRE, "agent");
        asm volatile("s_waitcnt vmcnt(0)" ::: "memory");
    }
    __syncthreads();
}

__global__ void __launch_bounds__(NTHR) fwd_mega(Params p, int ph_lo, int ph_hi, int use_bar) {
    extern __shared__ __attribute__((aligned(16))) unsigned char lds[];
    const int tid = threadIdx.x;
    if (use_bar) {
        if (tid == 0) { *(u32x4*)lds = (u32x4){0u, 0u, 0u, 0u}; }
        __syncthreads();
        (void)xcd_barrier_post((unsigned*)(p.ws + WS_CTL), (volatile LAS unsigned*)lds);
    }
    const int G = gridDim.x, bid = blockIdx.x;
    unsigned* ctl = (unsigned*)(p.ws + WS_CTL);
    for (int ph = ph_lo; ph < ph_hi; ++ph) {
        for (int rep = 0; rep < ((ph == REP_PH) ? 2 : 1); ++rep) {
        if (ph == 0) {
            const int sc0 = 0;
            for (int blk = bid - sc0; blk >= 0 && blk < 40; blk += G) { p0_silu_c(p, blk); signal_done(ctl + CW_SC + 16 * rep); }
            const int cb0 = (G >= 192) ? 96 : 0;
            if (bid >= cb0) p0_convert(p, cb0, G - cb0);
            if (bid < 96) wait_count(ctl, ctl + CW_SC + 16 * rep, 40u);
            for (int item = bid; item < 96; item += G) p0_mod_item(p, item, lds);
        } else if (ph == 1 || ph == 2) {
            bool sample_ok = false;
            int local = 0;
            for (;;) {
                int kind, a0, a1;
                if (ph == 1) { a0 = bid + local * G; ++local; if (a0 >= 256) break; kind = 0; a1 = 0; }
                else {
                    const int iq = q_next(ctl + CW_Q2 + 16 * rep, lds);
                    if (iq >= 1196) break;
                    const int i = iq - 2;
                    if (iq < 2) { kind = 0; a0 = 256 + iq; a1 = 6; }
                    else if (iq < 4) { kind = 0; a0 = 256 + (iq - 2); a1 = 7; }
                    else if (i < 10) { kind = 0; a0 = 256 + ((i - 2) >> 2); a1 = 2 + ((i - 2) & 3); }
                    else if (i < 42) { kind = 1; a0 = i - 10; a1 = 0; }
                    else if (i < 298) { kind = 2; a0 = (i - 42) & 63; a1 = 7 - ((i - 42) >> 6); }
                    else if (i < 426) { kind = 3; a0 = i - 298; a1 = 0; }
                    else { const int g = (i - 426) / 3, r = (i - 426) - 3 * g;
                        if (r == 2) { kind = 2; a0 = g & 63; a1 = 3 - (g >> 6); }
                        else { const int d = 2 * g + r; kind = 4; a0 = d >> 2; a1 = d & 3; } }
                }
                if (kind >= 3 && !sample_ok) { wait_count(ctl, ctl + CW_SAMPLE, 12u * (rep + 1)); sample_ok = true; }
                if (kind == 0) { p1_stripe(p, a0, a1, lds); if (ph == 2) signal_done(ctl + CW_SAMPLE); }
                else if (kind == 1) p2_scan(p, a0);
                else if (kind == 2) p2_attn(p, a0, a1, lds);
                else if (kind == 3) p2_glarec(p, a0, lds);
                else p2_decode(p, a0, a1, lds);
            }
        } else {
            for (;;) {
                const int qi = q_next(ctl + CW_Q3 + 16 * rep, lds);
                if (qi >= 540) break;
                if (qi < 16) { p3s_arows(p, qi, lds); signal_done(ctl + CW_AS); }
                else if (qi < 272) p3_stripe(p, qi - 16, lds);
                else if (qi < 280) { wait_count(ctl, ctl + CW_AS, 16u * (rep + 1)); p3s_cols(p, qi - 272, lds); signal_done(ctl + CW_COL); }
                else if (qi < 536) p3_stripe(p, qi - 280 + 256, lds);
                else { wait_count(ctl, ctl + CW_COL, 8u * (rep + 1)); p3s_ln(p, qi - 536, lds); }
            }
        }
        }
        if (use_bar && ph + 1 < ph_hi) {
            XcdBarrier xb; xb.bar = (unsigned*)(p.ws + WS_CTL); xb.x = xb_xcc_id(); xb.st = (volatile LAS unsigned*)lds;
            xcd_barrier(xb);
        }
    }
}


extern "C" void kernel_launch(void* const* d_in, const int* in_sizes, int n_in, void* d_out, int out_size, void* d_ws, size_t ws_size, hipStream_t stream) {
    static int grid = 0;
    if (grid == 0) {
        if (n_in != 22 || (size_t)out_size != OUT_END || ws_size < WS_END) { fprintf(stderr, "kernel_launch: unexpected shapes (n_in %d out %d ws %zu)\n", n_in, out_size, ws_size); grid = -1; return; }
        int dev = 0, cus = 0, per_cu = 0;
        if (hipGetDevice(&dev) != hipSuccess || hipDeviceGetAttribute(&cus, hipDeviceAttributeMultiprocessorCount, dev) != hipSuccess) { grid = -1; return; }
        if (hipFuncSetAttribute((const void*)fwd_mega, hipFuncAttributeMaxDynamicSharedMemorySize, LDS_BYTES) != hipSuccess) { fprintf(stderr, "kernel_launch: hipFuncSetAttribute failed\n"); grid = -1; return; }
        if (hipOccupancyMaxActiveBlocksPerMultiprocessor(&per_cu, (const void*)fwd_mega, NTHR, LDS_BYTES) != hipSuccess || per_cu < 1) { fprintf(stderr, "kernel_launch: occupancy query says %d\n", per_cu); grid = -1; return; }
        (void)hipGetLastError();
        grid = cus;
    }
    if (grid < 0) return;
    Params p{};
    p.x_prompt = (const float*)d_in[0]; p.x_sample = (const float*)d_in[1]; p.cache_lat = (const float*)d_in[2]; p.cache_kr = (const float*)d_in[3];
    p.state_gla = (const float*)d_in[4]; p.page_table = (const int*)d_in[5]; p.c_prompt = (const float*)d_in[6]; p.c_sample = (const float*)d_in[7];
    p.w_ada = (const float*)d_in[8]; p.b_ada = (const float*)d_in[9]; p.w_in = (const float*)d_in[10]; p.q_norm_g = (const float*)d_in[11];
    p.w_uq = (const float*)d_in[12]; p.kv_norm_g = (const float*)d_in[13]; p.w_uk = (const float*)d_in[14]; p.w_uv = (const float*)d_in[15];
    p.w_gate_up = (const float*)d_in[16]; p.b_gate = (const float*)d_in[17]; p.gla_norm_g = (const float*)d_in[18]; p.w_out = (const float*)d_in[19];
    p.ln_g = (const float*)d_in[20]; p.ln_b = (const float*)d_in[21];
    p.out = (float*)d_out; p.ws = (unsigned char*)d_ws;
    if (hipMemsetAsync((char*)d_ws + WS_CTL, 0, CTL_BYTES, stream) != hipSuccess) { fprintf(stderr, "kernel_launch: memset failed\n"); return; }
#if N_LAUNCHES == 1
    hipLaunchKernelGGL(fwd_mega, dim3(grid), dim3(NTHR), LDS_BYTES, stream, p, 0, 4, 1);
#else
    for (int ph = 0; ph < 4; ++ph) hipLaunchKernelGGL(fwd_mega, dim3(grid), dim3(NTHR), LDS_BYTES, stream, p, ph, ph + 1, 0);
#endif
    const hipError_t le = hipPeekAtLastError();
    if (le != hipSuccess) fprintf(stderr, "kernel_launch: launch failed: %s\n", hipGetErrorName(le));
}
```
